# Optimizing an MI355X kernel written in HIP

```python
import math
import jax, jax.numpy as jnp
from jax import lax
import numpy as np

D_MODEL = 1024
BATCH = 8
SEQ = 2048
DEPTH = 2

MEM_LEN = 256
EPS = 1e-6
Q_BLOCK = 128

A_HEADS = 8
A_QK_DIM = 64
A_V_DIM = 2 * A_QK_DIM
A_WIDTH = A_HEADS * A_V_DIM
B_WIDTH = D_MODEL // 2
CONV_W = 3
C_HEADS = 12
C_DIM = 128
C_WIDTH = C_HEADS * C_DIM
X_HEADS = 4
X_DIM = 128
X_WIDTH = X_HEADS * X_DIM

EVEN_MIX = A_WIDTH + B_WIDTH + X_WIDTH
ODD_MIX = C_WIDTH + X_WIDTH
EVEN_IN = 4 * A_WIDTH + 4 * B_WIDTH + 2 * X_WIDTH
ODD_IN = 4 * C_WIDTH + C_HEADS + 2 * X_WIDTH

kernel_name = "hybrid_diffattn_shortconv_fox_memxattn"


def rms_norm(x, g):
    xf = x.astype(jnp.float32)
    y = xf * lax.rsqrt(jnp.mean(xf * xf, axis=-1, keepdims=True) + EPS)
    return (y * g.astype(jnp.float32)).astype(x.dtype)


def alibi_slopes(n_heads):
    return jnp.asarray(np.array([2.0 ** (-8.0 * (i + 1) / n_heads) for i in range(n_heads)], dtype=np.float32))


def sweep_query_blocks(block_fn, *q_arrays):
    seq = q_arrays[0].shape[2]
    nb = seq // Q_BLOCK

    def split(a):
        a = a.reshape(a.shape[:2] + (nb, Q_BLOCK) + a.shape[3:])
        return jnp.moveaxis(a, 2, 0)

    starts = jnp.arange(nb, dtype=jnp.int32) * Q_BLOCK
    out = lax.map(lambda args: block_fn(args[0], *args[1:]), (starts,) + tuple(split(a) for a in q_arrays))
    out = jnp.moveaxis(out, 0, 2)
    return out.reshape(out.shape[:2] + (seq,) + out.shape[4:])


def differential_attention(q, k, v, q_g, k_g, lam_params, out_g, lam_init):
    bsz, seq, _ = q.shape
    q = rms_norm(q.reshape(bsz, seq, A_HEADS, 2, A_QK_DIM), q_g).transpose(0, 2, 3, 1, 4)
    k = rms_norm(k.reshape(bsz, seq, A_HEADS, 2, A_QK_DIM), k_g).transpose(0, 2, 3, 1, 4)
    v = v.reshape(bsz, seq, A_HEADS, A_V_DIM).transpose(0, 2, 1, 3)
    lp = lam_params.astype(jnp.float32)
    lam = jnp.exp(jnp.sum(lp[0] * lp[1])) - jnp.exp(jnp.sum(lp[2] * lp[3])) + lam_init
    slopes = alibi_slopes(A_HEADS)
    scale = A_QK_DIM ** -0.5
    k1, k2 = k[:, :, 0], k[:, :, 1]
    k_pos = jnp.arange(seq, dtype=jnp.int32)

    def block(start, q1b, q2b):
        q_pos = start + jnp.arange(Q_BLOCK, dtype=jnp.int32)
        dist = q_pos[:, None] - k_pos[None, :]
        causal = dist >= 0
        bias = -slopes[:, None, None] * dist.astype(jnp.float32)
        s1 = jnp.einsum('bhqd,bhkd->bhqk', q1b, k1).astype(jnp.float32) * scale + bias
        s2 = jnp.einsum('bhqd,bhkd->bhqk', q2b, k2).astype(jnp.float32) * scale + bias
        p1 = jax.nn.softmax(jnp.where(causal, s1, -jnp.inf), axis=-1)
        p2 = jax.nn.softmax(jnp.where(causal, s2, -jnp.inf), axis=-1)
        attn = (p1 - lam * p2).astype(v.dtype)
        return jnp.einsum('bhqk,bhkd->bhqd', attn, v)

    o = sweep_query_blocks(block, q[:, :, 0], q[:, :, 1])
    o = rms_norm(o, out_g) * (1.0 - lam_init)
    return o.transpose(0, 2, 1, 3).reshape(bsz, seq, A_WIDTH)


def causal_depthwise_conv(u, w, b):
    c = u.shape[-1]
    y = lax.conv_general_dilated(u, w[:, None, :].astype(u.dtype), window_strides=(1,),
                                 padding=[(CONV_W - 1, 0)],
                                 dimension_numbers=('NWC', 'WIO', 'NWC'),
                                 feature_group_count=c)
    return y + b.astype(u.dtype)


def short_gated_conv(h, c_gate, b_gate, w, b):
    return b_gate * causal_depthwise_conv(c_gate * h, w, b)


def forgetting_attention(q, k, v, f_logit, f_bias, q_g, k_g):
    bsz, seq, _ = q.shape
    q = rms_norm(q.reshape(bsz, seq, C_HEADS, C_DIM), q_g).transpose(0, 2, 1, 3)
    k = rms_norm(k.reshape(bsz, seq, C_HEADS, C_DIM), k_g).transpose(0, 2, 1, 3)
    v = v.reshape(bsz, seq, C_HEADS, C_DIM).transpose(0, 2, 1, 3)
    log_f = jax.nn.log_sigmoid(f_logit.astype(jnp.float32) + f_bias.astype(jnp.float32))
    cum = jnp.cumsum(log_f, axis=1).transpose(0, 2, 1)
    scale = C_DIM ** -0.5
    k_pos = jnp.arange(seq, dtype=jnp.int32)

    def block(start, qb, cqb):
        q_pos = start + jnp.arange(Q_BLOCK, dtype=jnp.int32)
        causal = q_pos[:, None] >= k_pos[None, :]
        s = jnp.einsum('bhqd,bhkd->bhqk', qb, k).astype(jnp.float32) * scale
        s = s + (cqb[..., :, None] - cum[:, :, None, :])
        p = jax.nn.softmax(jnp.where(causal, s, -jnp.inf), axis=-1).astype(v.dtype)
        return jnp.einsum('bhqk,bhkd->bhqd', p, v)

    o = sweep_query_blocks(block, q, cum)
    return o.transpose(0, 2, 1, 3).reshape(bsz, seq, C_WIDTH)


def memory_cross_attention(q, mem, mem_g, w_mem_kv, q_g, k_g):
    bsz, seq, _ = q.shape
    m = mem.shape[1]
    mk, mv = jnp.split(rms_norm(mem, mem_g) @ w_mem_kv, 2, axis=-1)
    q = rms_norm(q.reshape(bsz, seq, X_HEADS, X_DIM), q_g)
    mk = rms_norm(mk.reshape(bsz, m, X_HEADS, X_DIM), k_g)
    mv = mv.reshape(bsz, m, X_HEADS, X_DIM)
    s = jnp.einsum('bshd,bmhd->bhsm', q, mk).astype(jnp.float32) * (X_DIM ** -0.5)
    p = jax.nn.softmax(s, axis=-1).astype(mv.dtype)
    o = jnp.einsum('bhsm,bmhd->bshd', p, mv)
    return o.reshape(bsz, seq, X_WIDTH)


def even_layer(h, mem, layer, norm_g, w_in, w_out, a_qn, a_kn, a_lam, a_on,
               b_cw, b_cb, x_qn, x_kn, mem_g, w_mem_kv):
    u = rms_norm(h, norm_g)
    proj = u @ w_in
    cuts = np.cumsum([A_WIDTH] * 4 + [B_WIDTH] * 4 + [X_WIDTH] * 2)[:-1].tolist()
    aq, ak, av, az, bh, bc, bb, bz, xq, xz = jnp.split(proj, cuts, axis=-1)
    lam_init = 0.8 - 0.6 * math.exp(-0.3 * layer)
    ya = differential_attention(aq, ak, av, a_qn, a_kn, a_lam, a_on, lam_init)
    yb = short_gated_conv(bh, bc, bb, b_cw, b_cb)
    yx = memory_cross_attention(xq, mem, mem_g, w_mem_kv, x_qn, x_kn)
    y = jnp.concatenate([ya * jax.nn.silu(az), yb * jax.nn.silu(bz), yx * jax.nn.silu(xz)], axis=-1)
    return h + y @ w_out


def odd_layer(h, mem, norm_g, w_in, w_out, c_qn, c_kn, c_fb, x_qn, x_kn, mem_g, w_mem_kv):
    u = rms_norm(h, norm_g)
    proj = u @ w_in
    cuts = np.cumsum([C_WIDTH] * 4 + [C_HEADS] + [X_WIDTH] * 2)[:-1].tolist()
    cq, ck, cv, cz, cf, xq, xz = jnp.split(proj, cuts, axis=-1)
    yc = forgetting_attention(cq, ck, cv, cf, c_fb, c_qn, c_kn)
    yx = memory_cross_attention(xq, mem, mem_g, w_mem_kv, x_qn, x_kn)
    y = jnp.concatenate([yc * jax.nn.silu(cz), yx * jax.nn.silu(xz)], axis=-1)
    return h + y @ w_out


def setup_inputs(seed: int = 0) -> dict:
    key = jax.random.key(seed)
    ks = jax.random.split(key, 32)
    it = iter(range(32))
    ne = (DEPTH + 1) // 2
    no = DEPTH // 2

    def nrm(shape, scale):
        return scale * jax.random.normal(ks[next(it)], shape, jnp.float32)

    def gain(shape):
        return 1.0 + 0.02 * jax.random.normal(ks[next(it)], shape, jnp.float32)

    return {
        "x": nrm((BATCH, SEQ, D_MODEL), 1.0),
        "mem": nrm((BATCH, MEM_LEN, D_MODEL), 1.0),
        "e_norm_g": gain((ne, D_MODEL)),
        "e_w_in": nrm((ne, D_MODEL, EVEN_IN), D_MODEL ** -0.5),
        "e_w_out": nrm((ne, EVEN_MIX, D_MODEL), EVEN_MIX ** -0.5),
        "e_a_q_norm_g": gain((ne, A_QK_DIM)),
        "e_a_k_norm_g": gain((ne, A_QK_DIM)),
        "e_a_lambda": nrm((ne, 4, A_QK_DIM), 0.1),
        "e_a_out_norm_g": gain((ne, A_V_DIM)),
        "e_b_conv_w": nrm((ne, CONV_W, B_WIDTH), CONV_W ** -0.5),
        "e_b_conv_b": nrm((ne, B_WIDTH), 0.02),
        "e_x_q_norm_g": gain((ne, X_DIM)),
        "e_x_k_norm_g": gain((ne, X_DIM)),
        "e_mem_norm_g": gain((ne, D_MODEL)),
        "e_w_mem_kv": nrm((ne, D_MODEL, 2 * X_WIDTH), D_MODEL ** -0.5),
        "o_norm_g": gain((no, D_MODEL)),
        "o_w_in": nrm((no, D_MODEL, ODD_IN), D_MODEL ** -0.5),
        "o_w_out": nrm((no, ODD_MIX, D_MODEL), ODD_MIX ** -0.5),
        "o_c_q_norm_g": gain((no, C_DIM)),
        "o_c_k_norm_g": gain((no, C_DIM)),
        "o_c_forget_b": 3.0 + nrm((no, C_HEADS), 0.5),
        "o_x_q_norm_g": gain((no, X_DIM)),
        "o_x_k_norm_g": gain((no, X_DIM)),
        "o_mem_norm_g": gain((no, D_MODEL)),
        "o_w_mem_kv": nrm((no, D_MODEL, 2 * X_WIDTH), D_MODEL ** -0.5),
    }


def reference(x, mem, e_norm_g, e_w_in, e_w_out, e_a_q_norm_g, e_a_k_norm_g, e_a_lambda,
              e_a_out_norm_g, e_b_conv_w, e_b_conv_b, e_x_q_norm_g, e_x_k_norm_g,
              e_mem_norm_g, e_w_mem_kv, o_norm_g, o_w_in, o_w_out, o_c_q_norm_g,
              o_c_k_norm_g, o_c_forget_b, o_x_q_norm_g, o_x_k_norm_g, o_mem_norm_g,
              o_w_mem_kv):
    h = x
    for layer in range(DEPTH):
        i = layer // 2
        if layer % 2 == 0:
            h = even_layer(h, mem, layer, e_norm_g[i], e_w_in[i], e_w_out[i],
                           e_a_q_norm_g[i], e_a_k_norm_g[i], e_a_lambda[i], e_a_out_norm_g[i],
                           e_b_conv_w[i], e_b_conv_b[i], e_x_q_norm_g[i], e_x_k_norm_g[i],
                           e_mem_norm_g[i], e_w_mem_kv[i])
        else:
            h = odd_layer(h, mem, o_norm_g[i], o_w_in[i], o_w_out[i],
                          o_c_q_norm_g[i], o_c_k_norm_g[i], o_c_forget_b[i],
                          o_x_q_norm_g[i], o_x_k_norm_g[i], o_mem_norm_g[i], o_w_mem_kv[i])
    return h
```

```cpp
#include <hip/hip_runtime.h>
#include <cstdio>
#include <cstdint>

#ifndef P2_PARTS
#define P2_PARTS 7
#endif
#ifndef MK_N_LAUNCHES
#define MK_N_LAUNCHES 1
#endif

#define LAS __attribute__((address_space(3)))
#define GAS __attribute__((address_space(1)))
typedef unsigned short bf16_t;
typedef short bf16x8 __attribute__((ext_vector_type(8)));
typedef short s16x4 __attribute__((ext_vector_type(4)));
typedef float f32x4 __attribute__((ext_vector_type(4)));
typedef float f32x2 __attribute__((ext_vector_type(2)));
typedef float f32x16 __attribute__((ext_vector_type(16)));
typedef unsigned u32x4 __attribute__((ext_vector_type(4)));
typedef unsigned u32x2 __attribute__((ext_vector_type(2)));
typedef __bf16 bf16x2_t __attribute__((ext_vector_type(2)));

constexpr int BATCH = 8, SEQ = 2048, DM = 1024, M = BATCH * SEQ;
constexpr int MEML = 256, MM = BATCH * MEML;
constexpr float EPS = 1e-6f;
constexpr float LOG2E = 1.4426950408889634f;
constexpr float C2_64 = 0.125f * LOG2E;
constexpr float C2_128 = 0.08838834764831845f * LOG2E;
constexpr float LAM_INIT = 0.2f;

constexpr size_t MiB = 1u << 20;
constexpr size_t WS_CTL = 0, CTL_ZERO_BYTES = 1 * MiB;
constexpr size_t WS_SSQ1 = 512 * 1024;
constexpr size_t WS_RSTD0 = 1 * MiB;
constexpr size_t WS_WF = 1 * MiB + 256 * 1024;
constexpr size_t WS_LF = 2 * MiB;
constexpr size_t WS_WA_E = 3 * MiB, WS_WG_E = 13 * MiB, WS_WO_E = 17 * MiB, WS_WM_E = 21 * MiB;
constexpr size_t WS_WA_O = 23 * MiB, WS_WG_O = 33 * MiB, WS_WO_O = 37 * MiB, WS_WM_O = 41 * MiB;
constexpr size_t WS_MEMN = 43 * MiB;
constexpr size_t WS_MK_E = 47 * MiB, WS_MV_E = 49 * MiB, WS_MK_O = 51 * MiB, WS_MV_O = 53 * MiB;
constexpr size_t WS_Y = 56 * MiB, WS_R1 = 120 * MiB, WS_R2 = 168 * MiB, WS_R3 = 216 * MiB, WS_END = 248 * MiB;
constexpr size_t WS_BB = WS_R1 + 32 * MiB;
constexpr int CW_BAR = 4096;

constexpr int RING_BYTES = 131072;
constexpr int LDSCTL_OFF = RING_BYTES, MISC_OFF = LDSCTL_OFF + 320, XCH_OFF = LDSCTL_OFF + 1024;
constexpr int LDS_BYTES = 147456;

__device__ __forceinline__ unsigned cvtpk(float lo, float hi) { f32x2 v = {lo, hi}; bf16x2_t b = __builtin_convertvector(v, bf16x2_t); return __builtin_bit_cast(unsigned, b); }
__device__ __forceinline__ float bf_lo(unsigned w) { return __builtin_bit_cast(float, w << 16); }
__device__ __forceinline__ float bf_hi(unsigned w) { return __builtin_bit_cast(float, w & 0xffff0000u); }
__device__ __forceinline__ float wave_sum(float v) {
#pragma unroll
    for (int o = 1; o < 64; o <<= 1) v += __shfl_xor(v, o);
    return v;
}
#define LDS_WAIT() asm volatile("s_waitcnt lgkmcnt(0)" ::: "memory")
#define VM_WAIT() asm volatile("s_waitcnt vmcnt(0)" ::: "memory")

namespace pg8 {
constexpr int BM = 256, BK = 64, HALF = 128, HTB = HALF * BK * 2, STAGE_BYTES = 8 * HTB, NXCD = 8, WGM = 8;
__host__ __device__ __forceinline__ int lds_byte(int r, int c) { const int st = (r >> 4) * 2 + (c >> 5), rr = r & 15, cc = c & 31, ob = rr * 64 + cc * 2; return st * 1024 + (ob ^ (((ob >> 9) & 1) << 5)); }
__host__ __device__ __forceinline__ void stage_rc(int b, int& R, int& C) { const int st = b / 1024, sb = b % 1024, swz = sb ^ (((sb >> 9) & 1) << 5); R = (st >> 1) * 16 + swz / 64; C = (st & 1) * 32 + (swz % 64) / 2; }
__host__ __device__ __forceinline__ int perm32(int rho) { const int n = rho >> 4, i = rho & 15; return 8 * (i >> 2) + 4 * n + (i & 3); }
struct Unit { int pm, pn; };
struct Gemm { const bf16_t* A; const bf16_t* Bt; int M, N, K; };
struct StaticOrder {
    int nM, nN, nwg, G, c;
    __host__ __device__ void init(int M_, int N_, int G_, int c_) { nM = M_ / BM; nN = N_ / BM; nwg = nM * nN; G = G_; c = c_; }
    __host__ __device__ bool next(int i, Unit& u) const {
        const long L = (long)i * G + c; if (L >= nwg) return false;
        int wgid = (int)L; { const int q = nwg / NXCD, r = nwg % NXCD, xcd = wgid % NXCD, off = wgid / NXCD; wgid = (xcd < r ? xcd * (q + 1) : r * (q + 1) + (xcd - r) * q) + off; }
        const int nig = WGM * nN, gid = wgid / nig, fm = gid * WGM, gsz = (nM - fm) < WGM ? (nM - fm) : WGM;
        u.pm = fm + ((wgid % nig) % gsz); u.pn = (wgid % nig) / gsz; return true;
    }
};
template <class Epi, class Sched, bool ALIGN_EPI>
__device__ __forceinline__ void gemm_phase(LAS unsigned char* lds, const Gemm g, const Sched& S, const Epi& E) {
    const int tid = threadIdx.x, wid = __builtin_amdgcn_readfirstlane(tid >> 6), lane = tid & 63, wr = wid >> 2, wc = wid & 3, fr = lane & 15, fq = lane >> 4;
    const int K = g.K, nt = K / BK;
    unsigned voffA[2], voffB[2];
#pragma unroll
    for (int i = 0; i < 2; ++i) { int R, C; stage_rc(tid * 16 + i * 8192, R, C); const int Rb = (R & ~31) + perm32(R & 31);
        voffA[i] = (unsigned)(R * K + C) * 2u; voffB[i] = (unsigned)(Rb * K + C) * 2u; }
    const size_t kstep = (size_t)(BK * 2);
    const size_t hstep = (size_t)HALF * K * 2;
    const size_t tstep = 2 * hstep;
    const unsigned ldsw = (unsigned)wid * 1024u;
    const int aoff = lds_byte(wr * 64 + fr, fq * 8), boff = lds_byte(wc * 32 + fr, fq * 8);
#define PG8_SA(b, h) (((b) * 2 + (h)) * HTB)
#define PG8_SB(b, h) ((4 + (b) * 2 + (h)) * HTB)
#define PG8_STAGE(bufoff, gbase, voff) do { _Pragma("unroll") for (int _i = 0; _i < 2; ++_i) \
        __builtin_amdgcn_global_load_lds((const unsigned*)((const char*)(gbase) + (voff)[_i]), (LAS unsigned*)(lds + (bufoff) + ldsw + _i * 8192), 16, 0, 0); } while (0)
#define PG8_LDA(dst, b, h) do { _Pragma("unroll") for (int m = 0; m < 4; ++m) _Pragma("unroll") for (int k = 0; k < 2; ++k) dst[m][k] = *(const LAS bf16x8*)(lds + PG8_SA(b, h) + aoff + m * 2048 + k * 1024); } while (0)
#define PG8_LDB(dst, b, h) do { _Pragma("unroll") for (int n = 0; n < 2; ++n) _Pragma("unroll") for (int k = 0; k < 2; ++k) dst[n][k] = *(const LAS bf16x8*)(lds + PG8_SB(b, h) + boff + n * 2048 + k * 1024); } while (0)
#define PG8_MMA(ai, bj, At, Bt) do { __builtin_amdgcn_s_setprio(1); _Pragma("unroll") for (int m = 0; m < 4; ++m) _Pragma("unroll") for (int n = 0; n < 2; ++n) _Pragma("unroll") for (int k = 0; k < 2; ++k) \
        acc[ai][bj][m][n] = __builtin_amdgcn_mfma_f32_16x16x32_bf16(Bt[n][k], At[m][k], acc[ai][bj][m][n], 0, 0, 0); __builtin_amdgcn_s_setprio(0); } while (0)
#define PG8_WAIT_V(n) asm volatile("s_waitcnt vmcnt(" #n ")" ::: "memory")
#define PG8_WAIT_L(n) asm volatile("s_waitcnt lgkmcnt(" #n ")" ::: "memory")
#define PG8_BAR __builtin_amdgcn_s_barrier()
#define PG8_SCHED __builtin_amdgcn_sched_barrier(0)
    Unit cur, nxt; int ui = 0;
    if (!S.next(0, cur)) return;
    f32x4 acc[2][2][4][2];
#pragma unroll
    for (int a = 0; a < 2; ++a)
#pragma unroll
        for (int b = 0; b < 2; ++b)
#pragma unroll
            for (int m = 0; m < 4; ++m)
#pragma unroll
                for (int n = 0; n < 2; ++n) acc[a][b][m][n] = (f32x4){0.f, 0.f, 0.f, 0.f};
    bf16x8 At[4][2], B0[2][2], B1[2][2];
    const char* cA = (const char*)g.A + (size_t)cur.pm * tstep; const char* cB = (const char*)g.Bt + (size_t)cur.pn * tstep;
    PG8_STAGE(PG8_SB(0, 0), cB, voffB); PG8_STAGE(PG8_SB(0, 1), cB + hstep, voffB); PG8_STAGE(PG8_SA(0, 0), cA, voffA); PG8_STAGE(PG8_SA(0, 1), cA + hstep, voffA);
    if (wr == 1) PG8_BAR;
    PG8_WAIT_V(2); PG8_BAR;
    PG8_STAGE(PG8_SB(1, 0), cB + kstep, voffB); PG8_STAGE(PG8_SA(1, 0), cA + kstep, voffA); PG8_STAGE(PG8_SB(1, 1), cB + hstep + kstep, voffB);
    PG8_WAIT_V(6); PG8_BAR;
    for (;;) {
        const bool has_next = S.next(ui + 1, nxt);
        const char* nA = has_next ? (const char*)g.A + (size_t)nxt.pm * tstep : cA; const char* nB = has_next ? (const char*)g.Bt + (size_t)nxt.pn * tstep : cB;
        for (int t = 0; t < nt; t += 2) {
            const bool last = (t == nt - 2);
            const char* a1 = cA + (size_t)(t + 1) * kstep;
            const char* a2 = last ? nA : cA + (size_t)(t + 2) * kstep; const char* b2 = last ? nB : cB + (size_t)(t + 2) * kstep;
            const char* a3 = a2 + kstep; const char* b3 = b2 + kstep;
            PG8_LDB(B0, 0, 0); PG8_LDB(B1, 0, 1); PG8_SCHED; PG8_LDA(At, 0, 0); PG8_STAGE(PG8_SA(1, 1), a1 + hstep, voffA);
            PG8_WAIT_V(8); PG8_WAIT_L(0); PG8_BAR; PG8_MMA(0, 0, At, B0); PG8_MMA(0, 1, At, B1); PG8_BAR; PG8_SCHED;
            PG8_LDA(At, 0, 1); PG8_STAGE(PG8_SB(0, 0), b2, voffB); PG8_STAGE(PG8_SB(0, 1), b2 + hstep, voffB); PG8_STAGE(PG8_SA(0, 0), a2, voffA);
            PG8_WAIT_V(8); PG8_WAIT_L(0); PG8_BAR; PG8_MMA(1, 0, At, B0); PG8_MMA(1, 1, At, B1); PG8_BAR; PG8_SCHED;
            PG8_LDB(B0, 1, 0); PG8_LDB(B1, 1, 1); PG8_SCHED; PG8_LDA(At, 1, 0); PG8_STAGE(PG8_SA(0, 1), a2 + hstep, voffA);
            PG8_WAIT_V(8); PG8_WAIT_L(0); PG8_BAR; PG8_MMA(0, 0, At, B0); PG8_MMA(0, 1, At, B1); PG8_BAR; PG8_SCHED;
            PG8_LDA(At, 1, 1); PG8_STAGE(PG8_SB(1, 0), b3, voffB); PG8_STAGE(PG8_SB(1, 1), b3 + hstep, voffB); PG8_STAGE(PG8_SA(1, 0), a3, voffA);
            PG8_WAIT_V(8); PG8_WAIT_L(0); PG8_BAR; PG8_MMA(1, 0, At, B0); PG8_MMA(1, 1, At, B1); PG8_BAR; PG8_SCHED;
        }
        if constexpr (ALIGN_EPI) { if (wr == 0) PG8_BAR; }
        E(acc, cur, wr, wc, fr, fq);
        if (!has_next) break;
#pragma unroll
        for (int a = 0; a < 2; ++a)
#pragma unroll
            for (int b = 0; b < 2; ++b)
#pragma unroll
                for (int m = 0; m < 4; ++m)
#pragma unroll
                    for (int n = 0; n < 2; ++n) acc[a][b][m][n] = (f32x4){0.f, 0.f, 0.f, 0.f};
        cur = nxt; cA = nA; cB = nB; ++ui;
        if constexpr (ALIGN_EPI) { if (wr == 1) PG8_BAR; }
    }
    PG8_WAIT_V(0);
    if constexpr (!ALIGN_EPI) { if (wr == 0) PG8_BAR; }
    PG8_BAR;
#undef PG8_SA
#undef PG8_SB
#undef PG8_STAGE
#undef PG8_LDA
#undef PG8_LDB
#undef PG8_MMA
#undef PG8_WAIT_V
#undef PG8_WAIT_L
#undef PG8_BAR
#undef PG8_SCHED
}

struct TileDesc { int mode; bf16_t* dst; int ld; const float* g; float ps; };
struct EpiProj {
    int kind;
    const float* rstd;
    const float* ssq;
    bf16_t *Y, *R1, *R2, *R3, *BB, *MK, *MV;
    const float *g_q, *g_k, *g_xq, *g_xk;
    LAS float* xch;
    __device__ __forceinline__ TileDesc desc(int pn) const {
        TileDesc d; d.mode = 0; d.dst = nullptr; d.ld = 0; d.g = nullptr; d.ps = 1.f;
        if (kind == 0) {
            if (pn < 4) { d.mode = 1; d.dst = Y + 256 * pn; d.ld = 2048; d.g = g_q; d.ps = C2_64; }
            else if (pn < 8) { d.mode = 1; d.dst = R1 + 256 * (pn - 4); d.ld = 1024; d.g = g_k; }
            else if (pn < 12) { d.dst = R2 + 256 * (pn - 8); d.ld = 1024; }
            else if (pn < 16) { d.dst = R3 + 256 * (pn - 12); d.ld = 1024; }
            else if (pn < 18) { d.dst = BB + 256 * (pn - 16); d.ld = 512; }
            else { d.mode = 2; d.dst = Y + 1536 + 256 * (pn - 18); d.ld = 2048; d.g = g_xq; d.ps = C2_128; }
        } else if (kind == 1) {
            if (pn < 6) { d.mode = 2; d.dst = Y + 256 * pn; d.ld = 2048; d.g = g_q; d.ps = C2_128; }
            else if (pn < 12) { d.mode = 2; d.dst = R1 + 256 * (pn - 6); d.ld = 1536; d.g = g_k; }
            else if (pn < 18) { d.dst = R2 + 256 * (pn - 12); d.ld = 1536; }
            else { d.mode = 2; d.dst = Y + 1536 + 256 * (pn - 18); d.ld = 2048; d.g = g_xq; d.ps = C2_128; }
        } else {
            if (pn < 2) { d.mode = 2; d.dst = MK + 256 * pn; d.ld = 512; d.g = g_xk; }
            else { d.dst = MV + 256 * (pn - 2); d.ld = 512; }
        }
        return d;
    }
    __device__ __forceinline__ float rowscale(int row) const {
        if (kind == 0) return rstd[row];
        if (kind == 1) return 1.0f / sqrtf(ssq[row] * (1.0f / DM) + EPS);
        return 1.f;
    }
    __device__ __forceinline__ void operator()(const f32x4 (&acc)[2][2][4][2], const Unit& u, int wr, int wc, int fr, int fq) const {
        const TileDesc d = desc(u.pn);
        const int cl = 64 * wc + 8 * fq;
        f32x4 gv[2][2];
#pragma unroll
        for (int bj = 0; bj < 2; ++bj)
#pragma unroll
            for (int n = 0; n < 2; ++n) gv[bj][n] = (f32x4){d.ps, d.ps, d.ps, d.ps};
        if (d.mode != 0) {
            const int gi = (d.mode == 2 ? 64 * (wc & 1) : 0) + 8 * fq;
#pragma unroll
            for (int bj = 0; bj < 2; ++bj)
#pragma unroll
                for (int n = 0; n < 2; ++n) gv[bj][n] = *(const f32x4*)(d.g + gi + 32 * bj + 4 * n) * d.ps;
        }
        float rn[2][4];
#pragma unroll
        for (int ai = 0; ai < 2; ++ai)
#pragma unroll
            for (int m = 0; m < 4; ++m) rn[ai][m] = 1.f;
        if (d.mode != 0) {
            float ss[2][4];
#pragma unroll
            for (int ai = 0; ai < 2; ++ai)
#pragma unroll
                for (int m = 0; m < 4; ++m) {
                    const int row = u.pm * BM + ai * HALF + wr * 64 + m * 16 + fr; const float rs = rowscale(row); float s = 0.f;
#pragma unroll
                    for (int bj = 0; bj < 2; ++bj)
#pragma unroll
                        for (int n = 0; n < 2; ++n) { const f32x4 v = acc[ai][bj][m][n] * rs; s += (v[0] * v[0] + v[1] * v[1]) + (v[2] * v[2] + v[3] * v[3]); }
                    s += __shfl_xor(s, 16); s += __shfl_xor(s, 32);
                    ss[ai][m] = s;
                }
            if (d.mode == 2) {
#pragma unroll
                for (int ai = 0; ai < 2; ++ai)
#pragma unroll
                    for (int m = 0; m < 4; ++m) if (fq == 0) xch[(ai * HALF + wr * 64 + m * 16 + fr) * 4 + wc] = ss[ai][m];
                asm volatile("s_waitcnt lgkmcnt(0)" ::: "memory"); __builtin_amdgcn_s_barrier(); asm volatile("" ::: "memory");
#pragma unroll
                for (int ai = 0; ai < 2; ++ai)
#pragma unroll
                    for (int m = 0; m < 4; ++m) ss[ai][m] += xch[(ai * HALF + wr * 64 + m * 16 + fr) * 4 + (wc ^ 1)];
            }
            const float inv = d.mode == 2 ? (1.0f / 128.0f) : (1.0f / 64.0f);
#pragma unroll
            for (int ai = 0; ai < 2; ++ai)
#pragma unroll
                for (int m = 0; m < 4; ++m) rn[ai][m] = 1.0f / sqrtf(ss[ai][m] * inv + EPS);
        }
#pragma unroll
        for (int ai = 0; ai < 2; ++ai)
#pragma unroll
            for (int m = 0; m < 4; ++m) {
                const int row = u.pm * BM + ai * HALF + wr * 64 + m * 16 + fr; const float rs = rowscale(row) * rn[ai][m];
                bf16_t* rowp = d.dst + (size_t)row * d.ld + cl;
#pragma unroll
                for (int bj = 0; bj < 2; ++bj) {
                    const f32x4 v0 = acc[ai][bj][m][0] * rs * gv[bj][0], v1 = acc[ai][bj][m][1] * rs * gv[bj][1];
                    u32x4 w; w.x = cvtpk(v0[0], v0[1]); w.y = cvtpk(v0[2], v0[3]); w.z = cvtpk(v1[0], v1[1]); w.w = cvtpk(v1[2], v1[3]);
                    *(u32x4*)(rowp + 32 * bj) = w;
                }
            }
    }
};
struct EpiGate {
    int kind; const float* rstd; const float* ssq; bf16_t* Y;
    __device__ __forceinline__ float rowscale(int row) const { return kind == 0 ? rstd[row] : 1.0f / sqrtf(ssq[row] * (1.0f / DM) + EPS); }
    __device__ __forceinline__ void operator()(const f32x4 (&acc)[2][2][4][2], const Unit& u, int wr, int wc, int fr, int fq) const {
        const int cl = u.pn * BM + 64 * wc + 8 * fq;
#pragma unroll
        for (int ai = 0; ai < 2; ++ai)
#pragma unroll
            for (int m = 0; m < 4; ++m) {
                const int row = u.pm * BM + ai * HALF + wr * 64 + m * 16 + fr; const float rs = rowscale(row);
                bf16_t* rowp = Y + (size_t)row * 2048 + cl;
#pragma unroll
                for (int bj = 0; bj < 2; ++bj) {
                    const u32x4 yv = *(const u32x4*)(rowp + 32 * bj);
                    float z[8], yy[8];
#pragma unroll
                    for (int i = 0; i < 4; ++i) { z[i] = acc[ai][bj][m][0][i] * rs; z[4 + i] = acc[ai][bj][m][1][i] * rs; }
                    yy[0] = bf_lo(yv.x); yy[1] = bf_hi(yv.x); yy[2] = bf_lo(yv.y); yy[3] = bf_hi(yv.y); yy[4] = bf_lo(yv.z); yy[5] = bf_hi(yv.z); yy[6] = bf_lo(yv.w); yy[7] = bf_hi(yv.w);
#pragma unroll
                    for (int i = 0; i < 8; ++i) { const float sg = __builtin_amdgcn_rcpf(1.0f + __builtin_amdgcn_exp2f(-z[i] * LOG2E)); yy[i] = yy[i] * z[i] * sg; }
                    u32x4 w; w.x = cvtpk(yy[0], yy[1]); w.y = cvtpk(yy[2], yy[3]); w.z = cvtpk(yy[4], yy[5]); w.w = cvtpk(yy[6], yy[7]);
                    *(u32x4*)(rowp + 32 * bj) = w;
                }
            }
    }
};
template <bool FIRST> struct EpiOut {
    const float* base; float* hout; bf16_t* hb; float* ssq;
    __device__ __forceinline__ void operator()(const f32x4 (&acc)[2][2][4][2], const Unit& u, int wr, int wc, int fr, int fq) const {
        const int cl = u.pn * BM + 64 * wc + 8 * fq;
#pragma unroll
        for (int ai = 0; ai < 2; ++ai)
#pragma unroll
            for (int m = 0; m < 4; ++m) {
                const int row = u.pm * BM + ai * HALF + wr * 64 + m * 16 + fr; const size_t off = (size_t)row * DM + cl; float s = 0.f;
#pragma unroll
                for (int bj = 0; bj < 2; ++bj) {
                    const f32x4 h0 = *(const f32x4*)(base + off + 32 * bj) + acc[ai][bj][m][0], h1 = *(const f32x4*)(base + off + 32 * bj + 4) + acc[ai][bj][m][1];
                    *(f32x4*)(hout + off + 32 * bj) = h0; *(f32x4*)(hout + off + 32 * bj + 4) = h1;
                    if (FIRST) {
                        u32x4 w; w.x = cvtpk(h0[0], h0[1]); w.y = cvtpk(h0[2], h0[3]); w.z = cvtpk(h1[0], h1[1]); w.w = cvtpk(h1[2], h1[3]);
                        *(u32x4*)(hb + off + 32 * bj) = w;
                        s += (h0[0] * h0[0] + h0[1] * h0[1]) + (h0[2] * h0[2] + h0[3] * h0[3]) + (h1[0] * h1[0] + h1[1] * h1[1]) + (h1[2] * h1[2] + h1[3] * h1[3]);
                    }
                }
                if (FIRST) { s += __shfl_xor(s, 16); s += __shfl_xor(s, 32); if (fq == 0) atomicAdd(ssq + row, s); }
            }
    }
};
}

namespace att {
constexpr int NW = 8, QBLK = 32, KVBLK = 64;
constexpr int SHM_V = 16384, SHM_K = 16384, K_OFF = 2 * SHM_V;
constexpr int XSTG_END = 69632, WS_OFF = 69632, BIAS_OFF = 71680, SCAN_OFF = 79872;
constexpr float THR = 8.f;
#define KSWZ(row, colB) ((row) * 256 + ((colB) ^ (((row) & 7) << 4)))
#define SBAR() __builtin_amdgcn_sched_barrier(0)
__device__ __forceinline__ int v_st(int k, int c) { const int kk = (k & ~0xC) | ((k & 4) << 1) | ((k & 8) >> 1); return ((kk >> 3) * 4 + (c >> 5)) * 512 + ((kk & 7) * 32 + (c & 31)) * 2; }
__device__ __forceinline__ int v_rd_base(int lane) { return ((lane & 3) << 3) | (((lane >> 2) & 3) << 6) | (((lane >> 4) & 1) << 5) | (((lane >> 5) & 1) << 8); }
constexpr int v_rd_off(int d0, int ks, int half) { return d0 * 512 + ks * 4096 + half * 2048; }
__device__ __forceinline__ int crow(int r, int hi) { return (r & 3) + 8 * (r >> 2) + 4 * hi; }
__device__ __forceinline__ void mask_causal(f32x16& p0, f32x16& p1, int dq) {
    const float NEG = -__builtin_inff();
#pragma unroll
    for (int r = 0; r < 16; ++r) { const int c = (r & 3) + 8 * (r >> 2); if (dq - c < 0) p0[r] = NEG; if (dq - c - 32 < 0) p1[r] = NEG; }
}
__device__ __forceinline__ void partialSM(f32x16& p0, f32x16& p1, float& m_reg, float& mn, float& alpha, float toff) {
    float pmax = p0[0];
#pragma unroll
    for (int r = 1; r < 16; ++r) pmax = fmaxf(pmax, p0[r]);
#pragma unroll
    for (int r = 0; r < 16; ++r) pmax = fmaxf(pmax, p1[r]);
    { auto rr = __builtin_amdgcn_permlane32_swap(__float_as_uint(pmax), __float_as_uint(pmax), false, false);
      pmax = fmaxf(__uint_as_float(rr[0]), __uint_as_float(rr[1])); }
    pmax += toff;
    if (__builtin_expect(__all(pmax - m_reg <= THR), 1)) { mn = m_reg; alpha = 1.f; }
    else { mn = fmaxf(m_reg, pmax); alpha = __builtin_amdgcn_exp2f(m_reg - mn); m_reg = mn; }
    const float mr = mn - toff;
#pragma unroll
    for (int r = 0; r < 16; ++r) p0[r] -= mr;
#pragma unroll
    for (int r = 0; r < 16; ++r) p1[r] -= mr;
#pragma unroll
    for (int r = 0; r < 16; ++r) p0[r] = __builtin_amdgcn_exp2f(p0[r]);
}
__device__ __forceinline__ void finishSM(f32x16& p0, f32x16& p1, float alpha, float& l_reg, bf16x8& pa0, bf16x8& pa1, bf16x8& pa2, bf16x8& pa3) {
#pragma unroll
    for (int r = 0; r < 16; ++r) p1[r] = __builtin_amdgcn_exp2f(p1[r]);
    float ps = 0;
#pragma unroll
    for (int r = 0; r < 16; ++r) ps += p0[r];
#pragma unroll
    for (int r = 0; r < 16; ++r) ps += p1[r];
    { auto rr = __builtin_amdgcn_permlane32_swap(__float_as_uint(ps), __float_as_uint(ps), false, false);
      ps = __uint_as_float(rr[0]) + __uint_as_float(rr[1]); }
    l_reg = l_reg * alpha + ps;
#define PK4(P, B_, OUT) do { unsigned a0 = cvtpk(P[B_+0], P[B_+1]), a1 = cvtpk(P[B_+2], P[B_+3]);                          \
        unsigned b0 = cvtpk(P[B_+4], P[B_+5]), b1 = cvtpk(P[B_+6], P[B_+7]);                                             \
        auto r0 = __builtin_amdgcn_permlane32_swap(a0, b0, false, false); auto r1 = __builtin_amdgcn_permlane32_swap(a1, b1, false, false); \
        u32x4 w = {r0[0], r1[0], r0[1], r1[1]}; OUT = __builtin_bit_cast(bf16x8, w); } while (0)
    PK4(p0, 0, pa0); PK4(p0, 8, pa1); PK4(p1, 0, pa2); PK4(p1, 8, pa3);
#undef PK4
}
template <int KB, int ND, int BIAS>
__device__ __forceinline__ void qkt(f32x16& p0, f32x16& p1, LAS const char* K_lds, int ksub, int r32, int hi, const bf16x8* qr, LAS const float* bl) {
    if (BIAS) {
#pragma unroll
        for (int g = 0; g < 4; ++g) { const f32x4 a = *(LAS const f32x4*)(bl + 8 * g), b = *(LAS const f32x4*)(bl + 32 + 8 * g);
            p0[4 * g] = a[0]; p0[4 * g + 1] = a[1]; p0[4 * g + 2] = a[2]; p0[4 * g + 3] = a[3]; p1[4 * g] = b[0]; p1[4 * g + 1] = b[1]; p1[4 * g + 2] = b[2]; p1[4 * g + 3] = b[3]; }
    } else { p0 = f32x16{}; p1 = f32x16{}; }
    LAS const char* kb[4];
#pragma unroll
    for (int dd = 0; dd < 4; ++dd) kb[dd] = K_lds + KB * SHM_K + KSWZ(r32, (dd * 16 + hi * 8) * 2) + ksub;
#pragma unroll
    for (int d0 = 0; d0 < ND; ++d0) { LAS const char* a = kb[d0 & 3] + (d0 >> 2) * 128;
        const bf16x8 b0 = *(LAS const bf16x8*)(a);
        const bf16x8 b1 = *(LAS const bf16x8*)(a + 32 * 256);
        p0 = __builtin_amdgcn_mfma_f32_32x32x16_bf16(b0, qr[d0], p0, 0, 0, 0);
        p1 = __builtin_amdgcn_mfma_f32_32x32x16_bf16(b1, qr[d0], p1, 0, 0, 0); }
}
template <int VB>
__device__ __forceinline__ void pv_tile(f32x16* o, int vb0, bf16x8 pa0, bf16x8 pa1, bf16x8 pa2, bf16x8 pa3) {
#define TRRD(dst, off) asm volatile("ds_read_b64_tr_b16 %0, %1 offset:%2" : "=&v"(dst) : "v"(vb0), "i"(off) : "memory")
#define PV_D0(d0) do { s16x4 l0, l1, l2, l3, h0, h1, h2, h3; constexpr int b_ = VB * SHM_V + v_rd_off(d0, 0, 0); \
        TRRD(l0, b_); TRRD(h0, b_ + 2048); TRRD(l1, b_ + 4096); TRRD(h1, b_ + 6144); TRRD(l2, b_ + 8192); TRRD(h2, b_ + 10240); TRRD(l3, b_ + 12288); TRRD(h3, b_ + 14336); \
        asm volatile("s_waitcnt lgkmcnt(0)" ::: "memory"); SBAR(); \
        o[d0] = __builtin_amdgcn_mfma_f32_32x32x16_bf16(pa0, (bf16x8){l0[0], l0[1], l0[2], l0[3], h0[0], h0[1], h0[2], h0[3]}, o[d0], 0, 0, 0);   \
        o[d0] = __builtin_amdgcn_mfma_f32_32x32x16_bf16(pa1, (bf16x8){l1[0], l1[1], l1[2], l1[3], h1[0], h1[1], h1[2], h1[3]}, o[d0], 0, 0, 0);   \
        o[d0] = __builtin_amdgcn_mfma_f32_32x32x16_bf16(pa2, (bf16x8){l2[0], l2[1], l2[2], l2[3], h2[0], h2[1], h2[2], h2[3]}, o[d0], 0, 0, 0);   \
        o[d0] = __builtin_amdgcn_mfma_f32_32x32x16_bf16(pa3, (bf16x8){l3[0], l3[1], l3[2], l3[3], h3[0], h3[1], h3[2], h3[3]}, o[d0], 0, 0, 0); } while (0)
    PV_D0(0); PV_D0(1); PV_D0(2); PV_D0(3);
#undef PV_D0
#undef TRRD
}
template <int ND, int BIAS, bool CAUSAL>
__device__ __forceinline__ void attn_core(const bf16_t* Qw, int qp, const bf16_t* Kp, int kp, const bf16_t* Vp, int vp, int NT, int qlo, int ksub, float tslope,
                                          LAS char* lds, f32x16 (&o)[4], float& l_out) {
    const int tid = threadIdx.x, wid = __builtin_amdgcn_readfirstlane(tid >> 6), lane = tid & 63, r32 = lane & 31, hi = lane >> 5;
    LAS char* V_lds = lds; LAS char* K_lds = lds + K_OFF;
    LAS float* al_l = (LAS float*)(lds + WS_OFF) + wid * 64 + 32;
    LAS const float* biasL = (LAS const float*)(lds + BIAS_OFF) + 4 * hi;
    const int sr = tid >> 4, sc = (tid & 15) * 8, vst0 = v_st(sr, sc), vst1 = v_st(32 + sr, sc), kws = KSWZ(sr, sc * 2);
    const int vb0 = (int)(unsigned)(uintptr_t)V_lds + v_rd_base(lane);
    const int qm = qlo + r32 - 4 * hi;
    bf16x8 qr[ND];
#pragma unroll
    for (int d0 = 0; d0 < ND; ++d0) qr[d0] = *(const bf16x8*)(Qw + (size_t)r32 * qp + d0 * 16 + hi * 8);
    bf16x8 st_v0, st_v1, st_k0, st_k1;
#define SLOAD(k0) do { st_v0 = *(const bf16x8*)(Vp + (size_t)((k0) + sr) * vp + sc); st_v1 = *(const bf16x8*)(Vp + (size_t)((k0) + 32 + sr) * vp + sc); \
                       st_k0 = *(const bf16x8*)(Kp + (size_t)((k0) + sr) * kp + sc); st_k1 = *(const bf16x8*)(Kp + (size_t)((k0) + 32 + sr) * kp + sc); } while (0)
#define SWRITE(bf) do { *(LAS bf16x8*)(V_lds + (bf) * SHM_V + vst0) = st_v0; *(LAS bf16x8*)(V_lds + (bf) * SHM_V + vst1) = st_v1; \
                        *(LAS bf16x8*)(K_lds + (bf) * SHM_K + kws) = st_k0; *(LAS bf16x8*)(K_lds + (bf) * SHM_K + kws + 32 * 256) = st_k1; } while (0)
#define RESC(a) do { if (__any((a) < 1.f)) { if (hi == 0) al_l[r32] = (a); asm volatile("s_waitcnt lgkmcnt(0)" ::: "memory"); \
        _Pragma("unroll") for (int d_ = 0; d_ < 4; ++d_) _Pragma("unroll") for (int r = 0; r < 16; ++r) o[d_][r] *= al_l[crow(r, hi)]; } } while (0)
#define MASKT(P0_, P1_, t) do { if (CAUSAL) { const int kb_ = (t) * KVBLK; if (kb_ + KVBLK - 1 > qlo) mask_causal(P0_, P1_, qm - kb_); } } while (0)
#define BL(t) (biasL + (BIAS == 2 ? (t) * KVBLK : 0))
#define TOFF(t) (BIAS == 1 ? tslope * (float)(t) : 0.f)
    float m_reg = -1e30f, l_reg = 0.f;
#pragma unroll
    for (int d_ = 0; d_ < 4; ++d_) o[d_] = f32x16{};
    f32x16 pA0, pA1, pB0, pB1; float mnA, mnB, alA, alB; bf16x8 pa0, pa1, pa2, pa3;
    SLOAD(0); VM_WAIT(); SWRITE(0);
    __syncthreads();
    if (NT > 1) SLOAD(KVBLK);
    SBAR(); qkt<0, ND, BIAS>(pA0, pA1, K_lds, ksub, r32, hi, qr, BL(0));
    MASKT(pA0, pA1, 0); partialSM(pA0, pA1, m_reg, mnA, alA, TOFF(0));
    if (NT > 1) { VM_WAIT(); SWRITE(1); }
    __syncthreads();
#define HALF_STEP(PX0, PX1, mnX, alX, PY0, PY1, alY, t, KB, VB, SB) do {                                                      \
        SBAR(); qkt<KB, ND, BIAS>(PX0, PX1, K_lds, ksub, r32, hi, qr, BL(t));                                                 \
        finishSM(PY0, PY1, alY, l_reg, pa0, pa1, pa2, pa3); SBAR();                                                           \
        if ((t) + 1 < NT) { SLOAD(((t) + 1) * KVBLK); SBAR(); }                                                               \
        pv_tile<VB>(o, vb0, pa0, pa1, pa2, pa3); MASKT(PX0, PX1, (t)); partialSM(PX0, PX1, m_reg, mnX, alX, TOFF(t));         \
        __syncthreads();                                                                                                      \
        if ((t) + 1 < NT) { VM_WAIT(); SWRITE(SB); }                                                                          \
        RESC(alX); __syncthreads(); } while (0)
    for (int t = 1; t + 1 < NT; t += 2) {
        HALF_STEP(pB0, pB1, mnB, alB, pA0, pA1, alA, t, 1, 0, 0);
        HALF_STEP(pA0, pA1, mnA, alA, pB0, pB1, alB, t + 1, 0, 1, 1);
    }
    const bool even = (NT & 1) == 0;
    if (even) { SBAR(); qkt<1, ND, BIAS>(pB0, pB1, K_lds, ksub, r32, hi, qr, BL(NT - 1)); SBAR(); }
    finishSM(pA0, pA1, alA, l_reg, pa0, pa1, pa2, pa3); SBAR();
    pv_tile<0>(o, vb0, pa0, pa1, pa2, pa3);
    if (even) { MASKT(pB0, pB1, NT - 1); partialSM(pB0, pB1, m_reg, mnB, alB, TOFF(NT - 1)); __syncthreads(); RESC(alB);
        finishSM(pB0, pB1, alB, l_reg, pa0, pa1, pa2, pa3); SBAR(); pv_tile<1>(o, vb0, pa0, pa1, pa2, pa3); }
    l_out = l_reg;
#undef SLOAD
#undef SWRITE
#undef RESC
#undef MASKT
#undef BL
#undef TOFF
#undef HALF_STEP
}
__device__ __forceinline__ void store_rows_bf16(const f32x16 (&o)[4], float l_reg, bf16_t* Ow, int op, LAS char* lds) {
    const int tid = threadIdx.x, wid = __builtin_amdgcn_readfirstlane(tid >> 6), lane = tid & 63, r32 = lane & 31, hi = lane >> 5;
    LAS float* li_l = (LAS float*)(lds + WS_OFF) + wid * 64;
    if (hi == 0) li_l[r32] = l_reg;
    asm volatile("s_waitcnt lgkmcnt(0)" ::: "memory");
    float rli[16];
#pragma unroll
    for (int r = 0; r < 16; ++r) rli[r] = __builtin_amdgcn_rcpf(li_l[crow(r, hi)]);
    __syncthreads();
    LAS bf16_t* stg = (LAS bf16_t*)lds + wid * (32 * 136);
#pragma unroll
    for (int r = 0; r < 16; ++r) { const int orow = crow(r, hi);
#pragma unroll
        for (int d0 = 0; d0 < 4; ++d0) { const unsigned w = cvtpk(o[d0][r] * rli[r], 0.f); stg[orow * 136 + d0 * 32 + r32] = (bf16_t)(w & 0xffffu); } }
    asm volatile("s_waitcnt lgkmcnt(0)" ::: "memory");
#pragma unroll
    for (int i = 0; i < 8; ++i) { const int id = i * 64 + lane, row = id >> 4, ch = id & 15;
        const u32x4 v = *(LAS const u32x4*)(stg + row * 136 + ch * 8); *(u32x4*)(Ow + (size_t)row * op + ch * 8) = v; }
    asm volatile("s_waitcnt lgkmcnt(0)" ::: "memory");
    __syncthreads();
}
#undef KSWZ
#undef SBAR
}

typedef GAS unsigned gu32;
#define RLX_AGENT __ATOMIC_RELAXED, __HIP_MEMORY_SCOPE_AGENT
#define XB_TMO      128
#define XB_XCNT(j)  (256  + 64 * (j))
#define XB_XSUB(j)  (1280 + 64 * (j))
#define XB_XGEN(j)  (2304 + 64 * (j))
#define XB_TOP      3328
#define XB_TOPGEN   3392
#define XCD_BAR_WORDS 3456
#define XB_SPIN_CAP (1u << 18)
__device__ __forceinline__ unsigned xb_ld(unsigned* p)              { return __hip_atomic_load(p, __ATOMIC_RELAXED, __HIP_MEMORY_SCOPE_AGENT); }
__device__ __forceinline__ unsigned xb_add(unsigned* p, unsigned v) { return __hip_atomic_fetch_add(p, v, __ATOMIC_RELAXED, __HIP_MEMORY_SCOPE_AGENT); }
__device__ __forceinline__ unsigned xb_xcc_id() { return (unsigned)__builtin_amdgcn_s_getreg((3 << 11) | 20) & 0xFu; }
#define XB_SPIN(cond, bar) do { unsigned _sp = 0; while (cond) { __builtin_amdgcn_s_sleep(1); \
    if ((++_sp & 255u) == 0u) { if (xb_ld(&(bar)[XB_TMO])) break; if (_sp > XB_SPIN_CAP) { atomicAdd(&(bar)[XB_TMO], 1u); break; } } } } while (0)
struct XcdBarrier { unsigned* bar; unsigned x; volatile LAS unsigned* st; };
__device__ __forceinline__ XcdBarrier xcd_barrier_post(unsigned* bar, volatile LAS unsigned* st) {
    XcdBarrier b; b.bar = bar; b.x = xb_xcc_id(); b.st = st;
    if (threadIdx.x == 0) (void)xb_add(&bar[XB_XCNT(b.x)], 1u);
    return b;
}
__device__ __forceinline__ void xcd_barrier_complete(unsigned* bar, unsigned x, unsigned& nloc, unsigned& nx) {
    const unsigned G = gridDim.x * gridDim.y * gridDim.z;
    unsigned sum, cnt, mine, sp = 0u;
    for (;;) {
        sum = 0u; cnt = 0u; mine = 0u;
#pragma unroll
        for (unsigned j = 0; j < 16; ++j) { const unsigned c = xb_ld(&bar[XB_XCNT(j)]); sum += c; cnt += (c > 0u) ? 1u : 0u; mine = (j == x) ? c : mine; }
        if (sum == G) break;
        __builtin_amdgcn_s_sleep(1);
        if ((++sp & 255u) == 0u) { if (xb_ld(&bar[XB_TMO])) break; if (sp > XB_SPIN_CAP) { atomicAdd(&bar[XB_TMO], 1u); break; } }
    }
    nloc = mine > 0u ? mine : 1u; nx = cnt > 0u ? cnt : 1u;
}
__device__ __forceinline__ void xcd_barrier(const XcdBarrier& b) {
    asm volatile("s_waitcnt vmcnt(0)" ::: "memory");
    __syncthreads();
    if (threadIdx.x == 0) {
        unsigned* bar = b.bar;
        __builtin_amdgcn_s_waitcnt(0);
        unsigned nloc = b.st[0], nx = b.st[1];
        if (nloc == 0u) { xcd_barrier_complete(bar, b.x, nloc, nx); b.st[0] = nloc; b.st[1] = nx; }
        const unsigned old = xb_add(&bar[XB_XSUB(b.x)], 1u);
        const unsigned gen = old / nloc;
        if (old + 1u == (gen + 1u) * nloc) {
            __builtin_amdgcn_fence(__ATOMIC_RELEASE, "agent");
            asm volatile("s_waitcnt vmcnt(0)" ::: "memory");
            const unsigned og = xb_add(&bar[XB_TOP], 1u);
            const unsigned tg = og / nx;
            if (og + 1u == (tg + 1u) * nx) xb_add(&bar[XB_TOPGEN], 1u);
            else XB_SPIN(xb_ld(&bar[XB_TOPGEN]) == tg, bar);
            __builtin_amdgcn_fence(__ATOMIC_ACQUIRE, "agent");
            xb_add(&bar[XB_XGEN(b.x)], 1u);
            asm volatile("s_waitcnt vmcnt(0)" ::: "memory");
        } else {
            XB_SPIN(xb_ld(&bar[XB_XGEN(b.x)]) == gen, bar);
            __builtin_amdgcn_fence(__ATOMIC_ACQUIRE, "agent");
            asm volatile("s_waitcnt vmcnt(0)" ::: "memory");
        }
    }
    __syncthreads();
}

struct Args { const float* in[25]; float* out; unsigned char* ws; int ph_lo, ph_hi; };
struct Frame {
    LAS unsigned char* lds;
    int tid, lane, wave, vcu, G;
    unsigned char* ws;
};

__device__ __forceinline__ void p0_item(const float* W, int ldw, int src0, const float* g, bf16_t* dst, int K, int dst0, int nblk, LAS float* scr, int item, int lane) {
    const int kb = item / nblk, nb = item % nblk, k0 = 64 * kb;
    const int L = dst0 + 32 * nb, c = L & 255, rowbase = (L & ~255) + 128 * ((c >> 5) & 1) + 32 * (c >> 6);
    const float* src = W + (size_t)k0 * ldw + src0 + 32 * nb + (lane & 31);
#pragma unroll 8
    for (int i = 0; i < 32; ++i) { const int kk = 2 * i + (lane >> 5); float v = src[(size_t)kk * ldw]; if (g) v *= g[k0 + kk]; scr[kk * 33 + (lane & 31)] = v; }
    LDS_WAIT(); asm volatile("" ::: "memory");
    const int cc = lane & 7;
#pragma unroll
    for (int j = 0; j < 4; ++j) { const int n = (lane >> 3) + 8 * j; const LAS float* s = scr + (8 * cc) * 33 + n;
        u32x4 o; o.x = cvtpk(s[0 * 33], s[1 * 33]); o.y = cvtpk(s[2 * 33], s[3 * 33]); o.z = cvtpk(s[4 * 33], s[5 * 33]); o.w = cvtpk(s[6 * 33], s[7 * 33]);
        *(u32x4*)(dst + (size_t)(rowbase + n) * K + k0 + 8 * cc) = o; }
    LDS_WAIT(); asm volatile("" ::: "memory");
}
template <bool NORM> __device__ __forceinline__ void row_to_bf16(const float* xrow, bf16_t* orow, float* rstd_out, int lane) {
    const f32x4* xr = (const f32x4*)xrow + lane;
    f32x4 v[4]; float s = 0.f;
#pragma unroll
    for (int j = 0; j < 4; ++j) { v[j] = xr[64 * j]; s += (v[j].x * v[j].x + v[j].y * v[j].y) + (v[j].z * v[j].z + v[j].w * v[j].w); }
    const float rstd = 1.0f / sqrtf(wave_sum(s) * (1.0f / DM) + EPS);
    const float sc = NORM ? rstd : 1.f;
    u32x2* o8 = (u32x2*)orow + lane;
#pragma unroll
    for (int j = 0; j < 4; ++j) { u32x2 w; w.x = cvtpk(v[j].x * sc, v[j].y * sc); w.y = cvtpk(v[j].z * sc, v[j].w * sc); o8[64 * j] = w; }
    if (rstd_out && lane == 0) *rstd_out = rstd;
}

__global__ void __launch_bounds__(512, 2) hybrid_fwd(Args args) {
    extern __shared__ __attribute__((aligned(16))) unsigned char lds_raw[];
    Frame F;
    F.lds = (LAS unsigned char*)lds_raw;
    F.tid = threadIdx.x; F.lane = F.tid & 63; F.wave = __builtin_amdgcn_readfirstlane(F.tid >> 6);
    F.G = gridDim.x; { const int bx = blockIdx.x; F.vcu = (F.G % 8 == 0) ? (bx % 8) * (F.G / 8) + bx / 8 : bx; }
    F.ws = args.ws;
    unsigned char* ws = args.ws;
    volatile LAS unsigned* MISC = (volatile LAS unsigned*)(F.lds + MISC_OFF);
    for (int u = F.tid; u < (LDS_BYTES - LDSCTL_OFF) / 4; u += 512) ((LAS unsigned*)(F.lds + LDSCTL_OFF))[u] = 0u;
    __syncthreads();
    unsigned* ctl = (unsigned*)(ws + WS_CTL);
    XcdBarrier bar; bar.bar = ctl + CW_BAR; bar.x = 0; bar.st = nullptr;
    if (MK_N_LAUNCHES == 1) bar = xcd_barrier_post(ctl + CW_BAR, MISC + 8);
    const int lo = args.ph_lo, hi_ph = args.ph_hi;
#ifndef PHASE_MASK
#define PHASE_MASK 0x1ff
#endif
#define IN(k) (((PHASE_MASK >> (k)) & 1) && lo <= (k) && (k) < hi_ph)
#define SEAM(k) do { if (MK_N_LAUNCHES == 1 && IN(k) && IN((k) + 1)) xcd_barrier(bar); } while (0)

    const float* x = args.in[0]; const float* mem = args.in[1];
    bf16_t* xb = (bf16_t*)args.out;
    float* hout = args.out;
    float* rstd0 = (float*)(ws + WS_RSTD0); float* ssq1 = (float*)(ws + WS_SSQ1); float* WF = (float*)(ws + WS_WF); float* LF = (float*)(ws + WS_LF);
    bf16_t *WA_e = (bf16_t*)(ws + WS_WA_E), *WG_e = (bf16_t*)(ws + WS_WG_E), *WO_e = (bf16_t*)(ws + WS_WO_E), *WM_e = (bf16_t*)(ws + WS_WM_E);
    bf16_t *WA_o = (bf16_t*)(ws + WS_WA_O), *WG_o = (bf16_t*)(ws + WS_WG_O), *WO_o = (bf16_t*)(ws + WS_WO_O), *WM_o = (bf16_t*)(ws + WS_WM_O);
    bf16_t *memn = (bf16_t*)(ws + WS_MEMN), *MK_e = (bf16_t*)(ws + WS_MK_E), *MV_e = (bf16_t*)(ws + WS_MV_E), *MK_o = (bf16_t*)(ws + WS_MK_O), *MV_o = (bf16_t*)(ws + WS_MV_O);
    bf16_t *Y = (bf16_t*)(ws + WS_Y), *R1 = (bf16_t*)(ws + WS_R1), *R2 = (bf16_t*)(ws + WS_R2), *R3 = (bf16_t*)(ws + WS_R3), *BB = (bf16_t*)(ws + WS_BB);
    LAS float* xch = (LAS float*)(F.lds + XCH_OFF);
    LAS char* alds = (LAS char*)F.lds;

    if (IN(0)) {
        LAS float* scr = (LAS float*)(F.lds + F.wave * 16384);
        const int gw = F.vcu * 8 + F.wave, NGW = F.G * 8;
        for (int it = gw; it < 10240; it += NGW) {
            int r = it;
            if (r < 16 * 96) { p0_item(args.in[3], 7168, 0, args.in[2], WA_e, 1024, 0, 96, scr, r, F.lane); continue; } r -= 16 * 96;
            if (r < 16 * 48) { p0_item(args.in[3], 7168, 4096, args.in[2], WA_e, 1024, 3072, 48, scr, r, F.lane); continue; } r -= 16 * 48;
            if (r < 16 * 16) { p0_item(args.in[3], 7168, 6144, args.in[2], WA_e, 1024, 4608, 16, scr, r, F.lane); continue; } r -= 16 * 16;
            if (r < 16 * 32) { p0_item(args.in[3], 7168, 3072, args.in[2], WG_e, 1024, 0, 32, scr, r, F.lane); continue; } r -= 16 * 32;
            if (r < 16 * 16) { p0_item(args.in[3], 7168, 5632, args.in[2], WG_e, 1024, 1024, 16, scr, r, F.lane); continue; } r -= 16 * 16;
            if (r < 16 * 16) { p0_item(args.in[3], 7168, 6656, args.in[2], WG_e, 1024, 1536, 16, scr, r, F.lane); continue; } r -= 16 * 16;
            if (r < 32 * 32) { p0_item(args.in[4], 1024, 0, nullptr, WO_e, 2048, 0, 32, scr, r, F.lane); continue; } r -= 32 * 32;
            if (r < 16 * 32) { p0_item(args.in[14], 1024, 0, args.in[13], WM_e, 1024, 0, 32, scr, r, F.lane); continue; } r -= 16 * 32;
            if (r < 16 * 144) { p0_item(args.in[16], 7180, 0, args.in[15], WA_o, 1024, 0, 144, scr, r, F.lane); continue; } r -= 16 * 144;
            if (r < 16 * 16) { p0_item(args.in[16], 7180, 6156, args.in[15], WA_o, 1024, 4608, 16, scr, r, F.lane); continue; } r -= 16 * 16;
            if (r < 16 * 48) { p0_item(args.in[16], 7180, 4608, args.in[15], WG_o, 1024, 0, 48, scr, r, F.lane); continue; } r -= 16 * 48;
            if (r < 16 * 16) { p0_item(args.in[16], 7180, 6668, args.in[15], WG_o, 1024, 1536, 16, scr, r, F.lane); continue; } r -= 16 * 16;
            if (r < 32 * 32) { p0_item(args.in[17], 1024, 0, nullptr, WO_o, 2048, 0, 32, scr, r, F.lane); continue; } r -= 32 * 32;
            p0_item(args.in[24], 1024, 0, args.in[23], WM_o, 1024, 0, 32, scr, r, F.lane);
        }
        for (int m = gw; m < M; m += NGW) row_to_bf16<false>(x + (size_t)m * DM, xb + (size_t)m * DM, rstd0 + m, F.lane);
        for (int m = gw; m < MM; m += NGW) row_to_bf16<true>(mem + (size_t)m * DM, memn + (size_t)m * DM, nullptr, F.lane);
        for (int i = (F.vcu * 512 + F.tid); i < 12 * 1024; i += F.G * 512) { const int c = i >> 10, k = i & 1023; WF[i] = args.in[15][k] * args.in[16][(size_t)k * 7180 + 6144 + c]; }
    }
    SEAM(0);

    if (IN(1)) {
        { pg8::Gemm g{xb, WA_e, M, 5120, DM}; pg8::StaticOrder S; S.init(M, 5120, F.G, (int)blockIdx.x);
          pg8::EpiProj E{0, rstd0, nullptr, Y, R1, R2, R3, BB, nullptr, nullptr, args.in[5], args.in[6], args.in[11], nullptr, xch};
          pg8::gemm_phase<pg8::EpiProj, pg8::StaticOrder, true>(F.lds, g, S, E); }
        { pg8::Gemm g{memn, WM_e, MM, 1024, DM}; pg8::StaticOrder S; S.init(MM, 1024, F.G, (int)blockIdx.x);
          pg8::EpiProj E{2, nullptr, nullptr, nullptr, nullptr, nullptr, nullptr, nullptr, MK_e, MV_e, nullptr, nullptr, nullptr, args.in[12], xch};
          pg8::gemm_phase<pg8::EpiProj, pg8::StaticOrder, true>(F.lds, g, S, E); }
        { pg8::Gemm g{memn, WM_o, MM, 1024, DM}; pg8::StaticOrder S; S.init(MM, 1024, F.G, (int)((blockIdx.x + F.G - 32) % F.G));
          pg8::EpiProj E{3, nullptr, nullptr, nullptr, nullptr, nullptr, nullptr, nullptr, MK_o, MV_o, nullptr, nullptr, nullptr, args.in[22], xch};
          pg8::gemm_phase<pg8::EpiProj, pg8::StaticOrder, true>(F.lds, g, S, E); }
    }
    SEAM(1);

    if (IN(2)) {
        const int r32 = F.lane & 31, hi = F.lane >> 5;
        float lam;
        { const float* lp = args.in[7]; const float a = wave_sum(lp[F.lane] * lp[64 + F.lane]), b = wave_sum(lp[128 + F.lane] * lp[192 + F.lane]); lam = expf(a) - expf(b) + LAM_INIT; }
        for (int v = F.vcu; v < 256; v += F.G) {
            if (P2_PARTS & 1) { const int b = v >> 5, hd = (v >> 3) & 3, qb = v & 7;
              bf16_t* Qw = Y + (size_t)(b * SEQ + qb * 256 + F.wave * 32) * 2048 + 1536 + 128 * hd;
              f32x16 o[4]; float l;
              att::attn_core<8, 0, false>(Qw, 2048, MK_e + (size_t)(b * MEML) * 512 + 128 * hd, 512, MV_e + (size_t)(b * MEML) * 512 + 128 * hd, 512, 4, 0, 0, 0.f, alds, o, l);
              att::store_rows_bf16(o, l, Qw, 2048, alds); }
        }
        asm volatile("" ::: "memory");
        for (int v = F.vcu; v < 256; v += F.G) {
            if (P2_PARTS & 2) { const int bh = v >> 2, s = v & 3, b = bh >> 3, h = bh & 7, sub = F.wave >> 2, w4 = F.wave & 3;
              const float cslope = exp2f(-(float)(h + 1)) * LOG2E;
              for (int i = 0; i < 4; ++i) {
                  const int qb = (i == 0) ? 2 * s : (i == 1) ? 2 * s + 1 : (i == 2) ? 15 - 2 * s : 14 - 2 * s;
                  if (F.tid < 64) ((LAS float*)(alds + att::BIAS_OFF))[F.tid] = cslope * (float)F.tid;
                  const size_t row0 = (size_t)b * SEQ + qb * 128;
                  bf16_t* Qw = Y + (row0 + w4 * 32) * 2048 + 128 * h + 64 * sub;
                  f32x16 o[4]; float l;
                  att::attn_core<4, 1, true>(Qw, 2048, R1 + (size_t)(b * SEQ) * 1024 + 128 * h, 1024, R2 + (size_t)(b * SEQ) * 1024 + 128 * h, 1024,
                                             2 * (qb + 1), qb * 128 + w4 * 32, 128 * sub, cslope * 64.f, alds, o, l);
                  LAS float* li_l = (LAS float*)(alds + att::WS_OFF) + F.wave * 64;
                  if (hi == 0) li_l[r32] = l;
                  LDS_WAIT();
                  float rli[16];
#pragma unroll
                  for (int r = 0; r < 16; ++r) rli[r] = __builtin_amdgcn_rcpf(li_l[att::crow(r, hi)]);
                  __syncthreads();
                  LAS float* X = (LAS float*)alds + w4 * (32 * 132);
                  if (sub == 1) {
#pragma unroll
                      for (int r = 0; r < 16; ++r) { const int orow = att::crow(r, hi); const float f = rli[r] * lam;
#pragma unroll
                          for (int d0 = 0; d0 < 4; ++d0) X[orow * 132 + d0 * 32 + r32] = o[d0][r] * f; }
                  }
                  LDS_WAIT(); __syncthreads();
                  if (sub == 0) {
#pragma unroll
                      for (int r = 0; r < 16; ++r) { const int orow = att::crow(r, hi);
#pragma unroll
                          for (int d0 = 0; d0 < 4; ++d0) { const float t = o[d0][r] * rli[r] - X[orow * 132 + d0 * 32 + r32]; X[orow * 132 + d0 * 32 + r32] = t; } }
                      LDS_WAIT();
                      const LAS float* xr = X + r32 * 132 + hi * 64;
                      float ssum = 0.f;
#pragma unroll
                      for (int c = 0; c < 16; ++c) { const f32x4 t = *(const LAS f32x4*)(xr + 4 * c); ssum += (t[0] * t[0] + t[1] * t[1]) + (t[2] * t[2] + t[3] * t[3]); }
                      ssum += __shfl_xor(ssum, 32);
                      const float rn = (1.0f - LAM_INIT) / sqrtf(ssum * (1.0f / 128.0f) + EPS);
                      const float* og = args.in[8] + hi * 64;
                      bf16_t* orow = Y + (row0 + w4 * 32 + r32) * 2048 + 128 * h + hi * 64;
#pragma unroll
                      for (int c = 0; c < 8; ++c) { const f32x4 t0 = *(const LAS f32x4*)(xr + 8 * c), t1 = *(const LAS f32x4*)(xr + 8 * c + 4);
                          const f32x4 g0 = *(const f32x4*)(og + 8 * c), g1 = *(const f32x4*)(og + 8 * c + 4);
                          u32x4 w; w.x = cvtpk(t0[0] * rn * g0[0], t0[1] * rn * g0[1]); w.y = cvtpk(t0[2] * rn * g0[2], t0[3] * rn * g0[3]);
                          w.z = cvtpk(t1[0] * rn * g1[0], t1[1] * rn * g1[1]); w.w = cvtpk(t1[2] * rn * g1[2], t1[3] * rn * g1[3]);
                          *(u32x4*)(orow + 8 * c) = w; }
                  }
                  LDS_WAIT(); __syncthreads();
              } }
        }
        asm volatile("" ::: "memory");
        for (int v = F.vcu; v < 256; v += F.G) {
            if (P2_PARTS & 4) { const int ch = (F.tid & 63) * 8, t0 = 64 * v + 8 * (F.tid >> 6);
              const float* cw = args.in[9]; const float* cbp = args.in[10];
              float w0[8], w1[8], w2[8], bsv[8], um2[8], um1[8];
#pragma unroll
              for (int j = 0; j < 8; ++j) { w0[j] = cw[ch + j]; w1[j] = cw[512 + ch + j]; w2[j] = cw[1024 + ch + j]; bsv[j] = cbp[ch + j]; um2[j] = 0.f; um1[j] = 0.f; }
              if ((t0 & (SEQ - 1)) != 0) {
                  const u32x4 h2 = *(const u32x4*)(R3 + (size_t)(t0 - 2) * 1024 + ch), c2 = *(const u32x4*)(R3 + (size_t)(t0 - 2) * 1024 + 512 + ch);
                  const u32x4 h1 = *(const u32x4*)(R3 + (size_t)(t0 - 1) * 1024 + ch), c1 = *(const u32x4*)(R3 + (size_t)(t0 - 1) * 1024 + 512 + ch);
                  um2[0] = bf_lo(h2.x) * bf_lo(c2.x); um2[1] = bf_hi(h2.x) * bf_hi(c2.x); um2[2] = bf_lo(h2.y) * bf_lo(c2.y); um2[3] = bf_hi(h2.y) * bf_hi(c2.y);
                  um2[4] = bf_lo(h2.z) * bf_lo(c2.z); um2[5] = bf_hi(h2.z) * bf_hi(c2.z); um2[6] = bf_lo(h2.w) * bf_lo(c2.w); um2[7] = bf_hi(h2.w) * bf_hi(c2.w);
                  um1[0] = bf_lo(h1.x) * bf_lo(c1.x); um1[1] = bf_hi(h1.x) * bf_hi(c1.x); um1[2] = bf_lo(h1.y) * bf_lo(c1.y); um1[3] = bf_hi(h1.y) * bf_hi(c1.y);
                  um1[4] = bf_lo(h1.z) * bf_lo(c1.z); um1[5] = bf_hi(h1.z) * bf_hi(c1.z); um1[6] = bf_lo(h1.w) * bf_lo(c1.w); um1[7] = bf_hi(h1.w) * bf_hi(c1.w);
              }
              for (int rr = 0; rr < 8; ++rr) { const size_t t = (size_t)(t0 + rr);
                  const u32x4 hh = *(const u32x4*)(R3 + t * 1024 + ch), cc = *(const u32x4*)(R3 + t * 1024 + 512 + ch), bb = *(const u32x4*)(BB + t * 512 + ch);
                  float u0[8], bv[8], yv[8];
                  u0[0] = bf_lo(hh.x) * bf_lo(cc.x); u0[1] = bf_hi(hh.x) * bf_hi(cc.x); u0[2] = bf_lo(hh.y) * bf_lo(cc.y); u0[3] = bf_hi(hh.y) * bf_hi(cc.y);
                  u0[4] = bf_lo(hh.z) * bf_lo(cc.z); u0[5] = bf_hi(hh.z) * bf_hi(cc.z); u0[6] = bf_lo(hh.w) * bf_lo(cc.w); u0[7] = bf_hi(hh.w) * bf_hi(cc.w);
                  bv[0] = bf_lo(bb.x); bv[1] = bf_hi(bb.x); bv[2] = bf_lo(bb.y); bv[3] = bf_hi(bb.y); bv[4] = bf_lo(bb.z); bv[5] = bf_hi(bb.z); bv[6] = bf_lo(bb.w); bv[7] = bf_hi(bb.w);
#pragma unroll
                  for (int j = 0; j < 8; ++j) { yv[j] = bv[j] * (w0[j] * um2[j] + w1[j] * um1[j] + w2[j] * u0[j] + bsv[j]); um2[j] = um1[j]; um1[j] = u0[j]; }
                  u32x4 w; w.x = cvtpk(yv[0], yv[1]); w.y = cvtpk(yv[2], yv[3]); w.z = cvtpk(yv[4], yv[5]); w.w = cvtpk(yv[6], yv[7]);
                  *(u32x4*)(Y + t * 2048 + 1024 + ch) = w; } }
        }
    }
    SEAM(2);

    if (IN(3)) {
        pg8::Gemm g{xb, WG_e, M, 2048, DM}; pg8::StaticOrder S; S.init(M, 2048, F.G, (int)blockIdx.x);
        pg8::EpiGate E{0, rstd0, nullptr, Y};
        pg8::gemm_phase<pg8::EpiGate, pg8::StaticOrder, true>(F.lds, g, S, E);
    }
    SEAM(3);

    if (IN(4)) {
        pg8::Gemm g{Y, WO_e, M, DM, 2048}; pg8::StaticOrder S; S.init(M, DM, F.G, (int)blockIdx.x);
        pg8::EpiOut<true> E{x, hout, R3, ssq1};
        pg8::gemm_phase<pg8::EpiOut<true>, pg8::StaticOrder, true>(F.lds, g, S, E);
    }
    SEAM(4);

    if (IN(5)) {
        for (int v = F.vcu; v < 256; v += F.G) {
            const int rowb = 64 * v + 8 * F.wave;
            f32x4 hv[8][4]; float rs[8];
#pragma unroll
            for (int r = 0; r < 8; ++r) { const f32x4* hr = (const f32x4*)(hout + (size_t)(rowb + r) * DM) + F.lane; float s = 0.f;
#pragma unroll
                for (int j = 0; j < 4; ++j) { hv[r][j] = hr[64 * j]; s += (hv[r][j].x * hv[r][j].x + hv[r][j].y * hv[r][j].y) + (hv[r][j].z * hv[r][j].z + hv[r][j].w * hv[r][j].w); }
                rs[r] = 1.0f / sqrtf(wave_sum(s) * (1.0f / DM) + EPS); }
            for (int c = 0; c < 12; ++c) {
                const f32x4* wr_ = (const f32x4*)(WF + (size_t)c * DM) + F.lane; f32x4 wv[4];
#pragma unroll
                for (int j = 0; j < 4; ++j) wv[j] = wr_[64 * j];
                const float fb = args.in[20][c];
#pragma unroll
                for (int r = 0; r < 8; ++r) { float d = 0.f;
#pragma unroll
                    for (int j = 0; j < 4; ++j) d += (hv[r][j].x * wv[j].x + hv[r][j].y * wv[j].y) + (hv[r][j].z * wv[j].z + hv[r][j].w * wv[j].w);
                    d = wave_sum(d);
                    const float f = d * rs[r] + fb;
                    const float ls = fminf(f, 0.f) - log1pf(expf(-fabsf(f)));
                    if (F.lane == 0) LF[(size_t)(rowb + r) * 12 + c] = ls; }
            }
        }
        pg8::Gemm g{R3, WA_o, M, 5120, DM}; pg8::StaticOrder S; S.init(M, 5120, F.G, (int)blockIdx.x);
        pg8::EpiProj E{1, nullptr, ssq1, Y, R1, R2, nullptr, nullptr, nullptr, nullptr, args.in[18], args.in[19], args.in[21], nullptr, xch};
        pg8::gemm_phase<pg8::EpiProj, pg8::StaticOrder, true>(F.lds, g, S, E);
    }
    SEAM(5);

    if (IN(6)) {
        static constexpr unsigned char FOXTAB[8][8] = {
            {2, 32, 24, 0, 0, 0, 0, 0}, {2, 33, 25, 0, 0, 0, 0, 0}, {2, 34, 20, 0, 0, 0, 0, 0}, {2, 28, 29, 0, 0, 0, 0, 0},
            {2, 30, 26, 0, 0, 0, 0, 0}, {3, 21, 22, 16, 0, 0, 0, 0}, {4, 17, 18, 12, 8, 0, 0, 0}, {7, 13, 14, 9, 10, 4, 5, 6}};
        for (int v = F.vcu; v < 256; v += F.G) {
            { const int b = v >> 5, hd = (v >> 3) & 3, qb = v & 7;
              bf16_t* Qw = Y + (size_t)(b * SEQ + qb * 256 + F.wave * 32) * 2048 + 1536 + 128 * hd;
              f32x16 o[4]; float l;
              att::attn_core<8, 0, false>(Qw, 2048, MK_o + (size_t)(b * MEML) * 512 + 128 * hd, 512, MV_o + (size_t)(b * MEML) * 512 + 128 * hd, 512, 4, 0, 0, 0.f, alds, o, l);
              att::store_rows_bf16(o, l, Qw, 2048, alds); }
        }
        asm volatile("" ::: "memory");
        for (int v = F.vcu; v < 256; v += F.G) {
            const int grp = v >> 3, slot = v & 7, nun = FOXTAB[slot][0];
            for (int i = 0; i < nun; ++i) {
                const int code = FOXTAB[slot][1 + i], qb = (code >> 2) - 1, bh = 3 * grp + (code & 3), b = bh / 12, h = bh % 12;
                { const int n = 256 * (qb + 1), t0 = 4 * F.tid; float v0 = 0.f, v1 = 0.f, v2 = 0.f, v3 = 0.f;
                  if (t0 < n) { const float* lf = LF + ((size_t)b * SEQ + t0) * 12 + h; v0 = lf[0]; v1 = lf[12]; v2 = lf[24]; v3 = lf[36]; }
                  const float s1 = v0, s2 = s1 + v1, s3 = s2 + v2, s4 = s3 + v3;
                  float xs = s4;
#pragma unroll
                  for (int off = 1; off < 64; off <<= 1) { const float t = __shfl_up(xs, off); if (F.lane >= off) xs += t; }
                  LAS float* wtot = (LAS float*)(alds + att::SCAN_OFF);
                  if (F.lane == 63) wtot[F.wave] = xs;
                  LDS_WAIT(); __syncthreads();
                  float pre = 0.f;
#pragma unroll
                  for (int w = 0; w < 8; ++w) { const float t = wtot[w]; if (w < F.wave) pre += t; }
                  const float ex = pre + (xs - s4);
                  if (t0 < n) { LAS float* bl = (LAS float*)(alds + att::BIAS_OFF) + t0;
                      *(LAS f32x4*)bl = (f32x4){-(ex + s1) * LOG2E, -(ex + s2) * LOG2E, -(ex + s3) * LOG2E, -(ex + s4) * LOG2E}; }
                }
                bf16_t* Qw = Y + (size_t)(b * SEQ + qb * 256 + F.wave * 32) * 2048 + 128 * h;
                f32x16 o[4]; float l;
                att::attn_core<8, 2, true>(Qw, 2048, R1 + (size_t)(b * SEQ) * 1536 + 128 * h, 1536, R2 + (size_t)(b * SEQ) * 1536 + 128 * h, 1536,
                                           4 * (qb + 1), qb * 256 + F.wave * 32, 0, 0.f, alds, o, l);
                att::store_rows_bf16(o, l, Qw, 2048, alds);
            }
        }
    }
    SEAM(6);

    if (IN(7)) {
        pg8::Gemm g{R3, WG_o, M, 2048, DM}; pg8::StaticOrder S; S.init(M, 2048, F.G, (int)blockIdx.x);
        pg8::EpiGate E{1, nullptr, ssq1, Y};
        pg8::gemm_phase<pg8::EpiGate, pg8::StaticOrder, true>(F.lds, g, S, E);
    }
    SEAM(7);

    if (IN(8)) {
        pg8::Gemm g{Y, WO_o, M, DM, 2048}; pg8::StaticOrder S; S.init(M, DM, F.G, (int)blockIdx.x);
        pg8::EpiOut<false> E{hout, hout, nullptr, nullptr};
        pg8::gemm_phase<pg8::EpiOut<false>, pg8::StaticOrder, true>(F.lds, g, S, E);
    }
#undef IN
#undef SEAM
}

extern "C" void kernel_launch(void* const* d_in, const int* in_sizes, int n_in, void* d_out, int out_size, void* d_ws, size_t ws_size, hipStream_t stream) {
    static int grid = 0;
    if (grid == 0) {
        if (n_in != 25 || in_sizes[0] != M * DM || out_size != M * DM || ws_size < WS_END) {
            fprintf(stderr, "kernel_launch: unexpected shapes (n_in %d, in0 %d, out %d, ws %zu); nothing launched\n", n_in, n_in > 0 ? in_sizes[0] : -1, out_size, ws_size); grid = -1; return; }
        int dev = 0, cus = 0, per_cu = 0;
        if (hipGetDevice(&dev) != hipSuccess || hipDeviceGetAttribute(&cus, hipDeviceAttributeMultiprocessorCount, dev) != hipSuccess) { fprintf(stderr, "kernel_launch: device query failed\n"); grid = -1; return; }
        if (hipFuncSetAttribute((const void*)hybrid_fwd, hipFuncAttributeMaxDynamicSharedMemorySize, LDS_BYTES) != hipSuccess) { fprintf(stderr, "kernel_launch: hipFuncSetAttribute failed\n"); grid = -1; return; }
        if (hipOccupancyMaxActiveBlocksPerMultiprocessor(&per_cu, (const void*)hybrid_fwd, 512, LDS_BYTES) != hipSuccess || per_cu < 1) {
            fprintf(stderr, "kernel_launch: occupancy query reports %d workgroups per CU\n", per_cu); per_cu = 1; }
        (void)hipGetLastError();
        grid = cus;
        if (grid > 256) grid = 256;
    }
    if (grid < 0) return;
    if (hipMemsetAsync((char*)d_ws + WS_CTL, 0, CTL_ZERO_BYTES, stream) != hipSuccess) { fprintf(stderr, "kernel_launch: memset failed\n"); return; }
    Args a{};
    for (int i = 0; i < 25; ++i) a.in[i] = (const float*)d_in[i];
    a.out = (float*)d_out; a.ws = (unsigned char*)d_ws;
    if (MK_N_LAUNCHES == 1) { a.ph_lo = 0; a.ph_hi = 9; hipLaunchKernelGGL(hybrid_fwd, dim3(grid), dim3(512), LDS_BYTES, stream, a); }
    else { for (int p = 0; p < 9; ++p) { a.ph_lo = p; a.ph_hi = p + 1; hipLaunchKernelGGL(hybrid_fwd, dim3(grid), dim3(512), LDS_BYTES, stream, a); } }
    const hipError_t le = hipPeekAtLastError();
    if (le != hipSuccess) fprintf(stderr, "kernel_launch: launch failed: %s\n", hipGetErrorName(le));
}
```

```cpp
#include <hip/hip_runtime.h>
#include <cstdio>
#include <cstdint>

#ifndef PROBE_A
#define PROBE_A -1
#define PROBE_B -1
#endif
#ifndef ZSKIP
#define ZSKIP 30.0f
#endif
#ifndef FOX_SKIP
#define FOX_SKIP 1
#endif
#ifndef DRY_MODE
#define DRY_MODE 1
#endif
#ifndef STAGGER_TICKS
#define STAGGER_TICKS 0
#endif
#ifndef DUP_MASK
#define DUP_MASK 0
#endif
#ifndef P2_PARTS
#define P2_PARTS 15
#endif
#ifndef MK_N_LAUNCHES
#define MK_N_LAUNCHES 1
#endif

#define LAS __attribute__((address_space(3)))
#define GAS __attribute__((address_space(1)))
typedef unsigned short bf16_t;
typedef short bf16x8 __attribute__((ext_vector_type(8)));
typedef short s16x4 __attribute__((ext_vector_type(4)));
typedef float f32x4 __attribute__((ext_vector_type(4)));
typedef float f32x2 __attribute__((ext_vector_type(2)));
typedef float f32x16 __attribute__((ext_vector_type(16)));
typedef unsigned u32x4 __attribute__((ext_vector_type(4)));
typedef unsigned u32x2 __attribute__((ext_vector_type(2)));
typedef __bf16 bf16x2_t __attribute__((ext_vector_type(2)));

constexpr int BATCH = 8, SEQ = 2048, DM = 1024, M = BATCH * SEQ;
constexpr int MEML = 256, MM = BATCH * MEML;
constexpr float EPS = 1e-6f;
constexpr float LOG2E = 1.4426950408889634f;
constexpr float C2_64 = 0.125f * LOG2E;
constexpr float C2_128 = 0.08838834764831845f * LOG2E;
constexpr float LAM_INIT = 0.2f;

constexpr size_t MiB = 1u << 20;
constexpr size_t WS_CTL = 0, CTL_ZERO_BYTES = 1 * MiB;
constexpr size_t WS_SSQ1 = 512 * 1024;
constexpr size_t WS_RSTD0 = 1 * MiB;
constexpr size_t WS_WF = 1 * MiB + 256 * 1024;
constexpr size_t WS_LF = 2 * MiB;
constexpr size_t WS_WA_E = 3 * MiB, WS_WG_E = 13 * MiB, WS_WO_E = 17 * MiB, WS_WM_E = 21 * MiB;
constexpr size_t WS_WA_O = 3 * MiB, WS_WG_O = 13 * MiB, WS_WO_O = 17 * MiB, WS_WM_O = 41 * MiB;
constexpr size_t WS_MEMN = 43 * MiB;
constexpr size_t WS_MK_E = 47 * MiB, WS_MV_E = 49 * MiB, WS_MK_O = 51 * MiB, WS_MV_O = 53 * MiB;
constexpr size_t WS_Y = 56 * MiB, WS_R1 = 120 * MiB, WS_R2 = 168 * MiB, WS_R3 = 216 * MiB, WS_END = 248 * MiB;
constexpr size_t WS_BB = WS_R1 + 32 * MiB;
constexpr int CW_BAR = 4096, CW_Q2 = 8192, CW_Q6 = 8448, CW_MKV = 8704;

constexpr int RING_BYTES = 131072;
constexpr int LDSCTL_OFF = RING_BYTES, MISC_OFF = LDSCTL_OFF + 320, XCH_OFF = LDSCTL_OFF + 1024;
constexpr int GAIN_OFF = XCH_OFF + 4096;
constexpr int LDS_BYTES = 147456;

__device__ __forceinline__ unsigned cvtpk(float lo, float hi) { f32x2 v = {lo, hi}; bf16x2_t b = __builtin_convertvector(v, bf16x2_t); return __builtin_bit_cast(unsigned, b); }
__device__ __forceinline__ float bf_lo(unsigned w) { return __builtin_bit_cast(float, w << 16); }
__device__ __forceinline__ float bf_hi(unsigned w) { return __builtin_bit_cast(float, w & 0xffff0000u); }
__device__ __forceinline__ float wave_sum(float v) {
#pragma unroll
    for (int o = 1; o < 64; o <<= 1) v += __shfl_xor(v, o);
    return v;
}
template <int CTRL> __device__ __forceinline__ float dpp_mov(float v) { return __builtin_bit_cast(float, __builtin_amdgcn_update_dpp(0, __builtin_bit_cast(int, v), CTRL, 0xF, 0xF, true)); }
__device__ __forceinline__ float reduce8(const float (&d)[8], int lane) {
    float y[4];
#pragma unroll
    for (int i = 0; i < 4; ++i) { auto rr = __builtin_amdgcn_permlane32_swap(__float_as_uint(d[i]), __float_as_uint(d[i + 4]), false, false); y[i] = __uint_as_float(rr[0]) + __uint_as_float(rr[1]); }
    const bool b4 = (lane & 16) != 0, b3 = (lane & 8) != 0;
    float snd[2], kp[2], z[2];
#pragma unroll
    for (int j = 0; j < 2; ++j) { snd[j] = b4 ? y[j] : y[j + 2]; kp[j] = b4 ? y[j + 2] : y[j]; }
#pragma unroll
    for (int j = 0; j < 2; ++j) snd[j] = __shfl_xor(snd[j], 16);
#pragma unroll
    for (int j = 0; j < 2; ++j) z[j] = kp[j] + snd[j];
    const float s3 = b3 ? z[0] : z[1], k3 = b3 ? z[1] : z[0];
    float w = k3 + dpp_mov<0x128>(s3);
    w += dpp_mov<0xB1>(w); w += dpp_mov<0x4E>(w); w += dpp_mov<0x141>(w);
    return w;
}
#ifndef WT_STORES
#define WT_STORES 0
#endif
__device__ __forceinline__ void st16(void* p, u32x4 v) {
#if WT_STORES
    asm volatile("global_store_dwordx4 %0, %1, off sc1\n\ts_nop 1" :: "v"(p), "v"(v) : "memory");
#else
    *(u32x4*)p = v;
#endif
}
#ifndef EPI_TR
#define EPI_TR 1
#endif
__device__ __forceinline__ int tr_src4(int lane) { return 4 * ((lane >> 2) + 16 * (lane & 3)); }
__device__ __forceinline__ u32x4 lane_tr(u32x4 w, int src4) {
    w.x = (unsigned)__builtin_amdgcn_ds_bpermute(src4, (int)w.x); w.y = (unsigned)__builtin_amdgcn_ds_bpermute(src4, (int)w.y);
    w.z = (unsigned)__builtin_amdgcn_ds_bpermute(src4, (int)w.z); w.w = (unsigned)__builtin_amdgcn_ds_bpermute(src4, (int)w.w); return w; }
__device__ __forceinline__ u32x2 lane_tr(u32x2 w, int src4) {
    w.x = (unsigned)__builtin_amdgcn_ds_bpermute(src4, (int)w.x); w.y = (unsigned)__builtin_amdgcn_ds_bpermute(src4, (int)w.y); return w; }
#define LDS_WAIT() asm volatile("s_waitcnt lgkmcnt(0)" ::: "memory")
#define VM_WAIT() asm volatile("s_waitcnt vmcnt(0)" ::: "memory")

namespace pg8 {
constexpr int BM = 256, BK = 64, HALF = 128, HTB = HALF * BK * 2, STAGE_BYTES = 8 * HTB, NXCD = 8, WGM = 8;
__host__ __device__ __forceinline__ int lds_byte(int r, int c) { const int st = (r >> 4) * 2 + (c >> 5), rr = r & 15, cc = c & 31, ob = rr * 64 + cc * 2; return st * 1024 + (ob ^ (((ob >> 9) & 1) << 5)); }
__host__ __device__ __forceinline__ void stage_rc(int b, int& R, int& C) { const int st = b / 1024, sb = b % 1024, swz = sb ^ (((sb >> 9) & 1) << 5); R = (st >> 1) * 16 + swz / 64; C = (st & 1) * 32 + (swz % 64) / 2; }
__host__ __device__ __forceinline__ int perm32(int rho) { const int n = rho >> 4, i = rho & 15; return 8 * (i >> 2) + 4 * n + (i & 3); }
struct Unit { int pm, pn; };
struct Gemm { const bf16_t* A; const bf16_t* Bt; int M, N, K; };
struct StaticOrder {
    int nM, nN, nwg, G, c;
    __host__ __device__ void init(int M_, int N_, int G_, int c_) { nM = M_ / BM; nN = N_ / BM; nwg = nM * nN; G = G_; c = c_; }
    __host__ __device__ bool next(int i, Unit& u) const {
        const long L = (long)i * G + c; if (L >= nwg) return false;
        int wgid = (int)L; { const int q = nwg / NXCD, r = nwg % NXCD, xcd = wgid % NXCD, off = wgid / NXCD; wgid = (xcd < r ? xcd * (q + 1) : r * (q + 1) + (xcd - r) * q) + off; }
        const int nig = WGM * nN, gid = wgid / nig, fm = gid * WGM, gsz = (nM - fm) < WGM ? (nM - fm) : WGM;
        u.pm = fm + ((wgid % nig) % gsz); u.pn = (wgid % nig) / gsz; return true;
    }
};
struct OneUnit { int pm, pn; __host__ __device__ bool next(int i, Unit& u) const { if (i != 0) return false; u.pm = pm; u.pn = pn; return true; } };
template <class Epi, class Sched, bool ALIGN_EPI>
__device__ __forceinline__ void gemm_phase(LAS unsigned char* lds, const Gemm g, const Sched& S, const Epi& E) {
    const int tid = threadIdx.x, wid = __builtin_amdgcn_readfirstlane(tid >> 6), lane = tid & 63, wr = wid >> 2, wc = wid & 3, fr = lane & 15, fq = lane >> 4;
    const int K = g.K, nt = K / BK;
    unsigned voffA[2], voffB[2];
#pragma unroll
    for (int i = 0; i < 2; ++i) { int R, C; stage_rc(tid * 16 + i * 8192, R, C); const int Rb = (R & ~31) + perm32(R & 31);
        voffA[i] = (unsigned)(R * K + C) * 2u; voffB[i] = (unsigned)(Rb * K + C) * 2u; }
    const size_t kstep = (size_t)(BK * 2);
    const size_t hstep = (size_t)HALF * K * 2;
    const size_t tstep = 2 * hstep;
    const unsigned ldsw = (unsigned)wid * 1024u;
    const int aoff = lds_byte(wr * 64 + fr, fq * 8), boff = lds_byte(wc * 32 + fr, fq * 8);
#define PG8_SA(b, h) (((b) * 2 + (h)) * HTB)
#define PG8_SB(b, h) ((4 + (b) * 2 + (h)) * HTB)
#define PG8_STAGE(bufoff, gbase, voff) do { _Pragma("unroll") for (int _i = 0; _i < 2; ++_i) \
        __builtin_amdgcn_global_load_lds((const unsigned*)((const char*)(gbase) + (voff)[_i]), (LAS unsigned*)(lds + (bufoff) + ldsw + _i * 8192), 16, 0, 0); } while (0)
#define PG8_LDA(dst, b, h) do { _Pragma("unroll") for (int m = 0; m < 4; ++m) _Pragma("unroll") for (int k = 0; k < 2; ++k) dst[m][k] = *(const LAS bf16x8*)(lds + PG8_SA(b, h) + aoff + m * 2048 + k * 1024); } while (0)
#define PG8_LDB(dst, b, h) do { _Pragma("unroll") for (int n = 0; n < 2; ++n) _Pragma("unroll") for (int k = 0; k < 2; ++k) dst[n][k] = *(const LAS bf16x8*)(lds + PG8_SB(b, h) + boff + n * 2048 + k * 1024); } while (0)
#define PG8_MMA(ai, bj, At, Bt) do { __builtin_amdgcn_s_setprio(1); _Pragma("unroll") for (int m = 0; m < 4; ++m) _Pragma("unroll") for (int n = 0; n < 2; ++n) _Pragma("unroll") for (int k = 0; k < 2; ++k) \
        acc[ai][bj][m][n] = __builtin_amdgcn_mfma_f32_16x16x32_bf16(Bt[n][k], At[m][k], acc[ai][bj][m][n], 0, 0, 0); __builtin_amdgcn_s_setprio(0); } while (0)
#define PG8_WAIT_V(n) asm volatile("s_waitcnt vmcnt(" #n ")" ::: "memory")
#define PG8_WAIT_L(n) asm volatile("s_waitcnt lgkmcnt(" #n ")" ::: "memory")
#define PG8_BAR __builtin_amdgcn_s_barrier()
#define PG8_SCHED __builtin_amdgcn_sched_barrier(0)
    Unit cur, nxt; int ui = 0;
    if (!S.next(0, cur)) return;
    f32x4 acc[2][2][4][2];
    bf16x8 At[4][2], B0[2][2], B1[2][2];
    const char* cA = (const char*)g.A + (size_t)cur.pm * tstep; const char* cB = (const char*)g.Bt + (size_t)cur.pn * tstep;
    typename Epi::Init ini;
    E.init_load(ini, cur, wr, wc, fr, fq);
    PG8_STAGE(PG8_SB(0, 0), cB, voffB); PG8_STAGE(PG8_SB(0, 1), cB + hstep, voffB); PG8_STAGE(PG8_SA(0, 0), cA, voffA); PG8_STAGE(PG8_SA(0, 1), cA + hstep, voffA);
    E.init_acc(acc, ini);
    if (wr == 1) PG8_BAR;
    PG8_WAIT_V(2); PG8_BAR;
    PG8_STAGE(PG8_SB(1, 0), cB + kstep, voffB); PG8_STAGE(PG8_SA(1, 0), cA + kstep, voffA); PG8_STAGE(PG8_SB(1, 1), cB + hstep + kstep, voffB);
    PG8_WAIT_V(6); PG8_BAR;
    for (;;) {
        const bool has_next = S.next(ui + 1, nxt);
        const char* nA = has_next ? (const char*)g.A + (size_t)nxt.pm * tstep : cA; const char* nB = has_next ? (const char*)g.Bt + (size_t)nxt.pn * tstep : cB;
        for (int t = 0; t < nt; t += 2) {
            const bool last = (t == nt - 2);
            const char* a1 = cA + (size_t)(t + 1) * kstep;
            const char* a2 = last ? nA : cA + (size_t)(t + 2) * kstep; const char* b2 = last ? nB : cB + (size_t)(t + 2) * kstep;
            const char* a3 = a2 + kstep; const char* b3 = b2 + kstep;
            PG8_LDB(B0, 0, 0); PG8_LDB(B1, 0, 1); PG8_SCHED; PG8_LDA(At, 0, 0); PG8_STAGE(PG8_SA(1, 1), a1 + hstep, voffA);
            PG8_WAIT_V(8); PG8_WAIT_L(0); PG8_BAR; PG8_MMA(0, 0, At, B0); PG8_MMA(0, 1, At, B1); PG8_BAR; PG8_SCHED;
            PG8_LDA(At, 0, 1); PG8_STAGE(PG8_SB(0, 0), b2, voffB); PG8_STAGE(PG8_SB(0, 1), b2 + hstep, voffB); PG8_STAGE(PG8_SA(0, 0), a2, voffA);
            PG8_WAIT_V(8); PG8_WAIT_L(0); PG8_BAR; PG8_MMA(1, 0, At, B0); PG8_MMA(1, 1, At, B1); PG8_BAR; PG8_SCHED;
            PG8_LDB(B0, 1, 0); PG8_LDB(B1, 1, 1); PG8_SCHED; PG8_LDA(At, 1, 0); PG8_STAGE(PG8_SA(0, 1), a2 + hstep, voffA);
            PG8_WAIT_V(8); PG8_WAIT_L(0); PG8_BAR; PG8_MMA(0, 0, At, B0); PG8_MMA(0, 1, At, B1); PG8_BAR; PG8_SCHED;
            PG8_LDA(At, 1, 1); PG8_STAGE(PG8_SB(1, 0), b3, voffB); PG8_STAGE(PG8_SB(1, 1), b3 + hstep, voffB); PG8_STAGE(PG8_SA(1, 0), a3, voffA);
            PG8_WAIT_V(8); PG8_WAIT_L(0); PG8_BAR; PG8_MMA(1, 0, At, B0); PG8_MMA(1, 1, At, B1); PG8_BAR; PG8_SCHED;
        }
        if constexpr (ALIGN_EPI) { if (wr == 0) PG8_BAR; }
        E(acc, cur, wr, wc, fr, fq, ini);
        if (!has_next) break;
#pragma unroll
        for (int a = 0; a < 2; ++a)
#pragma unroll
            for (int b = 0; b < 2; ++b)
#pragma unroll
                for (int m = 0; m < 4; ++m)
#pragma unroll
                    for (int n = 0; n < 2; ++n) acc[a][b][m][n] = (f32x4){0.f, 0.f, 0.f, 0.f};
        cur = nxt; cA = nA; cB = nB; ++ui;
        if constexpr (Epi::RESID) { E.init_load(ini, cur, wr, wc, fr, fq); E.init_acc(acc, ini); }
        if constexpr (ALIGN_EPI) { if (wr == 1) PG8_BAR; }
    }
    PG8_WAIT_V(0);
    if constexpr (!ALIGN_EPI) { if (wr == 0) PG8_BAR; }
    PG8_BAR;
#undef PG8_SA
#undef PG8_SB
#undef PG8_STAGE
#undef PG8_LDA
#undef PG8_LDB
#undef PG8_MMA
#undef PG8_WAIT_V
#undef PG8_WAIT_L
#undef PG8_BAR
#undef PG8_SCHED
}

struct TileDesc { int mode; bf16_t* dst; int ld; LAS const float* g; float ps; };
struct EpiProj {
    int kind;
    const float* rstd;
    const float* ssq;
    bf16_t *Y, *R1, *R2, *R3, *BB, *MK, *MV;
    const float *g_q, *g_k, *g_xq, *g_xk;
    LAS float* xch; bf16_t* GA; bf16_t* GX;
    LAS float* gl = nullptr;
    __device__ __forceinline__ void stage_gains(LAS float* slot, int tid) {
        gl = slot;
        if (tid < 128) { const int t = kind == 0 ? (tid & 63) : tid;
            if (g_q) slot[tid] = g_q[t]; if (g_k) slot[128 + tid] = g_k[t]; if (g_xq) slot[256 + tid] = g_xq[tid]; if (g_xk) slot[384 + tid] = g_xk[tid]; }
        asm volatile("s_waitcnt vmcnt(0) lgkmcnt(0)" ::: "memory"); __builtin_amdgcn_s_barrier(); asm volatile("" ::: "memory");
    }
    struct Init { float rv[2][4]; };
    static constexpr bool RESID = true;
    __device__ __forceinline__ void init_load(Init& I, const Unit& u, int wr, int wc, int fr, int fq) const {
        const float* src = kind == 0 ? rstd : ssq;
#pragma unroll
        for (int ai = 0; ai < 2; ++ai)
#pragma unroll
            for (int m = 0; m < 4; ++m) I.rv[ai][m] = kind <= 1 ? src[u.pm * BM + ai * HALF + wr * 64 + m * 16 + fr] : 1.f;
    }
    __device__ __forceinline__ void init_acc(f32x4 (&acc)[2][2][4][2], const Init&) const {
#pragma unroll
        for (int a = 0; a < 2; ++a)
#pragma unroll
            for (int b = 0; b < 2; ++b)
#pragma unroll
                for (int m = 0; m < 4; ++m)
#pragma unroll
                    for (int n = 0; n < 2; ++n) acc[a][b][m][n] = (f32x4){0.f, 0.f, 0.f, 0.f};
    }
    __device__ __forceinline__ TileDesc desc(int pn) const {
        TileDesc d; d.mode = 0; d.dst = nullptr; d.ld = 0; d.g = nullptr; d.ps = 1.f;
        if (kind == 0) {
            if (pn < 4) { d.mode = 1; d.dst = Y + 256 * pn; d.ld = 2048; d.g = gl; d.ps = C2_64; }
            else if (pn < 8) { d.mode = 1; d.dst = R1 + 256 * (pn - 4); d.ld = 1024; d.g = gl + 128; }
            else if (pn < 12) { d.dst = R2 + 256 * (pn - 8); d.ld = 1024; }
            else if (pn < 16) { d.mode = 4; d.dst = R3 + 128 * (pn - 12); d.ld = 512; }
            else if (pn < 18) { d.mode = 5; d.dst = BB + 128 * (pn - 16); d.ld = 512; }
            else if (pn < 20) { d.mode = 2; d.dst = Y + 1536 + 256 * (pn - 18); d.ld = 2048; d.g = gl + 256; d.ps = C2_128; }
            else if (pn < 24) { d.mode = 3; d.dst = GA + 256 * (pn - 20); d.ld = 1024; }
            else if (pn < 26) { d.mode = 5; d.dst = BB + 256 + 128 * (pn - 24); d.ld = 512; }
            else { d.mode = 3; d.dst = GX + 256 * (pn - 26); d.ld = 512; }
        } else if (kind == 1) {
            if (pn < 6) { d.mode = 2; d.dst = Y + 256 * pn; d.ld = 2048; d.g = gl; d.ps = C2_128; }
            else if (pn < 12) { d.mode = 2; d.dst = R1 + 256 * (pn - 6); d.ld = 1536; d.g = gl + 128; }
            else if (pn < 18) { d.dst = R2 + 256 * (pn - 12); d.ld = 1536; }
            else if (pn < 20) { d.mode = 2; d.dst = Y + 1536 + 256 * (pn - 18); d.ld = 2048; d.g = gl + 256; d.ps = C2_128; }
            else { d.mode = 3; d.dst = GA + 256 * (pn - 20); d.ld = 2048; }
        } else {
            if (pn < 2) { d.mode = 2; d.dst = MK + 256 * pn; d.ld = 512; d.g = gl + 384; }
            else { d.dst = MV + 256 * (pn - 2); d.ld = 512; }
        }
        return d;
    }
    __device__ __forceinline__ float rowscale(float raw) const {
        if (kind == 0) return raw;
        if (kind == 1) return __builtin_amdgcn_rsqf(raw * (1.0f / DM) + EPS);
        return 1.f;
    }
    __device__ __forceinline__ void operator()(const f32x4 (&acc)[2][2][4][2], const Unit& u, int wr, int wc, int fr, int fq, const Init& I) const {
        const TileDesc d = desc(u.pn);
        const int cl = 64 * wc + 8 * fq;
        f32x4 gv[2][2];
#pragma unroll
        for (int bj = 0; bj < 2; ++bj)
#pragma unroll
            for (int n = 0; n < 2; ++n) gv[bj][n] = (f32x4){d.ps, d.ps, d.ps, d.ps};
        if (d.mode == 1 || d.mode == 2) {
            const int gi = (d.mode == 2 ? 64 * (wc & 1) : 0) + 8 * fq;
#pragma unroll
            for (int bj = 0; bj < 2; ++bj)
#pragma unroll
                for (int n = 0; n < 2; ++n) gv[bj][n] = *(LAS const f32x4*)(d.g + gi + 32 * bj + 4 * n) * d.ps;
        }
        float rf[2][4];
#pragma unroll
        for (int ai = 0; ai < 2; ++ai)
#pragma unroll
            for (int m = 0; m < 4; ++m) rf[ai][m] = rowscale(I.rv[ai][m]);
        if (d.mode == 1 || d.mode == 2) {
            float ss[2][4];
#pragma unroll
            for (int ai = 0; ai < 2; ++ai)
#pragma unroll
                for (int m = 0; m < 4; ++m) { float s0 = 0.f;
#pragma unroll
                    for (int bj = 0; bj < 2; ++bj)
#pragma unroll
                        for (int n = 0; n < 2; ++n) { const f32x4 v = acc[ai][bj][m][n]; s0 += (v[0] * v[0] + v[1] * v[1]) + (v[2] * v[2] + v[3] * v[3]); }
                    ss[ai][m] = s0 * rf[ai][m] * rf[ai][m]; }
#pragma unroll
            for (int ai = 0; ai < 2; ++ai)
#pragma unroll
                for (int m = 0; m < 4; ++m) ss[ai][m] += __shfl_xor(ss[ai][m], 16);
#pragma unroll
            for (int ai = 0; ai < 2; ++ai)
#pragma unroll
                for (int m = 0; m < 4; ++m) { auto rr = __builtin_amdgcn_permlane32_swap(__float_as_uint(ss[ai][m]), __float_as_uint(ss[ai][m]), false, false); ss[ai][m] = __uint_as_float(rr[0]) + __uint_as_float(rr[1]); }
            if (d.mode == 2) {
#pragma unroll
                for (int ai = 0; ai < 2; ++ai)
#pragma unroll
                    for (int m = 0; m < 4; ++m) if (fq == 0) xch[(ai * HALF + wr * 64 + m * 16 + fr) * 4 + wc] = ss[ai][m];
                asm volatile("s_waitcnt lgkmcnt(0)" ::: "memory"); __builtin_amdgcn_s_barrier(); asm volatile("" ::: "memory");
#pragma unroll
                for (int ai = 0; ai < 2; ++ai)
#pragma unroll
                    for (int m = 0; m < 4; ++m) ss[ai][m] += xch[(ai * HALF + wr * 64 + m * 16 + fr) * 4 + (wc ^ 1)];
            }
            const float inv = d.mode == 2 ? (1.0f / 128.0f) : (1.0f / 64.0f);
#pragma unroll
            for (int ai = 0; ai < 2; ++ai)
#pragma unroll
                for (int m = 0; m < 4; ++m) rf[ai][m] *= __builtin_amdgcn_rsqf(ss[ai][m] * inv + EPS);
        }
        asm volatile("" :: "v"(rf[0][0]), "v"(rf[0][1]), "v"(rf[0][2]), "v"(rf[0][3]), "v"(rf[1][0]), "v"(rf[1][1]), "v"(rf[1][2]), "v"(rf[1][3]), "v"(gv[0][0]), "v"(gv[0][1]), "v"(gv[1][0]), "v"(gv[1][1]));
        switch (d.mode) {
            case 0: store_tile<0>(acc, d, rf, gv, u, wr, wc, fr, fq); break;
            case 1: case 2: store_tile<1>(acc, d, rf, gv, u, wr, wc, fr, fq); break;
            case 3: store_tile<3>(acc, d, rf, gv, u, wr, wc, fr, fq); break;
            case 4: store_tile<4>(acc, d, rf, gv, u, wr, wc, fr, fq); break;
            default: store_tile<5>(acc, d, rf, gv, u, wr, wc, fr, fq); break;
        }
    }
    template <int MODE>
    __device__ __forceinline__ void store_tile(const f32x4 (&acc)[2][2][4][2], const TileDesc& d, const float (&rf)[2][4], const f32x4 (&gv)[2][2], const Unit& u, int wr, int wc, int fr, int fq) const {
        const int lane_ = fr + 16 * fq, src4 = tr_src4(lane_);
        const int clS = 64 * wc + 8 * (lane_ & 3);
        bf16_t* base = d.dst + (size_t)(u.pm * BM + wr * 64 + (lane_ >> 2)) * d.ld + (MODE >= 4 ? (clS >> 1) : clS);
        const size_t ld16 = (size_t)16 * d.ld;
#pragma unroll
        for (int ai = 0; ai < 2; ++ai) {
        u32x4 wq[1][4][2];
#pragma unroll
            for (int m = 0; m < 4; ++m) {
                const float rs = rf[ai][m];
#pragma unroll
                for (int bj = 0; bj < 2; ++bj) {
                    if (MODE >= 4) {
                        f32x4 v0 = acc[ai][bj][m][0] * rs, v1 = acc[ai][bj][m][1] * rs;
                        if (MODE == 5) {
#pragma unroll
                            for (int i = 0; i < 4; ++i) v1[i] *= __builtin_amdgcn_rcpf(1.0f + __builtin_amdgcn_exp2f(-v1[i] * LOG2E)); }
                        v0 *= v1;
                        u32x2 w; w.x = cvtpk(v0[0], v0[1]); w.y = cvtpk(v0[2], v0[3]);
                        w = lane_tr(w, src4);
                        wq[0][m][bj].x = w.x; wq[0][m][bj].y = w.y;
                    } else {
                        f32x4 v0, v1;
                        if (MODE == 1) { v0 = acc[ai][bj][m][0] * (gv[bj][0] * rs); v1 = acc[ai][bj][m][1] * (gv[bj][1] * rs); }
                        else { v0 = acc[ai][bj][m][0] * rs; v1 = acc[ai][bj][m][1] * rs; }
                        if (MODE == 3) {
#pragma unroll
                            for (int i = 0; i < 4; ++i) { v0[i] *= __builtin_amdgcn_rcpf(1.0f + __builtin_amdgcn_exp2f(-v0[i] * LOG2E)); v1[i] *= __builtin_amdgcn_rcpf(1.0f + __builtin_amdgcn_exp2f(-v1[i] * LOG2E)); } }
                        u32x4 w; w.x = cvtpk(v0[0], v0[1]); w.y = cvtpk(v0[2], v0[3]); w.z = cvtpk(v1[0], v1[1]); w.w = cvtpk(v1[2], v1[3]);
                        wq[0][m][bj] = lane_tr(w, src4);
                    }
                }
            }
#pragma unroll
            for (int m = 0; m < 4; ++m) {
                bf16_t* rowp = base + (size_t)(ai * 8 + m) * ld16;
#pragma unroll
                for (int bj = 0; bj < 2; ++bj) {
                    if (MODE >= 4) { u32x2 w; w.x = wq[0][m][bj].x; w.y = wq[0][m][bj].y; *(u32x2*)(rowp + 16 * bj) = w; }
                    else st16(rowp + 32 * bj, wq[0][m][bj]);
                }
            }
        }
    }
};
template <bool FIRST> struct EpiOut {
    const bf16_t* base; float* hout; bf16_t* hb; float* ssq; int dry;
    struct Init { u32x4 b[2][4][2]; };
    static constexpr bool RESID = true;
    __device__ __forceinline__ void init_load(Init& I, const Unit& u, int wr, int wc, int fr, int fq) const {
        const int cl = u.pn * BM + 64 * wc + 8 * fq;
#pragma unroll
        for (int ai = 0; ai < 2; ++ai)
#pragma unroll
            for (int m = 0; m < 4; ++m)
#pragma unroll
                for (int bj = 0; bj < 2; ++bj) I.b[ai][m][bj] = *(const u32x4*)(base + (size_t)(u.pm * BM + ai * HALF + wr * 64 + m * 16 + fr) * DM + cl + 32 * bj);
    }
    __device__ __forceinline__ void init_acc(f32x4 (&acc)[2][2][4][2], const Init& I) const {
#pragma unroll
        for (int ai = 0; ai < 2; ++ai)
#pragma unroll
            for (int m = 0; m < 4; ++m)
#pragma unroll
                for (int bj = 0; bj < 2; ++bj) { const u32x4 bv = I.b[ai][m][bj];
                    acc[ai][bj][m][0] = (f32x4){bf_lo(bv.x), bf_hi(bv.x), bf_lo(bv.y), bf_hi(bv.y)}; acc[ai][bj][m][1] = (f32x4){bf_lo(bv.z), bf_hi(bv.z), bf_lo(bv.w), bf_hi(bv.w)}; }
    }
    __device__ __forceinline__ void operator()(const f32x4 (&acc)[2][2][4][2], const Unit& u, int wr, int wc, int fr, int fq, const Init&) const {
        const int cl = u.pn * BM + 64 * wc + 8 * fq;
        float sr[2][4];
#pragma unroll
        for (int ai = 0; ai < 2; ++ai) {
#pragma unroll
            for (int m = 0; m < 4; ++m) {
                const int row = u.pm * BM + ai * HALF + wr * 64 + m * 16 + fr; const size_t off = (size_t)row * DM + cl; float s = 0.f;
#pragma unroll
                for (int bj = 0; bj < 2; ++bj) {
                    const f32x4 h0 = acc[ai][bj][m][0], h1 = acc[ai][bj][m][1];
                    if (FIRST) {
                        u32x4 w; w.x = cvtpk(h0[0], h0[1]); w.y = cvtpk(h0[2], h0[3]); w.z = cvtpk(h1[0], h1[1]); w.w = cvtpk(h1[2], h1[3]);
                        st16(hb + off + 32 * bj, w);
                        s += (h0[0] * h0[0] + h0[1] * h0[1]) + (h0[2] * h0[2] + h0[3] * h0[3]) + (h1[0] * h1[0] + h1[1] * h1[1]) + (h1[2] * h1[2] + h1[3] * h1[3]);
                    } else { *(f32x4*)(hout + off + 32 * bj) = h0; *(f32x4*)(hout + off + 32 * bj + 4) = h1; }
                }
                sr[ai][m] = s;
            }
        }
        if (FIRST) {
#pragma unroll
            for (int ai = 0; ai < 2; ++ai)
#pragma unroll
                for (int m = 0; m < 4; ++m) sr[ai][m] += __shfl_xor(sr[ai][m], 16);
#pragma unroll
            for (int ai = 0; ai < 2; ++ai)
#pragma unroll
                for (int m = 0; m < 4; ++m) { auto rr = __builtin_amdgcn_permlane32_swap(__float_as_uint(sr[ai][m]), __float_as_uint(sr[ai][m]), false, false);
                    const float t = __uint_as_float(rr[0]) + __uint_as_float(rr[1]);
                    if (fq == 0) atomicAdd(ssq + u.pm * BM + ai * HALF + wr * 64 + m * 16 + fr, t); }
        }
    }
};
}

namespace att {
constexpr int NW = 8, QBLK = 32, KVBLK = 64;
constexpr int SHM_V = 16384, SHM_K = 16384, NSTG = 3, K_OFF = 0, V_OFF = NSTG * SHM_K;
constexpr int XSTG_END = 69632, WS_OFF = 98304, BIAS_OFF = 100352, SCAN_OFF = 108544;
constexpr float THR = 8.f;
#define KSWZ(row, colB) ((row) * 256 + ((colB) ^ (((row) & 7) << 4)))
#define SBAR() __builtin_amdgcn_sched_barrier(0)
__device__ __forceinline__ int v_st(int k, int c) { const int kk = (k & ~0xC) | ((k & 4) << 1) | ((k & 8) >> 1); return ((kk >> 3) * 4 + (c >> 5)) * 512 + ((kk & 7) * 32 + (c & 31)) * 2; }
__device__ __forceinline__ int v_rd_base(int lane) { return ((lane & 3) << 3) | (((lane >> 2) & 3) << 6) | (((lane >> 4) & 1) << 5) | (((lane >> 5) & 1) << 8); }
constexpr int v_rd_off(int d0, int ks, int half) { return d0 * 512 + ks * 4096 + half * 2048; }
__device__ __forceinline__ int crow(int r, int hi) { return (r & 3) + 8 * (r >> 2) + 4 * hi; }
__device__ __forceinline__ void mask_causal(f32x16& p0, f32x16& p1, int dq) {
    const float NEG = -__builtin_inff();
#pragma unroll
    for (int r = 0; r < 16; ++r) { const int c = (r & 3) + 8 * (r >> 2); if (dq - c < 0) p0[r] = NEG; if (dq - c - 32 < 0) p1[r] = NEG; }
}
__device__ __forceinline__ f32x16 ninf16() { const float n = -__builtin_inff(); return (f32x16){n, n, n, n, n, n, n, n, n, n, n, n, n, n, n, n}; }
template <bool ADD> __device__ __forceinline__ void partialSM(f32x16& p0, f32x16& p1, float rowc) {
    if (ADD) {
#pragma unroll
        for (int r = 0; r < 16; ++r) p0[r] += rowc;
#pragma unroll
        for (int r = 0; r < 16; ++r) p1[r] += rowc;
    }
#pragma unroll
    for (int r = 0; r < 16; ++r) p0[r] = __builtin_amdgcn_exp2f(p0[r]);
}
__device__ __forceinline__ void finishSM(f32x16& p0, f32x16& p1, float& l_reg, bf16x8& pa0, bf16x8& pa1, bf16x8& pa2, bf16x8& pa3) {
#pragma unroll
    for (int r = 0; r < 16; ++r) p1[r] = __builtin_amdgcn_exp2f(p1[r]);
    float ps = 0;
#pragma unroll
    for (int r = 0; r < 16; ++r) ps += p0[r];
#pragma unroll
    for (int r = 0; r < 16; ++r) ps += p1[r];
    { auto rr = __builtin_amdgcn_permlane32_swap(__float_as_uint(ps), __float_as_uint(ps), false, false);
      ps = __uint_as_float(rr[0]) + __uint_as_float(rr[1]); }
    l_reg += ps;
#define PK4(P, B_, OUT) do { unsigned a0 = cvtpk(P[B_+0], P[B_+1]), a1 = cvtpk(P[B_+2], P[B_+3]);                          \
        unsigned b0 = cvtpk(P[B_+4], P[B_+5]), b1 = cvtpk(P[B_+6], P[B_+7]);                                             \
        auto r0 = __builtin_amdgcn_permlane32_swap(a0, b0, false, false); auto r1 = __builtin_amdgcn_permlane32_swap(a1, b1, false, false); \
        u32x4 w = {r0[0], r1[0], r0[1], r1[1]}; OUT = __builtin_bit_cast(bf16x8, w); } while (0)
    PK4(p0, 0, pa0); PK4(p0, 8, pa1); PK4(p1, 0, pa2); PK4(p1, 8, pa3);
#undef PK4
}
template <int ND, int BIAS>
__device__ __forceinline__ void qkt(f32x16& p0, f32x16& p1, LAS const char* K_lds  , int ksub, int r32, int hi, const bf16x8* qr, LAS const float* bl) {
    if (BIAS) {
#pragma unroll
        for (int g = 0; g < 4; ++g) { const f32x4 a = *(LAS const f32x4*)(bl + 8 * g), b = *(LAS const f32x4*)(bl + 32 + 8 * g);
            p0[4 * g] = a[0]; p0[4 * g + 1] = a[1]; p0[4 * g + 2] = a[2]; p0[4 * g + 3] = a[3]; p1[4 * g] = b[0]; p1[4 * g + 1] = b[1]; p1[4 * g + 2] = b[2]; p1[4 * g + 3] = b[3]; }
    } else { p0 = f32x16{}; p1 = f32x16{}; }
    LAS const char* kb[4];
    int r32v = r32; asm volatile("" : "+v"(r32v));
#pragma unroll
    for (int dd = 0; dd < 4; ++dd) kb[dd] = K_lds + KSWZ(r32v, (dd * 16 + hi * 8) * 2) + ksub;
#pragma unroll
    for (int d0 = 0; d0 < ND; ++d0) { LAS const char* a = kb[d0 & 3] + (d0 >> 2) * 128;
        const bf16x8 b0 = *(LAS const bf16x8*)(a);
        const bf16x8 b1 = *(LAS const bf16x8*)(a + 32 * 256);
        p0 = __builtin_amdgcn_mfma_f32_32x32x16_bf16(b0, qr[d0], p0, 0, 0, 0);
        p1 = __builtin_amdgcn_mfma_f32_32x32x16_bf16(b1, qr[d0], p1, 0, 0, 0); }
}
__device__ __forceinline__ void pv_tile(f32x16* o, int vb0  , bf16x8 pa0, bf16x8 pa1, bf16x8 pa2, bf16x8 pa3) {
#define TRRD(dst, off) asm volatile("ds_read_b64_tr_b16 %0, %1 offset:%2" : "=&v"(dst) : "v"(vb0), "i"(off) : "memory")
#define PV_D0(d0) do { s16x4 l0, l1, l2, l3, h0, h1, h2, h3; constexpr int b_ = v_rd_off(d0, 0, 0); \
        TRRD(l0, b_); TRRD(h0, b_ + 2048); TRRD(l1, b_ + 4096); TRRD(h1, b_ + 6144); TRRD(l2, b_ + 8192); TRRD(h2, b_ + 10240); TRRD(l3, b_ + 12288); TRRD(h3, b_ + 14336); \
        asm volatile("s_waitcnt lgkmcnt(0)" ::: "memory"); SBAR(); \
        o[d0] = __builtin_amdgcn_mfma_f32_32x32x16_bf16(pa0, (bf16x8){l0[0], l0[1], l0[2], l0[3], h0[0], h0[1], h0[2], h0[3]}, o[d0], 0, 0, 0);   \
        o[d0] = __builtin_amdgcn_mfma_f32_32x32x16_bf16(pa1, (bf16x8){l1[0], l1[1], l1[2], l1[3], h1[0], h1[1], h1[2], h1[3]}, o[d0], 0, 0, 0);   \
        o[d0] = __builtin_amdgcn_mfma_f32_32x32x16_bf16(pa2, (bf16x8){l2[0], l2[1], l2[2], l2[3], h2[0], h2[1], h2[2], h2[3]}, o[d0], 0, 0, 0);   \
        o[d0] = __builtin_amdgcn_mfma_f32_32x32x16_bf16(pa3, (bf16x8){l3[0], l3[1], l3[2], l3[3], h3[0], h3[1], h3[2], h3[3]}, o[d0], 0, 0, 0); } while (0)
    PV_D0(0); PV_D0(1); PV_D0(2); PV_D0(3);
#undef PV_D0
#undef TRRD
}
template <int ND> struct Pre { bf16x8 qr[ND]; };
template <int ND>
__device__ __forceinline__ void attn_preload(Pre<ND>& P, const bf16_t* Qw, int qp) {
    int tid = threadIdx.x; asm volatile("" : "+v"(tid));
    const int lane = tid & 63, r32 = lane & 31, hi = lane >> 5;
#pragma unroll
    for (int d0 = 0; d0 < ND; ++d0) P.qr[d0] = *(const bf16x8*)(Qw + (size_t)r32 * qp + d0 * 16 + hi * 8);
}
template <int ND, int BIAS, bool CAUSAL>
__device__ __forceinline__ void attn_core(Pre<ND>& P, const bf16_t* Kp, int kp, const bf16_t* Vp, int vp, int NT, int qlo, int ksub, int tsh, float tslope, float eoff,
                                          LAS char* lds, f32x16 (&o)[4], float& l_out) {
    int tid = threadIdx.x; asm volatile("" : "+v"(tid));
    const int wid = __builtin_amdgcn_readfirstlane(tid >> 6), lane = tid & 63, r32 = lane & 31, hi = lane >> 5;
    LAS char* K_lds = lds + K_OFF; LAS char* V_lds = lds + V_OFF;
    LAS const float* biasL = (LAS const float*)(lds + BIAS_OFF) + tsh + 4 * hi;
    const int vb0 = (int)(unsigned)(uintptr_t)V_lds + v_rd_base(lane);
    const int qm = qlo + r32 - 4 * hi;
    const int tl = __builtin_amdgcn_readfirstlane((qlo + 31) >> 6);
    bf16x8 (&qr)[ND] = P.qr;
    const bf16_t* ksrc[2]; const bf16_t* vsrc[2];
#pragma unroll
    for (int i = 0; i < 2; ++i) { const int p = 2 * wid + i;
        const int row = 4 * p + (lane >> 4); ksrc[i] = Kp + (size_t)row * kp + 8 * ((lane & 15) ^ (row & 7));
        const int sbt = 2 * p + (lane >> 5), kk = (sbt >> 2) * 8 + ((lane & 31) >> 2), c = 32 * (sbt & 3) + 8 * (lane & 3), k = (kk & ~0xC) | ((kk & 4) << 1) | ((kk & 8) >> 1);
        vsrc[i] = Vp + (size_t)k * vp + c; }
    const size_t ktile = (size_t)KVBLK * kp, vtile = (size_t)KVBLK * vp;
#define DMA_K(t_, stg) do { const int tt_ = (t_) < NT ? (t_) : NT - 1; _Pragma("unroll") for (int i_ = 0; i_ < 2; ++i_) \
        __builtin_amdgcn_global_load_lds((const unsigned*)(ksrc[i_] + (size_t)tt_ * ktile), (LAS unsigned*)(K_lds + (stg) + (2 * wid + i_) * 1024), 16, 0, 0); } while (0)
#define DMA_V(t_, stg) do { const int tt_ = (t_) < NT ? (t_) : NT - 1; _Pragma("unroll") for (int i_ = 0; i_ < 2; ++i_) \
        __builtin_amdgcn_global_load_lds((const unsigned*)(vsrc[i_] + (size_t)tt_ * vtile), (LAS unsigned*)(V_lds + (stg) + (2 * wid + i_) * 1024), 16, 0, 0); } while (0)
#define WAIT_BAR(N) asm volatile("s_waitcnt vmcnt(" #N ") lgkmcnt(0)\n\ts_barrier" ::: "memory")
#define MASKT(P0_, P1_, t) do { if (CAUSAL) { const int kb_ = (t) * KVBLK; if (kb_ + KVBLK - 1 > qlo) { asm volatile("" ::: "memory"); mask_causal(P0_, P1_, qm - kb_); } } } while (0)
#define BL(t) (biasL + (BIAS == 2 ? (t) * KVBLK : 0))
#define ROWC(t) (BIAS == 1 ? rowc + tslope * (float)(t) : rowc)
    float l_reg = 0.f, rowc = -eoff;
#pragma unroll
    for (int d_ = 0; d_ < 4; ++d_) o[d_] = f32x16{};
    f32x16 pA0, pA1, pB0, pB1; bf16x8 pa0, pa1, pa2, pa3;
    int s_m1 = 2 * SHM_K, s_0 = 0, s_p1 = SHM_K, s_p2 = 2 * SHM_K;
#define ROT() do { s_m1 = s_0; s_0 = s_p1; s_p1 = s_p2; s_p2 = (s_p2 == 2 * SHM_K) ? 0 : s_p2 + SHM_K; } while (0)
    DMA_K(0, 0); DMA_V(0, 0); DMA_K(1, SHM_K);
    asm volatile("s_waitcnt vmcnt(2)" ::: "memory");
    __builtin_amdgcn_s_barrier(); asm volatile("" ::: "memory");
    if (BIAS == 2) rowc -= ((LAS const float*)(lds + BIAS_OFF))[tsh + qlo + r32];
    if (BIAS == 1) rowc -= (tslope * (1.0f / 64.0f)) * (float)(qlo + r32);
    DMA_K(2, 2 * SHM_K); DMA_V(1, SHM_V);
    SBAR(); qkt<ND, BIAS>(pA0, pA1, K_lds + s_0, ksub, r32, hi, qr, BL(0));
    MASKT(pA0, pA1, 0); partialSM<BIAS != 0>(pA0, pA1, ROWC(0));
    WAIT_BAR(4);
    ROT();
#define STEP(PX0, PX1, PY0, PY1, t) do { \
        DMA_K((t) + 2, s_p2); DMA_V((t) + 1, s_p1); \
        const bool act_ = !CAUSAL || (t) <= tl;       \
        SBAR(); if (act_) qkt<ND, BIAS>(PX0, PX1, K_lds + s_0, ksub, r32, hi, qr, BL(t)); \
        if (!CAUSAL || (t) - 1 <= tl) { finishSM(PY0, PY1, l_reg, pa0, pa1, pa2, pa3); SBAR(); \
            pv_tile(o, vb0 + s_m1, pa0, pa1, pa2, pa3); }       \
        if (act_) { MASKT(PX0, PX1, (t)); partialSM<BIAS != 0>(PX0, PX1, ROWC(t)); } else { PX0 = f32x16{}; PX1 = ninf16(); }   \
        WAIT_BAR(4); \
        ROT(); } while (0)
    int t = 1;
    for (; t + 1 < NT; t += 2) {
        STEP(pB0, pB1, pA0, pA1, t);
        STEP(pA0, pA1, pB0, pB1, t + 1);
    }
    const bool even = (NT & 1) == 0;
    const bool actL = !CAUSAL || NT - 1 <= tl;
    if (even && actL) { SBAR(); qkt<ND, BIAS>(pB0, pB1, K_lds + s_0, ksub, r32, hi, qr, BL(NT - 1)); SBAR(); }
    if (!CAUSAL || (even ? NT - 2 : NT - 1) <= tl) { finishSM(pA0, pA1, l_reg, pa0, pa1, pa2, pa3); SBAR();
        pv_tile(o, vb0 + s_m1, pa0, pa1, pa2, pa3); }
    if (even) { if (actL) { MASKT(pB0, pB1, NT - 1); partialSM<BIAS != 0>(pB0, pB1, ROWC(NT - 1)); } WAIT_BAR(0);
        if (actL) { finishSM(pB0, pB1, l_reg, pa0, pa1, pa2, pa3); SBAR(); pv_tile(o, vb0 + s_0, pa0, pa1, pa2, pa3); } }
    asm volatile("s_waitcnt vmcnt(0)" ::: "memory");
    l_out = l_reg;
#undef DMA_K
#undef DMA_V
#undef WAIT_BAR
#undef MASKT
#undef BL
#undef ROWC
#undef ROT
#undef STEP
}
__device__ __forceinline__ void store_rows_bf16(const f32x16 (&o)[4], float l_reg, bf16_t* Ow, int op, LAS char* lds, const bf16_t* Gw, int gp) {
    int tid = threadIdx.x; asm volatile("" : "+v"(tid));
    const int wid = __builtin_amdgcn_readfirstlane(tid >> 6), lane = tid & 63, r32 = lane & 31, hi = lane >> 5;
    LAS float* li_l = (LAS float*)(lds + WS_OFF) + wid * 64;
    if (hi == 0) li_l[r32] = l_reg;
    asm volatile("s_waitcnt lgkmcnt(0)" ::: "memory");
    float rli[16];
#pragma unroll
    for (int r = 0; r < 16; ++r) rli[r] = __builtin_amdgcn_rcpf(li_l[crow(r, hi)]);
    u32x4 gin[8];
#pragma unroll
    for (int i = 0; i < 8; ++i) { const int id = i * 64 + lane, row = id >> 4, ch = id & 15; gin[i] = *(const u32x4*)(Gw + (size_t)row * gp + ch * 8); }
    __syncthreads();
    LAS bf16_t* stg = (LAS bf16_t*)lds + wid * (32 * 136);
#pragma unroll
    for (int r = 0; r < 16; ++r) { const int orow = crow(r, hi);
#pragma unroll
        for (int d0 = 0; d0 < 4; ++d0) { const unsigned w = cvtpk(o[d0][r] * rli[r], 0.f); stg[orow * 136 + d0 * 32 + r32] = (bf16_t)(w & 0xffffu); } }
    asm volatile("s_waitcnt lgkmcnt(0)" ::: "memory");
#pragma unroll
    for (int i = 0; i < 8; ++i) { const int id = i * 64 + lane, row = id >> 4, ch = id & 15;
        const u32x4 v = *(LAS const u32x4*)(stg + row * 136 + ch * 8); const u32x4 gq = gin[i]; u32x4 w;
        w.x = cvtpk(bf_lo(v.x) * bf_lo(gq.x), bf_hi(v.x) * bf_hi(gq.x)); w.y = cvtpk(bf_lo(v.y) * bf_lo(gq.y), bf_hi(v.y) * bf_hi(gq.y));
        w.z = cvtpk(bf_lo(v.z) * bf_lo(gq.z), bf_hi(v.z) * bf_hi(gq.z)); w.w = cvtpk(bf_lo(v.w) * bf_lo(gq.w), bf_hi(v.w) * bf_hi(gq.w));
        st16(Ow + (size_t)row * op + ch * 8, w); }
    asm volatile("s_waitcnt lgkmcnt(0)" ::: "memory");
    __syncthreads();
}
#undef KSWZ
#undef SBAR
}

typedef GAS unsigned gu32;
#define RLX_AGENT __ATOMIC_RELAXED, __HIP_MEMORY_SCOPE_AGENT
#define XB_TMO      128
#define XB_XCNT(j)  (256  + 64 * (j))
#define XB_XSUB(j)  (1280 + 64 * (j))
#define XB_XGEN(j)  (2304 + 64 * (j))
#define XB_TOP      3328
#define XB_TOPGEN   3392
#define XCD_BAR_WORDS 3456
#define XB_SPIN_CAP (1u << 18)
__device__ __forceinline__ unsigned xb_ld(unsigned* p)              { return __hip_atomic_load(p, __ATOMIC_RELAXED, __HIP_MEMORY_SCOPE_AGENT); }
__device__ __forceinline__ unsigned xb_add(unsigned* p, unsigned v) { return __hip_atomic_fetch_add(p, v, __ATOMIC_RELAXED, __HIP_MEMORY_SCOPE_AGENT); }
__device__ __forceinline__ unsigned xb_xcc_id() { return (unsigned)__builtin_amdgcn_s_getreg((3 << 11) | 20) & 0xFu; }
#define XB_SPIN(cond, bar) do { unsigned _sp = 0; while (cond) { __builtin_amdgcn_s_sleep(1); \
    if ((++_sp & 255u) == 0u) { if (xb_ld(&(bar)[XB_TMO])) break; if (_sp > XB_SPIN_CAP) { atomicAdd(&(bar)[XB_TMO], 1u); break; } } } } while (0)
struct XcdBarrier { unsigned* bar; unsigned x; volatile LAS unsigned* st; };
__device__ __forceinline__ XcdBarrier xcd_barrier_post(unsigned* bar, volatile LAS unsigned* st) {
    XcdBarrier b; b.bar = bar; b.x = xb_xcc_id(); b.st = st;
    if (threadIdx.x == 0) (void)xb_add(&bar[XB_XCNT(b.x)], 1u);
    return b;
}
__device__ __forceinline__ void xcd_barrier_complete(unsigned* bar, unsigned x, unsigned& nloc, unsigned& nx) {
    const unsigned G = gridDim.x * gridDim.y * gridDim.z;
    unsigned sum, cnt, mine, sp = 0u;
    for (;;) {
        sum = 0u; cnt = 0u; mine = 0u;
#pragma unroll
        for (unsigned j = 0; j < 16; ++j) { const unsigned c = xb_ld(&bar[XB_XCNT(j)]); sum += c; cnt += (c > 0u) ? 1u : 0u; mine = (j == x) ? c : mine; }
        if (sum == G) break;
        __builtin_amdgcn_s_sleep(1);
        if ((++sp & 255u) == 0u) { if (xb_ld(&bar[XB_TMO])) break; if (sp > XB_SPIN_CAP) { atomicAdd(&bar[XB_TMO], 1u); break; } }
    }
    nloc = mine > 0u ? mine : 1u; nx = cnt > 0u ? cnt : 1u;
}
__device__ __forceinline__ void xcd_barrier(const XcdBarrier& b) {
    asm volatile("s_waitcnt vmcnt(0)" ::: "memory");
    __syncthreads();
    if (threadIdx.x == 0) {
        unsigned* bar = b.bar;
        __builtin_amdgcn_s_waitcnt(0);
        unsigned nloc = b.st[0], nx = b.st[1];
        if (nloc == 0u) { xcd_barrier_complete(bar, b.x, nloc, nx); b.st[0] = nloc; b.st[1] = nx; }
        const unsigned old = xb_add(&bar[XB_XSUB(b.x)], 1u);
        const unsigned gen = old / nloc;
        if (old + 1u == (gen + 1u) * nloc) {
            __builtin_amdgcn_fence(__ATOMIC_RELEASE, "agent");
            asm volatile("s_waitcnt vmcnt(0)" ::: "memory");
            const unsigned og = xb_add(&bar[XB_TOP], 1u);
            const unsigned tg = og / nx;
            if (og + 1u == (tg + 1u) * nx) xb_add(&bar[XB_TOPGEN], 1u);
            else XB_SPIN(xb_ld(&bar[XB_TOPGEN]) == tg, bar);
            __builtin_amdgcn_fence(__ATOMIC_ACQUIRE, "agent");
            xb_add(&bar[XB_XGEN(b.x)], 1u);
            asm volatile("s_waitcnt vmcnt(0)" ::: "memory");
        } else {
            XB_SPIN(xb_ld(&bar[XB_XGEN(b.x)]) == gen, bar);
            __builtin_amdgcn_fence(__ATOMIC_ACQUIRE, "agent");
            asm volatile("s_waitcnt vmcnt(0)" ::: "memory");
        }
    }
    __syncthreads();
}

struct Args { const float* in[25]; float* out; unsigned char* ws; int ph_lo, ph_hi; };
struct Frame {
    LAS unsigned char* lds;
    int tid, lane, wave, vcu, G;
    unsigned char* ws;
};

struct P0Job { const float* W; const float* g; bf16_t* dst; int ldw, src0, K, dst0, nblk, r, src1; };
__device__ __forceinline__ void p0_load(const P0Job& j, int lane, float (&v)[32]) {
    const int kb = j.r / j.nblk, nb = j.r % j.nblk;
    const int n = lane & 31;
    const int col = j.src1 > 0 ? ((n & 4) ? j.src1 : j.src0) + 16 * nb + 4 * (n >> 3) + (n & 3) : j.src0 + 32 * nb + n;
    const float* src = j.W + (size_t)(64 * kb) * j.ldw + col + (size_t)(lane >> 5) * j.ldw;
#pragma unroll
    for (int i = 0; i < 32; ++i) v[i] = src[(size_t)(2 * i) * j.ldw];
}
__device__ __forceinline__ void p0_finish(const P0Job& j, int lane, const float (&v)[32], LAS float* scr) {
    const int kb = j.r / j.nblk, nb = j.r % j.nblk, k0 = 64 * kb;
    const int L = j.dst0 + 32 * nb, c = L & 255, rowbase = (L & ~255) + 128 * ((c >> 5) & 1) + 32 * (c >> 6);
#pragma unroll
    for (int i = 0; i < 32; ++i) scr[(2 * i + (lane >> 5)) * 33 + (lane & 31)] = v[i];
    LDS_WAIT(); asm volatile("" ::: "memory");
    const int cc = lane & 7;
    f32x4 g0 = {1.f, 1.f, 1.f, 1.f}, g1 = {1.f, 1.f, 1.f, 1.f};
    if (j.g) { g0 = *(const f32x4*)(j.g + k0 + 8 * cc); g1 = *(const f32x4*)(j.g + k0 + 8 * cc + 4); }
#pragma unroll
    for (int jj = 0; jj < 4; ++jj) { const int n = (lane >> 3) + 8 * jj; const LAS float* sp = scr + (8 * cc) * 33 + n;
        u32x4 o; o.x = cvtpk(sp[0 * 33] * g0[0], sp[1 * 33] * g0[1]); o.y = cvtpk(sp[2 * 33] * g0[2], sp[3 * 33] * g0[3]);
        o.z = cvtpk(sp[4 * 33] * g1[0], sp[5 * 33] * g1[1]); o.w = cvtpk(sp[6 * 33] * g1[2], sp[7 * 33] * g1[3]);
        *(u32x4*)(j.dst + (size_t)(rowbase + n) * j.K + k0 + 8 * cc) = o; }
    LDS_WAIT(); asm volatile("" ::: "memory");
}
template <bool NORM> __device__ __forceinline__ void row_to_bf16(const float* xrow, bf16_t* orow, float* rstd_out, int lane) {
    const f32x4* xr = (const f32x4*)xrow + lane;
    f32x4 v[4]; float s = 0.f;
#pragma unroll
    for (int j = 0; j < 4; ++j) { v[j] = xr[64 * j]; s += (v[j].x * v[j].x + v[j].y * v[j].y) + (v[j].z * v[j].z + v[j].w * v[j].w); }
    const float rstd = 1.0f / sqrtf(wave_sum(s) * (1.0f / DM) + EPS);
    const float sc = NORM ? rstd : 1.f;
    u32x2* o8 = (u32x2*)orow + lane;
#pragma unroll
    for (int j = 0; j < 4; ++j) { u32x2 w; w.x = cvtpk(v[j].x * sc, v[j].y * sc); w.y = cvtpk(v[j].z * sc, v[j].w * sc); o8[64 * j] = w; }
    if (rstd_out && lane == 0) *rstd_out = rstd;
}

__global__ void __launch_bounds__(512, 2) hybrid_fwd(Args args) {
    extern __shared__ __attribute__((aligned(16))) unsigned char lds_raw[];
    Frame F;
    F.lds = (LAS unsigned char*)lds_raw;
    F.tid = threadIdx.x; F.lane = F.tid & 63; F.wave = __builtin_amdgcn_readfirstlane(F.tid >> 6);
    F.G = gridDim.x; { const int bx = blockIdx.x; F.vcu = (F.G % 8 == 0) ? (bx % 8) * (F.G / 8) + bx / 8 : bx; }
    F.ws = args.ws;
    unsigned char* ws = args.ws;
    volatile LAS unsigned* MISC = (volatile LAS unsigned*)(F.lds + MISC_OFF);
    for (int u = F.tid; u < (LDS_BYTES - LDSCTL_OFF) / 4; u += 512) ((LAS unsigned*)(F.lds + LDSCTL_OFF))[u] = 0u;
    __syncthreads();
    unsigned* ctl = (unsigned*)(ws + WS_CTL);
    XcdBarrier bar; bar.bar = ctl + CW_BAR; bar.x = 0; bar.st = nullptr;
    if (MK_N_LAUNCHES == 1) bar = xcd_barrier_post(ctl + CW_BAR, MISC + 8);
    const int lo = args.ph_lo, hi_ph = args.ph_hi;
#ifndef PHASE_MASK
#define PHASE_MASK 0x1ff
#endif
#define IN(k) (((PHASE_MASK >> (k)) & 1) && lo <= (k) && (k) < hi_ph)
#if DUP_MASK
#define REPS(k) for (int rep_ = ((DUP_MASK >> (k)) & 1) ? 0 : 1; rep_ < 2; ++rep_)
#define DRY (rep_ == 0)
#else
#define REPS(k)
#define DRY false
#endif
#if PROBE_A >= 0
#define STAMP(k) do { if (blockIdx.x == 0 && F.tid == 0) MISC[16 + (k)] = (unsigned)__builtin_amdgcn_s_memrealtime(); } while (0)
#else
#define STAMP(k)
#endif
#define SEAM(k) do { if (MK_N_LAUNCHES == 1 && IN(k) && (IN((k) + 1) || (((k) == 2 || (k) == 6) && IN((k) + 2)))) xcd_barrier(bar); STAMP((k) + 1); } while (0)

    const float* x = args.in[0]; const float* mem = args.in[1];
    bf16_t* xb = (bf16_t*)args.out;
    float* hout = args.out;
    float* rstd0 = (float*)(ws + WS_RSTD0); float* ssq1 = (float*)(ws + WS_SSQ1); float* WF = (float*)(ws + WS_WF); float* LF = (float*)(ws + WS_LF);
    bf16_t *WA_e = (bf16_t*)(ws + WS_WA_E), *WG_e = (bf16_t*)(ws + WS_WG_E), *WO_e = (bf16_t*)(ws + WS_WO_E), *WM_e = (bf16_t*)(ws + WS_WM_E);
    bf16_t *WA_o = (bf16_t*)(ws + WS_WA_O), *WG_o = (bf16_t*)(ws + WS_WG_O), *WO_o = (bf16_t*)(ws + WS_WO_O), *WM_o = (bf16_t*)(ws + WS_WM_O);
    bf16_t *memn = (bf16_t*)(ws + WS_MEMN), *MK_e = (bf16_t*)(ws + WS_MK_E), *MV_e = (bf16_t*)(ws + WS_MV_E), *MK_o = (bf16_t*)(ws + WS_MK_O), *MV_o = (bf16_t*)(ws + WS_MV_O);
    bf16_t *Y = (bf16_t*)(ws + WS_Y), *R1 = (bf16_t*)(ws + WS_R1), *R2 = (bf16_t*)(ws + WS_R2), *R3 = (bf16_t*)(ws + WS_R3), *BB = (bf16_t*)(ws + WS_BB);
    LAS float* xch = (LAS float*)(F.lds + XCH_OFF);
    bf16_t* GA_e = (bf16_t*)args.out + (size_t)M * 1024;
    bf16_t* GX_e = R2 + (size_t)M * 1024;
    bf16_t* G1 = (bf16_t*)args.out;
    LAS char* alds = (LAS char*)F.lds;

    STAMP(0);
    if (IN(0)) REPS(0) {
        LAS float* scr = (LAS float*)(F.lds + F.wave * 16384);
        const int gw = F.vcu * 8 + F.wave, NGW = F.G * 8;
#define P0_DECODE(J, it_) do { int r = (it_); \
            if (r < 16 * 96) { J = P0Job{args.in[3], args.in[2], WA_e, 7168, 0, 1024, 0, 96, r}; break; } r -= 16 * 96;              \
            if (r < 16 * 32) { J = P0Job{args.in[3], args.in[2], WA_e, 7168, 4096, 1024, 3072, 32, r, 4608}; break; } r -= 16 * 32;   \
            if (r < 16 * 16) { J = P0Job{args.in[3], args.in[2], WA_e, 7168, 5120, 1024, 4096, 16, r, 5632}; break; } r -= 16 * 16;   \
            if (r < 16 * 16) { J = P0Job{args.in[3], args.in[2], WA_e, 7168, 6144, 1024, 4608, 16, r}; break; } r -= 16 * 16;        \
            if (r < 16 * 32) { J = P0Job{args.in[3], args.in[2], WG_e, 7168, 3072, 1024, 0, 32, r}; break; } r -= 16 * 32;           \
            if (r < 16 * 16) { J = P0Job{args.in[3], args.in[2], WG_e, 7168, 5376, 1024, 1024, 16, r, 5888}; break; } r -= 16 * 16;   \
            if (r < 16 * 16) { J = P0Job{args.in[3], args.in[2], WG_e, 7168, 6656, 1024, 1536, 16, r}; break; } r -= 16 * 16;        \
            if (r < 32 * 32) { J = P0Job{args.in[4], nullptr, WO_e, 1024, 0, 2048, 0, 32, r}; break; } r -= 32 * 32;                 \
            if (r < 16 * 32) { J = P0Job{args.in[14], args.in[13], WM_e, 1024, 0, 1024, 0, 32, r}; break; } r -= 16 * 32;            \
            if (r < 16 * 144) { J = P0Job{args.in[16], args.in[15], WA_o, 7180, 0, 1024, 0, 144, r}; break; } r -= 16 * 144;         \
            if (r < 16 * 16) { J = P0Job{args.in[16], args.in[15], WA_o, 7180, 6156, 1024, 4608, 16, r}; break; } r -= 16 * 16;      \
            if (r < 16 * 48) { J = P0Job{args.in[16], args.in[15], WG_o, 7180, 4608, 1024, 0, 48, r}; break; } r -= 16 * 48;         \
            if (r < 16 * 16) { J = P0Job{args.in[16], args.in[15], WG_o, 7180, 6668, 1024, 1536, 16, r}; break; } r -= 16 * 16;      \
            if (r < 32 * 32) { J = P0Job{args.in[17], nullptr, WO_o, 1024, 0, 2048, 0, 32, r}; break; } r -= 32 * 32; \
            J = P0Job{args.in[24], args.in[23], WM_o, 1024, 0, 1024, 0, 32, r}; } while (0)
        { int it = gw; P0Job cur{}, nxt{}; float va[32], vb[32];
#define P0_IDX(i_) ((i_) < 3584 ? (i_) : (i_) < 4096 ? (i_) + 1024 : (i_) + 5632)
          if (it < 4608) { P0_DECODE(cur, P0_IDX(it)); p0_load(cur, F.lane, va); }
          while (it < 4608) {
              const int itn = it + NGW; const bool hn = itn < 4608;
              if (hn) { P0_DECODE(nxt, P0_IDX(itn)); p0_load(nxt, F.lane, vb); }
              p0_finish(cur, F.lane, va, scr);
#pragma unroll
              for (int i = 0; i < 32; ++i) va[i] = vb[i];
              cur = nxt; it = itn;
          } }
        for (int m = gw; m < M; m += 4 * NGW) {
            f32x4 v[4][4]; float ss[4];
#pragma unroll
            for (int q = 0; q < 4; ++q) { const int mq = (m + q * NGW < M) ? m + q * NGW : m; const f32x4* xr = (const f32x4*)(x + (size_t)mq * DM) + F.lane;
#pragma unroll
                for (int j = 0; j < 4; ++j) v[q][j] = xr[64 * j]; }
#pragma unroll
            for (int q = 0; q < 4; ++q) { float t = 0.f;
#pragma unroll
                for (int j = 0; j < 4; ++j) t += (v[q][j].x * v[q][j].x + v[q][j].y * v[q][j].y) + (v[q][j].z * v[q][j].z + v[q][j].w * v[q][j].w);
                ss[q] = t; }
#pragma unroll
            for (int o = 1; o < 64; o <<= 1) {
#pragma unroll
                for (int q = 0; q < 4; ++q) ss[q] += __shfl_xor(ss[q], o); }
#pragma unroll
            for (int q = 0; q < 4; ++q) { const int mm = m + q * NGW; if (mm >= M) continue; u32x2* o8 = (u32x2*)(xb + (size_t)mm * DM) + F.lane;
#pragma unroll
                for (int j = 0; j < 4; ++j) { u32x2 w; w.x = cvtpk(v[q][j].x, v[q][j].y); w.y = cvtpk(v[q][j].z, v[q][j].w); o8[64 * j] = w; }
                if (F.lane == 0) rstd0[mm] = 1.0f / sqrtf(ss[q] * (1.0f / DM) + EPS); }
        }
        for (int m = gw; m < MM; m += NGW) row_to_bf16<true>(mem + (size_t)m * DM, memn + (size_t)m * DM, nullptr, F.lane);
        for (int i = (F.vcu * 512 + F.tid); i < 16 * 1024; i += F.G * 512) { const int c = i >> 10, k = i & 1023;
            const float wv_ = c < 12 ? args.in[15][k] * args.in[16][(size_t)k * 7180 + 6144 + c] : 0.f; ((bf16_t*)WF)[i] = (bf16_t)(cvtpk(wv_, 0.f) & 0xffffu); }
    }
    SEAM(0);

    if (IN(1)) REPS(1) {
        if (STAGGER_TICKS > 0 && ((blockIdx.x >> 3) & 1)) { const unsigned long long t0 = __builtin_amdgcn_s_memrealtime(); while (__builtin_amdgcn_s_memrealtime() - t0 < (unsigned long long)STAGGER_TICKS) __builtin_amdgcn_s_sleep(8); }
        pg8::Gemm g{xb, WA_e, M, 7168, DM}; pg8::StaticOrder S; S.init(M, 7168, F.G, (int)blockIdx.x);
        pg8::EpiProj E{0, rstd0, nullptr, Y, R1, R2, R3, BB, nullptr, nullptr, args.in[5], args.in[6], args.in[11], nullptr, xch, GA_e, GX_e};
        E.stage_gains((LAS float*)(F.lds + GAIN_OFF), F.tid);
        pg8::gemm_phase<pg8::EpiProj, pg8::StaticOrder, true>(F.lds, g, S, E);
    }
    SEAM(1);

#define Q_POP_FIRST(qh) do { if (F.tid == 0) MISC[12] = xb_add((qh), 1u); LDS_WAIT(); __syncthreads(); cur = (int)MISC[12]; __syncthreads(); } while (0)
#define Q_PREFETCH(qh) unsigned nxt_reg_ = 0u; if (F.tid == 0) nxt_reg_ = xb_add((qh), 1u)
#define Q_NEXT() do { if (F.tid == 0) MISC[12] = nxt_reg_; LDS_WAIT(); __syncthreads(); cur = (int)MISC[12]; __syncthreads(); } while (0)
    if (IN(2)) REPS(2) {
        bf16_t* dummy = (bf16_t*)(ws + WS_END) + (size_t)(F.vcu * 8 + F.wave) * 2048;
        unsigned* qh = ctl + CW_Q2 + (DRY ? 64 : 0); unsigned* mkv_done = ctl + CW_MKV;
        const int r32 = F.lane & 31, hi = F.lane >> 5;
        float lam;
        { const float* lp = args.in[7]; const float a = wave_sum(lp[F.lane] * lp[64 + F.lane]), b = wave_sum(lp[128 + F.lane] * lp[192 + F.lane]);
          lam = __builtin_bit_cast(float, __builtin_amdgcn_readfirstlane(__builtin_bit_cast(int, expf(a) - expf(b) + LAM_INIT))); }
        float zb, b2;
        { float gq = fabsf(args.in[5][F.lane]), gk = fabsf(args.in[6][F.lane]);
#pragma unroll
          for (int o = 1; o < 64; o <<= 1) { gq = fmaxf(gq, __shfl_xor(gq, o)); gk = fmaxf(gk, __shfl_xor(gk, o)); }
          b2 = __builtin_bit_cast(float, __builtin_amdgcn_readfirstlane(__builtin_bit_cast(int, 16.0f * gq * gk))); zb = ZSKIP + b2; }
        const float eoff64 = fmaxf(0.f, b2 * 0.5f * LOG2E - 100.0f);
        int cur; Q_POP_FIRST(qh);
        while ((P2_PARTS & 1) && cur < 64) {
            Q_PREFETCH(qh);
            { const int lay = cur >> 5, uu = cur & 31; pg8::OneUnit S{uu >> 2, uu & 3};
              pg8::Gemm g{memn, lay ? WM_o : WM_e, MM, 1024, DM};
              pg8::EpiProj E{2, nullptr, nullptr, nullptr, nullptr, nullptr, nullptr, nullptr, lay ? MK_o : MK_e, lay ? MV_o : MV_e, nullptr, nullptr, nullptr, lay ? args.in[22] : args.in[12], xch, nullptr, nullptr};
              E.stage_gains((LAS float*)(F.lds + GAIN_OFF), F.tid);
              pg8::gemm_phase<pg8::EpiProj, pg8::OneUnit, true>(F.lds, g, S, E);
              if (F.tid == 0 && !DRY) { __builtin_amdgcn_fence(__ATOMIC_RELEASE, "agent"); asm volatile("s_waitcnt vmcnt(0)" ::: "memory"); xb_add(mkv_done, 1u); } }
            Q_NEXT();
        }
        asm volatile("" ::: "memory");
#define DIFF_DECODE(c_) const int j = (c_) - 64, qb = 15 - (j >> 6), bh = j & 63, b = bh >> 3, h = bh & 7, sub = F.wave >> 2, w4 = sub ? 3 - (F.wave & 3) : (F.wave & 3);     \
              const float slope = exp2f(-(float)(h + 1)), cslope = slope * LOG2E; \
              int jlo = 0; { const float dz = zb / slope, q0f = (float)(qb * 128); if (q0f > dz) jlo = (int)((q0f - dz) * (1.0f / 64.0f)); } \
              const size_t row0 = (size_t)b * SEQ + qb * 128; \
              bf16_t* Qw = Y + (row0 + w4 * 32) * 2048 + 128 * h + 64 * sub; \
              const bf16_t* Kp = R1 + (size_t)(b * SEQ + 64 * jlo) * 1024 + 128 * h; const bf16_t* Vp = R2 + (size_t)(b * SEQ + 64 * jlo) * 1024 + 128 * h
        att::Pre<4> PD;
        if ((P2_PARTS & 2) && cur < 1088) { DIFF_DECODE(cur); att::attn_preload<4>(PD, Qw, 2048); }
        while ((P2_PARTS & 2) && cur < 1088) {
            unsigned nxt_reg_ = 0u; if (F.tid == 0) nxt_reg_ = xb_add(qh, 1u);
            int nxt;
            { DIFF_DECODE(cur);
              if (F.tid < 64) ((LAS float*)(alds + att::BIAS_OFF))[F.tid] = cslope * (float)F.tid;
              f32x16 o[4]; float l;
              att::attn_core<4, 1, true>(PD, Kp, 1024, Vp, 1024, 2 * (qb + 1) - jlo, qb * 128 + w4 * 32 - 64 * jlo, 128 * sub, 0, cslope * 64.f, eoff64, alds, o, l);
              if (F.tid == 0) MISC[12] = nxt_reg_; LDS_WAIT(); __syncthreads(); nxt = (int)MISC[12];
              if (nxt < 1088) { DIFF_DECODE(nxt); att::attn_preload<4>(PD, Qw, 2048); }
              const int chq = F.lane & 15;
              LAS float* li_l = (LAS float*)(alds + att::WS_OFF) + F.wave * 64;
              if (hi == 0) li_l[r32] = l;
              LDS_WAIT();
              float rli[16];
#pragma unroll
              for (int r = 0; r < 16; ++r) rli[r] = __builtin_amdgcn_rcpf(li_l[att::crow(r, hi)]);
              __syncthreads();
              LAS float* X = (LAS float*)alds + w4 * (32 * 132);
              if (sub == 1) {
#pragma unroll
                  for (int r = 0; r < 16; ++r) { const int orow = att::crow(r, hi); const float f = rli[r] * lam;
#pragma unroll
                      for (int d0 = 0; d0 < 4; ++d0) X[orow * 132 + d0 * 32 + r32] = o[d0][r] * f; }
              }
              LDS_WAIT(); __syncthreads();
              if (sub == 0) {
#pragma unroll
                  for (int r = 0; r < 16; ++r) { const int orow = att::crow(r, hi);
#pragma unroll
                      for (int d0 = 0; d0 < 4; ++d0) { const float t = o[d0][r] * rli[r] - X[orow * 132 + d0 * 32 + r32]; X[orow * 132 + d0 * 32 + r32] = t; } }
                  u32x4 gin[8];
#pragma unroll
                  for (int i = 0; i < 8; ++i) gin[i] = *(const u32x4*)(GA_e + (row0 + w4 * 32 + 4 * i + (F.lane >> 4)) * 1024 + 128 * h + chq * 8);
                  const f32x4 g0 = *(const f32x4*)(args.in[8] + chq * 8), g1 = *(const f32x4*)(args.in[8] + chq * 8 + 4);
                  LDS_WAIT();
                  const LAS float* xr = X + r32 * 132 + hi * 64;
                  float ssum = 0.f;
#pragma unroll
                  for (int c = 0; c < 16; ++c) { const f32x4 t = *(const LAS f32x4*)(xr + 4 * c); ssum += (t[0] * t[0] + t[1] * t[1]) + (t[2] * t[2] + t[3] * t[3]); }
                  { auto rr = __builtin_amdgcn_permlane32_swap(__float_as_uint(ssum), __float_as_uint(ssum), false, false); ssum = __uint_as_float(rr[0]) + __uint_as_float(rr[1]); }
                  const float rn = (1.0f - LAM_INIT) * __builtin_amdgcn_rsqf(ssum * (1.0f / 128.0f) + EPS);
                  if (hi == 0) li_l[32 + r32] = rn;
                  LDS_WAIT();
#pragma unroll
                  for (int i = 0; i < 8; ++i) { const int row = 4 * i + (F.lane >> 4);
                      const LAS float* xs = X + row * 132 + chq * 8;
                      const f32x4 t0 = *(const LAS f32x4*)(xs), t1 = *(const LAS f32x4*)(xs + 4);
                      const float rv = li_l[32 + row];
                      const u32x4 gz = gin[i];
                      u32x4 w; w.x = cvtpk(t0[0] * rv * g0[0] * bf_lo(gz.x), t0[1] * rv * g0[1] * bf_hi(gz.x)); w.y = cvtpk(t0[2] * rv * g0[2] * bf_lo(gz.y), t0[3] * rv * g0[3] * bf_hi(gz.y));
                      w.z = cvtpk(t1[0] * rv * g1[0] * bf_lo(gz.z), t1[1] * rv * g1[1] * bf_hi(gz.z)); w.w = cvtpk(t1[2] * rv * g1[2] * bf_lo(gz.w), t1[3] * rv * g1[3] * bf_hi(gz.w));
                      bf16_t* op_ = DRY ? dummy + row * 32 + chq * 8 : Y + (row0 + w4 * 32 + row) * 2048 + 128 * h + chq * 8;
                      st16(op_, w); }
              }
              LDS_WAIT(); __syncthreads(); }
            cur = nxt;
        }
#undef DIFF_DECODE
        asm volatile("" ::: "memory");
        if (cur < 1344) {
            if (F.tid == 0) { unsigned sp = 0; while (xb_ld(mkv_done) < 64u && !DRY) { __builtin_amdgcn_s_sleep(2); if (++sp > (1u << 22)) break; }
                __builtin_amdgcn_fence(__ATOMIC_ACQUIRE, "agent"); asm volatile("s_waitcnt vmcnt(0)" ::: "memory"); }
            __syncthreads();
        }
#define CROSS_DECODE(c_, base_, MK_, MV_) const int c = (c_) - (base_), b = c >> 5, hd = (c >> 3) & 3, qb = c & 7; \
              bf16_t* Qw = Y + (size_t)(b * SEQ + qb * 256 + F.wave * 32) * 2048 + 1536 + 128 * hd; \
              const bf16_t* Kp = (MK_) + (size_t)(b * MEML) * 512 + 128 * hd; const bf16_t* Vp = (MV_) + (size_t)(b * MEML) * 512 + 128 * hd
        att::Pre<8> PX;
        if ((P2_PARTS & 4) && cur < 1344) { CROSS_DECODE(cur, 1088, MK_e, MV_e); att::attn_preload<8>(PX, Qw, 2048); }
        while ((P2_PARTS & 4) && cur < 1344) {
            unsigned nxt_reg_ = 0u; if (F.tid == 0) nxt_reg_ = xb_add(qh, 1u);
            int nxt;
            { CROSS_DECODE(cur, 1088, MK_e, MV_e);
              f32x16 o[4]; float l;
              att::attn_core<8, 0, false>(PX, Kp, 512, Vp, 512, 4, 0, 0, 0, 0.f, 0.f, alds, o, l);
              if (F.tid == 0) MISC[12] = nxt_reg_; LDS_WAIT(); __syncthreads(); nxt = (int)MISC[12];
              bf16_t* Ow = DRY ? dummy : Qw; const bf16_t* GXw = GX_e + (size_t)(b * SEQ + qb * 256 + F.wave * 32) * 512 + 128 * hd;
              if (nxt < 1344) { CROSS_DECODE(nxt, 1088, MK_e, MV_e); att::attn_preload<8>(PX, Qw, 2048); }
              att::store_rows_bf16(o, l, Ow, DRY ? 32 : 2048, alds, GXw, 512); }
            cur = nxt;
        }
        asm volatile("" ::: "memory");
        while ((P2_PARTS & 8) && cur < 1600) {
            Q_PREFETCH(qh);
            { const int ch = (F.tid & 63) * 8, t0 = 64 * (cur - 1344) + 8 * (F.tid >> 6);
              const float* cw = args.in[9]; const float* cbp = args.in[10];
              u32x4 uin[10], gin[8];
              const bool halo = (t0 & (SEQ - 1)) != 0;
#pragma unroll
              for (int rr = 0; rr < 10; ++rr) { const size_t t = (size_t)((halo || rr >= 2) ? t0 - 2 + rr : t0); uin[rr] = *(const u32x4*)(R3 + t * 512 + ch); }
#pragma unroll
              for (int rr = 0; rr < 8; ++rr) gin[rr] = *(const u32x4*)(BB + (size_t)(t0 + rr) * 512 + ch);
              float w0[8], w1[8], w2[8], bsv[8], um2[8], um1[8];
#pragma unroll
              for (int j = 0; j < 8; ++j) { w0[j] = cw[ch + j]; w1[j] = cw[512 + ch + j]; w2[j] = cw[1024 + ch + j]; bsv[j] = cbp[ch + j]; }
#define CONV_U(dst, U_) do { dst[0] = bf_lo(U_.x); dst[1] = bf_hi(U_.x); dst[2] = bf_lo(U_.y); dst[3] = bf_hi(U_.y); dst[4] = bf_lo(U_.z); dst[5] = bf_hi(U_.z); dst[6] = bf_lo(U_.w); dst[7] = bf_hi(U_.w); } while (0)
              CONV_U(um2, uin[0]); CONV_U(um1, uin[1]);
              if (!halo) {
#pragma unroll
                  for (int j = 0; j < 8; ++j) { um2[j] = 0.f; um1[j] = 0.f; } }
#pragma unroll
              for (int rr = 0; rr < 8; ++rr) { const size_t t = (size_t)(t0 + rr);
                  float u0[8], gv[8], yv[8];
                  CONV_U(u0, uin[rr + 2]); CONV_U(gv, gin[rr]);
#pragma unroll
                  for (int j = 0; j < 8; ++j) { yv[j] = gv[j] * (w0[j] * um2[j] + w1[j] * um1[j] + w2[j] * u0[j] + bsv[j]); um2[j] = um1[j]; um1[j] = u0[j]; }
                  u32x4 w; w.x = cvtpk(yv[0], yv[1]); w.y = cvtpk(yv[2], yv[3]); w.z = cvtpk(yv[4], yv[5]); w.w = cvtpk(yv[6], yv[7]);
                  *(u32x4*)(DRY ? dummy + (rr & 7) * 64 : Y + t * 2048 + 1024 + ch) = w; }
#undef CONV_U
            }
            Q_NEXT();
        }
        asm volatile("" ::: "memory");
        while (cur < 2176) {
            Q_PREFETCH(qh);
            { const int n_ = 8 * (cur - 1600) + F.wave; P0Job jb{}; P0_DECODE(jb, (n_ < 1024 ? 3584 + n_ : 4096 + n_)); float vv[32];
              p0_load(jb, F.lane, vv); p0_finish(jb, F.lane, vv, (LAS float*)(F.lds + F.wave * 16384)); }
            Q_NEXT();
        }
    }
    SEAM(2);

    if (IN(4)) REPS(4) {
        pg8::Gemm g{Y, WO_e, M, DM, 2048}; pg8::StaticOrder S; S.init(M, DM, F.G, (int)blockIdx.x);
        pg8::EpiOut<true> E{xb, nullptr, R3, ssq1, DRY ? 1 : 0};
        pg8::gemm_phase<pg8::EpiOut<true>, pg8::StaticOrder, true>(F.lds, g, S, E);
    }
    SEAM(4);

    if (IN(5)) REPS(5) {
        for (int v = F.vcu; v < 256; v += F.G) {
            const int w4 = F.wave & 3, kh = F.wave >> 2, fr = F.lane & 15, fq = F.lane >> 4, row0 = 64 * v + 16 * w4;
            const bf16_t* ap = R3 + (size_t)(row0 + fr) * DM + kh * 512 + 8 * fq;
            const bf16_t* bp = (const bf16_t*)WF + (size_t)fr * DM + kh * 512 + 8 * fq;
            f32x4 facc = {0.f, 0.f, 0.f, 0.f};
#pragma unroll 8
            for (int ks = 0; ks < 16; ++ks) { const bf16x8 a = *(const bf16x8*)(ap + 32 * ks), bb = *(const bf16x8*)(bp + 32 * ks);
                facc = __builtin_amdgcn_mfma_f32_16x16x32_bf16(a, bb, facc, 0, 0, 0); }
            LAS f32x4* fx = (LAS f32x4*)F.lds + w4 * 64 + F.lane;
            if (kh == 1) *fx = facc;
            LDS_WAIT(); __syncthreads();
            if (kh == 0) { const f32x4 o2 = *fx; facc += o2;
                const float fbc = args.in[20][fr < 12 ? fr : 0];
                float sq[4];
#pragma unroll
                for (int r = 0; r < 4; ++r) sq[r] = ssq1[row0 + 4 * fq + r];
#pragma unroll
                for (int r = 0; r < 4; ++r) { const int row = row0 + 4 * fq + r;
                    const float f = facc[r] * __builtin_amdgcn_rsqf(sq[r] * (1.0f / DM) + EPS) + fbc;
                    const float ls = fminf(f, 0.f) - __logf(1.0f + __expf(-fabsf(f)));
                    if (fr < 12) LF[(size_t)row * 12 + fr] = ls; } }
            LDS_WAIT(); __syncthreads();
        }
        if (STAGGER_TICKS > 0 && ((blockIdx.x >> 3) & 1)) { const unsigned long long t0 = __builtin_amdgcn_s_memrealtime(); while (__builtin_amdgcn_s_memrealtime() - t0 < (unsigned long long)STAGGER_TICKS) __builtin_amdgcn_s_sleep(8); }
        pg8::Gemm g{R3, WA_o, M, 7168, DM}; pg8::StaticOrder S; S.init(M, 7168, F.G, (int)blockIdx.x);
        pg8::EpiProj E{1, nullptr, ssq1, Y, R1, R2, nullptr, nullptr, nullptr, nullptr, args.in[18], args.in[19], args.in[21], nullptr, xch, G1, nullptr};
        E.stage_gains((LAS float*)(F.lds + GAIN_OFF), F.tid);
        pg8::gemm_phase<pg8::EpiProj, pg8::StaticOrder, true>(F.lds, g, S, E);
    }
    SEAM(5);

    if (IN(6)) REPS(6) {
        bf16_t* dummy = (bf16_t*)(ws + WS_END) + (size_t)(F.vcu * 8 + F.wave) * 2048;
        unsigned* qh = ctl + CW_Q6 + (DRY ? 64 : 0);
        float eoff128, zbF;
        { float gq = fmaxf(fabsf(args.in[18][F.lane]), fabsf(args.in[18][64 + F.lane])), gk = fmaxf(fabsf(args.in[19][F.lane]), fabsf(args.in[19][64 + F.lane]));
#pragma unroll
          for (int o = 1; o < 64; o <<= 1) { gq = fmaxf(gq, __shfl_xor(gq, o)); gk = fmaxf(gk, __shfl_xor(gk, o)); }
          eoff128 = __builtin_bit_cast(float, __builtin_amdgcn_readfirstlane(__builtin_bit_cast(int, fmaxf(0.f, 11.3137085f * gq * gk * LOG2E - 100.0f))));
          zbF = __builtin_bit_cast(float, __builtin_amdgcn_readfirstlane(__builtin_bit_cast(int, (ZSKIP + 2.0f * 11.3137085f * gq * gk) * LOG2E))); }
        int cur; Q_POP_FIRST(qh);
#define FOX_DECODE(c_) const int qb = 7 - (c_) / 96, bh = (c_) % 96, b = bh / 12, h = bh % 12; \
              bf16_t* Qw = Y + (size_t)(b * SEQ + qb * 256 + F.wave * 32) * 2048 + 128 * h; \
              const bf16_t* Kp = R1 + (size_t)(b * SEQ) * 1536 + 128 * h; const bf16_t* Vp = R2 + (size_t)(b * SEQ) * 1536 + 128 * h
        att::Pre<8> PF; float lfp[4] = {0.f, 0.f, 0.f, 0.f};
#define FOX_LF_LOAD() do { const int n_ = 256 * (qb + 1), t0_ = 4 * F.tid; lfp[0] = lfp[1] = lfp[2] = lfp[3] = 0.f; \
            if (t0_ < n_) { const float* lf = LF + ((size_t)b * SEQ + t0_) * 12 + h; lfp[0] = lf[0]; lfp[1] = lf[12]; lfp[2] = lf[24]; lfp[3] = lf[36]; } } while (0)
        if (cur < 768) { FOX_DECODE(cur); att::attn_preload<8>(PF, Qw, 2048); FOX_LF_LOAD(); }
        while (cur < 768) {
            unsigned nxt_reg_ = 0u; if (F.tid == 0) nxt_reg_ = xb_add(qh, 1u);
            int nxt;
            { FOX_DECODE(cur);
              { const int n = 256 * (qb + 1), t0 = 4 * F.tid; const float v0 = lfp[0], v1 = lfp[1], v2 = lfp[2], v3 = lfp[3];
                const float s1 = v0, s2 = s1 + v1, s3 = s2 + v2, s4 = s3 + v3;
                float xs = s4;
#pragma unroll
                for (int off = 1; off < 64; off <<= 1) { const float t = __shfl_up(xs, off); if (F.lane >= off) xs += t; }
                LAS float* wtot = (LAS float*)(alds + att::SCAN_OFF);
                if (F.lane == 63) wtot[F.wave] = xs;
                LDS_WAIT(); __syncthreads();
                float pre = 0.f;
#pragma unroll
                for (int w = 0; w < 8; ++w) { const float t = wtot[w]; if (w < F.wave) pre += t; }
                const float ex = pre + (xs - s4);
                if (t0 < n) { LAS float* bl = (LAS float*)(alds + att::BIAS_OFF) + t0;
                    *(LAS f32x4*)bl = (f32x4){-(ex + s1) * LOG2E, -(ex + s2) * LOG2E, -(ex + s3) * LOG2E, -(ex + s4) * LOG2E}; }
              }
              f32x16 o[4]; float l;
              int jlo = 0;
              if (FOX_SKIP) { LDS_WAIT(); __syncthreads();
                  LAS const float* tb = (LAS const float*)(alds + att::BIAS_OFF);
                  const float d = tb[F.lane < 4 * qb ? 64 * F.lane + 63 : 0] - tb[256 * qb];
                  jlo = __builtin_popcountll(__ballot(F.lane < 4 * qb && d < -zbF)); }
              att::attn_core<8, 2, true>(PF, Kp + (size_t)(64 * jlo) * 1536, 1536, Vp + (size_t)(64 * jlo) * 1536, 1536, 4 * (qb + 1) - jlo, qb * 256 + F.wave * 32 - 64 * jlo, 0, 64 * jlo, 0.f, eoff128, alds, o, l);
              if (F.tid == 0) MISC[12] = nxt_reg_; LDS_WAIT(); __syncthreads(); nxt = (int)MISC[12];
              bf16_t* Ow = DRY ? dummy : Qw; const bf16_t* Gw = G1 + (size_t)(b * SEQ + qb * 256 + F.wave * 32) * 2048 + 128 * h;
              if (nxt < 768) { FOX_DECODE(nxt); att::attn_preload<8>(PF, Qw, 2048); FOX_LF_LOAD(); }
              att::store_rows_bf16(o, l, Ow, DRY ? 32 : 2048, alds, Gw, 2048); }
            cur = nxt;
        }
#undef FOX_DECODE
#undef FOX_LF_LOAD
        asm volatile("" ::: "memory");
        att::Pre<8> PX;
        if (cur < 1024) { CROSS_DECODE(cur, 768, MK_o, MV_o); att::attn_preload<8>(PX, Qw, 2048); }
        while (cur < 1024) {
            unsigned nxt_reg_ = 0u; if (F.tid == 0) nxt_reg_ = xb_add(qh, 1u);
            int nxt;
            { CROSS_DECODE(cur, 768, MK_o, MV_o);
              f32x16 o[4]; float l;
              att::attn_core<8, 0, false>(PX, Kp, 512, Vp, 512, 4, 0, 0, 0, 0.f, 0.f, alds, o, l);
              if (F.tid == 0) MISC[12] = nxt_reg_; LDS_WAIT(); __syncthreads(); nxt = (int)MISC[12];
              bf16_t* Ow = DRY ? dummy : Qw; const bf16_t* Gw = G1 + (size_t)(b * SEQ + qb * 256 + F.wave * 32) * 2048 + 1536 + 128 * hd;
              if (nxt < 1024) { CROSS_DECODE(nxt, 768, MK_o, MV_o); att::attn_preload<8>(PX, Qw, 2048); }
              att::store_rows_bf16(o, l, Ow, DRY ? 32 : 2048, alds, Gw, 2048); }
            cur = nxt;
        }
#undef CROSS_DECODE
        asm volatile("" ::: "memory");
        while (cur < 1152) {
            Q_PREFETCH(qh);
            { P0Job jb{}; P0_DECODE(jb, 8704 + 8 * (cur - 1024) + F.wave); float vv[32];
              p0_load(jb, F.lane, vv); p0_finish(jb, F.lane, vv, (LAS float*)(F.lds + F.wave * 16384)); }
            Q_NEXT();
        }
    }
    SEAM(6);

    if (IN(8)) REPS(8) {
        pg8::Gemm g{Y, WO_o, M, DM, 2048}; pg8::StaticOrder S; S.init(M, DM, F.G, (int)blockIdx.x);
        pg8::EpiOut<false> E{R3, hout, nullptr, nullptr, DRY ? 1 : 0};
        pg8::gemm_phase<pg8::EpiOut<false>, pg8::StaticOrder, true>(F.lds, g, S, E);
    }
#if PROBE_A >= 0
    xcd_barrier(bar); STAMP(9);
    if (blockIdx.x == 0) {
        const float ta = (float)(MISC[16 + PROBE_A + 1] - MISC[16 + PROBE_A]) * 0.000001f;
        const float tb = (PROBE_B >= 0) ? (float)(MISC[16 + (PROBE_B >= 0 ? PROBE_B : 0) + 1] - MISC[16 + (PROBE_B >= 0 ? PROBE_B : 0)]) * 0.0000025f : 0.05f;
        if (F.tid == 0) hout[0] += ta;
        for (int i = F.tid; i < (1 << 22); i += 512) hout[1024 + i] += tb;
    }
#endif
#undef P0_DECODE
#undef P0_IDX
#undef IN
#undef SEAM
#undef REPS
#undef DRY
}

extern "C" void kernel_launch(void* const* d_in, const int* in_sizes, int n_in, void* d_out, int out_size, void* d_ws, size_t ws_size, hipStream_t stream) {
    static int grid = 0;
    if (grid == 0) {
        if (n_in != 25 || in_sizes[0] != M * DM || out_size != M * DM || ws_size < WS_END) {
            fprintf(stderr, "kernel_launch: unexpected shapes (n_in %d, in0 %d, out %d, ws %zu); nothing launched\n", n_in, n_in > 0 ? in_sizes[0] : -1, out_size, ws_size); grid = -1; return; }
        int dev = 0, cus = 0, per_cu = 0;
        if (hipGetDevice(&dev) != hipSuccess || hipDeviceGetAttribute(&cus, hipDeviceAttributeMultiprocessorCount, dev) != hipSuccess) { fprintf(stderr, "kernel_launch: device query failed\n"); grid = -1; return; }
        if (hipFuncSetAttribute((const void*)hybrid_fwd, hipFuncAttributeMaxDynamicSharedMemorySize, LDS_BYTES) != hipSuccess) { fprintf(stderr, "kernel_launch: hipFuncSetAttribute failed\n"); grid = -1; return; }
        if (hipOccupancyMaxActiveBlocksPerMultiprocessor(&per_cu, (const void*)hybrid_fwd, 512, LDS_BYTES) != hipSuccess || per_cu < 1) {
            fprintf(stderr, "kernel_launch: occupancy query reports %d workgroups per CU\n", per_cu); per_cu = 1; }
        (void)hipGetLastError();
        grid = cus;
        if (grid > 256) grid = 256;
    }
    if (grid < 0) return;
    if (hipMemsetAsync((char*)d_ws + WS_CTL, 0, CTL_ZERO_BYTES, stream) != hipSuccess) { fprintf(stderr, "kernel_launch: memset failed\n"); return; }
    Args a{};
    for (int i = 0; i < 25; ++i) a.in[i] = (const float*)d_in[i];
    a.out = (float*)d_out; a.ws = (unsigned char*)d_ws;
    if (MK_N_LAUNCHES == 1) { a.ph_lo = 0; a.ph_hi = 9; hipLaunchKernelGGL(hybrid_fwd, dim3(grid), dim3(512), LDS_BYTES, stream, a); }
    else { for (int p = 0; p < 9; ++p) { a.ph_lo = p; a.ph_hi = p + 1; hipLaunchKernelGGL(hybrid_fwd, dim3(grid), dim3(512), LDS_BYTES, stream, a); } }
    const hipError_t le = hipPeekAtLastError();
    if (le != hipSuccess) fprintf(stderr, "kernel_launch: launch failed: %s\n", hipGetErrorName(le));
}
```

```cpp
#include <hip/hip_runtime.h>
#include <cstdio>
#include <cstdint>

#ifndef PROBE_A
#define PROBE_A -1
#define PROBE_B -1
#endif
#ifndef ZSKIP
#define ZSKIP 30.0f
#endif
#ifndef FOX_SKIP
#define FOX_SKIP 1
#endif
#ifndef DRY_MODE
#define DRY_MODE 1
#endif
#ifndef STAGGER_TICKS
#define STAGGER_TICKS 0
#endif
#ifndef DUP_MASK
#define DUP_MASK 0
#endif
#ifndef P2_PARTS
#define P2_PARTS 15
#endif
#ifndef MK_N_LAUNCHES
#define MK_N_LAUNCHES 1
#endif

#define LAS __attribute__((address_space(3)))
#define GAS __attribute__((address_space(1)))
typedef unsigned short bf16_t;
typedef short bf16x8 __attribute__((ext_vector_type(8)));
typedef short s16x4 __attribute__((ext_vector_type(4)));
typedef float f32x4 __attribute__((ext_vector_type(4)));
typedef float f32x2 __attribute__((ext_vector_type(2)));
typedef float f32x16 __attribute__((ext_vector_type(16)));
typedef unsigned u32x4 __attribute__((ext_vector_type(4)));
typedef unsigned u32x2 __attribute__((ext_vector_type(2)));
typedef __bf16 bf16x2_t __attribute__((ext_vector_type(2)));

constexpr int BATCH = 8, SEQ = 2048, DM = 1024, M = BATCH * SEQ;
constexpr int MEML = 256, MM = BATCH * MEML;
constexpr float EPS = 1e-6f;
constexpr float LOG2E = 1.4426950408889634f;
constexpr float C2_64 = 0.125f * LOG2E;
constexpr float C2_128 = 0.08838834764831845f * LOG2E;
constexpr float LAM_INIT = 0.2f;

constexpr size_t MiB = 1u << 20;
constexpr size_t WS_CTL = 0, CTL_ZERO_BYTES = 1 * MiB;
constexpr size_t WS_SSQ1 = 512 * 1024;
constexpr size_t WS_RSTD0 = 1 * MiB;
constexpr size_t WS_WF = 1 * MiB + 256 * 1024;
constexpr size_t WS_LF = 2 * MiB;
constexpr size_t WS_WA_E = 3 * MiB, WS_WG_E = 13 * MiB, WS_WO_E = 17 * MiB, WS_WM_E = 21 * MiB;
constexpr size_t WS_WA_O = 3 * MiB, WS_WG_O = 13 * MiB, WS_WO_O = 17 * MiB, WS_WM_O = 41 * MiB;
constexpr size_t WS_MEMN = 43 * MiB;
constexpr size_t WS_MK_E = 47 * MiB, WS_MV_E = 49 * MiB, WS_MK_O = 51 * MiB, WS_MV_O = 53 * MiB;
constexpr size_t WS_Y = 56 * MiB, WS_R1 = 120 * MiB, WS_R2 = 168 * MiB, WS_R3 = 216 * MiB, WS_END = 248 * MiB;
constexpr size_t WS_BB = WS_R1 + 32 * MiB;
constexpr int CW_BAR = 4096, CW_Q2 = 8192, CW_Q6 = 8448, CW_MKV = 8704;

constexpr int RING_BYTES = 131072;
constexpr int LDSCTL_OFF = RING_BYTES, MISC_OFF = LDSCTL_OFF + 320, XCH_OFF = LDSCTL_OFF + 1024;
constexpr int LDS_BYTES = 147456;

__device__ __forceinline__ unsigned cvtpk(float lo, float hi) { f32x2 v = {lo, hi}; bf16x2_t b = __builtin_convertvector(v, bf16x2_t); return __builtin_bit_cast(unsigned, b); }
__device__ __forceinline__ float bf_lo(unsigned w) { return __builtin_bit_cast(float, w << 16); }
__device__ __forceinline__ float bf_hi(unsigned w) { return __builtin_bit_cast(float, w & 0xffff0000u); }
__device__ __forceinline__ float wave_sum(float v) {
#pragma unroll
    for (int o = 1; o < 64; o <<= 1) v += __shfl_xor(v, o);
    return v;
}
template <int CTRL> __device__ __forceinline__ float dpp_mov(float v) { return __builtin_bit_cast(float, __builtin_amdgcn_update_dpp(0, __builtin_bit_cast(int, v), CTRL, 0xF, 0xF, true)); }
__device__ __forceinline__ float reduce8(const float (&d)[8], int lane) {
    float y[4];
#pragma unroll
    for (int i = 0; i < 4; ++i) { auto rr = __builtin_amdgcn_permlane32_swap(__float_as_uint(d[i]), __float_as_uint(d[i + 4]), false, false); y[i] = __uint_as_float(rr[0]) + __uint_as_float(rr[1]); }
    const bool b4 = (lane & 16) != 0, b3 = (lane & 8) != 0;
    float snd[2], kp[2], z[2];
#pragma unroll
    for (int j = 0; j < 2; ++j) { snd[j] = b4 ? y[j] : y[j + 2]; kp[j] = b4 ? y[j + 2] : y[j]; }
#pragma unroll
    for (int j = 0; j < 2; ++j) snd[j] = __shfl_xor(snd[j], 16);
#pragma unroll
    for (int j = 0; j < 2; ++j) z[j] = kp[j] + snd[j];
    const float s3 = b3 ? z[0] : z[1], k3 = b3 ? z[1] : z[0];
    float w = k3 + dpp_mov<0x128>(s3);
    w += dpp_mov<0xB1>(w); w += dpp_mov<0x4E>(w); w += dpp_mov<0x141>(w);
    return w;
}
#ifndef WT_STORES
#define WT_STORES 0
#endif
__device__ __forceinline__ void st16(void* p, u32x4 v) {
#if WT_STORES
    asm volatile("global_store_dwordx4 %0, %1, off sc1\n\ts_nop 1" :: "v"(p), "v"(v) : "memory");
#else
    *(u32x4*)p = v;
#endif
}
#ifndef EPI_TR
#define EPI_TR 1
#endif
__device__ __forceinline__ int tr_src4(int lane) { return 4 * ((lane >> 2) + 16 * (lane & 3)); }
__device__ __forceinline__ u32x4 lane_tr(u32x4 w, int src4) {
    w.x = (unsigned)__builtin_amdgcn_ds_bpermute(src4, (int)w.x); w.y = (unsigned)__builtin_amdgcn_ds_bpermute(src4, (int)w.y);
    w.z = (unsigned)__builtin_amdgcn_ds_bpermute(src4, (int)w.z); w.w = (unsigned)__builtin_amdgcn_ds_bpermute(src4, (int)w.w); return w; }
__device__ __forceinline__ u32x2 lane_tr(u32x2 w, int src4) {
    w.x = (unsigned)__builtin_amdgcn_ds_bpermute(src4, (int)w.x); w.y = (unsigned)__builtin_amdgcn_ds_bpermute(src4, (int)w.y); return w; }
#define LDS_WAIT() asm volatile("s_waitcnt lgkmcnt(0)" ::: "memory")
#define VM_WAIT() asm volatile("s_waitcnt vmcnt(0)" ::: "memory")

namespace pg8 {
constexpr int BM = 256, BK = 64, HALF = 128, HTB = HALF * BK * 2, STAGE_BYTES = 8 * HTB, NXCD = 8, WGM = 8;
__host__ __device__ __forceinline__ int lds_byte(int r, int c) { const int st = (r >> 4) * 2 + (c >> 5), rr = r & 15, cc = c & 31, ob = rr * 64 + cc * 2; return st * 1024 + (ob ^ (((ob >> 9) & 1) << 5)); }
__host__ __device__ __forceinline__ void stage_rc(int b, int& R, int& C) { const int st = b / 1024, sb = b % 1024, swz = sb ^ (((sb >> 9) & 1) << 5); R = (st >> 1) * 16 + swz / 64; C = (st & 1) * 32 + (swz % 64) / 2; }
__host__ __device__ __forceinline__ int perm32(int rho) { const int n = rho >> 4, i = rho & 15; return 8 * (i >> 2) + 4 * n + (i & 3); }
struct Unit { int pm, pn; };
struct Gemm { const bf16_t* A; const bf16_t* Bt; int M, N, K; };
struct StaticOrder {
    int nM, nN, nwg, G, c;
    __host__ __device__ void init(int M_, int N_, int G_, int c_) { nM = M_ / BM; nN = N_ / BM; nwg = nM * nN; G = G_; c = c_; }
    __host__ __device__ bool next(int i, Unit& u) const {
        const long L = (long)i * G + c; if (L >= nwg) return false;
        int wgid = (int)L; { const int q = nwg / NXCD, r = nwg % NXCD, xcd = wgid % NXCD, off = wgid / NXCD; wgid = (xcd < r ? xcd * (q + 1) : r * (q + 1) + (xcd - r) * q) + off; }
        const int nig = WGM * nN, gid = wgid / nig, fm = gid * WGM, gsz = (nM - fm) < WGM ? (nM - fm) : WGM;
        u.pm = fm + ((wgid % nig) % gsz); u.pn = (wgid % nig) / gsz; return true;
    }
};
struct OneUnit { int pm, pn; __host__ __device__ bool next(int i, Unit& u) const { if (i != 0) return false; u.pm = pm; u.pn = pn; return true; } };
template <class Epi, class Sched, bool ALIGN_EPI>
__device__ __forceinline__ void gemm_phase(LAS unsigned char* lds, const Gemm g, const Sched& S, const Epi& E) {
    const int tid = threadIdx.x, wid = __builtin_amdgcn_readfirstlane(tid >> 6), lane = tid & 63, wr = wid >> 2, wc = wid & 3, fr = lane & 15, fq = lane >> 4;
    const int K = g.K, nt = K / BK;
    unsigned voffA[2], voffB[2];
#pragma unroll
    for (int i = 0; i < 2; ++i) { int R, C; stage_rc(tid * 16 + i * 8192, R, C); const int Rb = (R & ~31) + perm32(R & 31);
        voffA[i] = (unsigned)(R * K + C) * 2u; voffB[i] = (unsigned)(Rb * K + C) * 2u; }
    const size_t kstep = (size_t)(BK * 2);
    const size_t hstep = (size_t)HALF * K * 2;
    const size_t tstep = 2 * hstep;
    const unsigned ldsw = (unsigned)wid * 1024u;
    const int aoff = lds_byte(wr * 64 + fr, fq * 8), boff = lds_byte(wc * 32 + fr, fq * 8);
#define PG8_SA(b, h) (((b) * 2 + (h)) * HTB)
#define PG8_SB(b, h) ((4 + (b) * 2 + (h)) * HTB)
#define PG8_STAGE(bufoff, gbase, voff) do { _Pragma("unroll") for (int _i = 0; _i < 2; ++_i) \
        __builtin_amdgcn_global_load_lds((const unsigned*)((const char*)(gbase) + (voff)[_i]), (LAS unsigned*)(lds + (bufoff) + ldsw + _i * 8192), 16, 0, 0); } while (0)
#define PG8_LDA(dst, b, h) do { _Pragma("unroll") for (int m = 0; m < 4; ++m) _Pragma("unroll") for (int k = 0; k < 2; ++k) dst[m][k] = *(const LAS bf16x8*)(lds + PG8_SA(b, h) + aoff + m * 2048 + k * 1024); } while (0)
#define PG8_LDB(dst, b, h) do { _Pragma("unroll") for (int n = 0; n < 2; ++n) _Pragma("unroll") for (int k = 0; k < 2; ++k) dst[n][k] = *(const LAS bf16x8*)(lds + PG8_SB(b, h) + boff + n * 2048 + k * 1024); } while (0)
#define PG8_MMA(ai, bj, At, Bt) do { __builtin_amdgcn_s_setprio(1); _Pragma("unroll") for (int m = 0; m < 4; ++m) _Pragma("unroll") for (int n = 0; n < 2; ++n) _Pragma("unroll") for (int k = 0; k < 2; ++k) \
        acc[ai][bj][m][n] = __builtin_amdgcn_mfma_f32_16x16x32_bf16(Bt[n][k], At[m][k], acc[ai][bj][m][n], 0, 0, 0); __builtin_amdgcn_s_setprio(0); } while (0)
#define PG8_WAIT_V(n) asm volatile("s_waitcnt vmcnt(" #n ")" ::: "memory")
#define PG8_WAIT_L(n) asm volatile("s_waitcnt lgkmcnt(" #n ")" ::: "memory")
#define PG8_BAR __builtin_amdgcn_s_barrier()
#define PG8_SCHED __builtin_amdgcn_sched_barrier(0)
    Unit cur, nxt; int ui = 0;
    if (!S.next(0, cur)) return;
    f32x4 acc[2][2][4][2];
    bf16x8 At[4][2], B0[2][2], B1[2][2];
    const char* cA = (const char*)g.A + (size_t)cur.pm * tstep; const char* cB = (const char*)g.Bt + (size_t)cur.pn * tstep;
    typename Epi::Init ini;
    E.init_load(ini, cur, wr, wc, fr, fq);
    PG8_STAGE(PG8_SB(0, 0), cB, voffB); PG8_STAGE(PG8_SB(0, 1), cB + hstep, voffB); PG8_STAGE(PG8_SA(0, 0), cA, voffA); PG8_STAGE(PG8_SA(0, 1), cA + hstep, voffA);
    E.init_acc(acc, ini);
    if (wr == 1) PG8_BAR;
    PG8_WAIT_V(2); PG8_BAR;
    PG8_STAGE(PG8_SB(1, 0), cB + kstep, voffB); PG8_STAGE(PG8_SA(1, 0), cA + kstep, voffA); PG8_STAGE(PG8_SB(1, 1), cB + hstep + kstep, voffB);
    PG8_WAIT_V(6); PG8_BAR;
    for (;;) {
        const bool has_next = S.next(ui + 1, nxt);
        const char* nA = has_next ? (const char*)g.A + (size_t)nxt.pm * tstep : cA; const char* nB = has_next ? (const char*)g.Bt + (size_t)nxt.pn * tstep : cB;
        for (int t = 0; t < nt; t += 2) {
            const bool last = (t == nt - 2);
            const char* a1 = cA + (size_t)(t + 1) * kstep;
            const char* a2 = last ? nA : cA + (size_t)(t + 2) * kstep; const char* b2 = last ? nB : cB + (size_t)(t + 2) * kstep;
            const char* a3 = a2 + kstep; const char* b3 = b2 + kstep;
            PG8_LDB(B0, 0, 0); PG8_LDB(B1, 0, 1); PG8_SCHED; PG8_LDA(At, 0, 0); PG8_STAGE(PG8_SA(1, 1), a1 + hstep, voffA);
            PG8_WAIT_V(8); PG8_WAIT_L(0); PG8_BAR; PG8_MMA(0, 0, At, B0); PG8_MMA(0, 1, At, B1); PG8_BAR; PG8_SCHED;
            PG8_LDA(At, 0, 1); PG8_STAGE(PG8_SB(0, 0), b2, voffB); PG8_STAGE(PG8_SB(0, 1), b2 + hstep, voffB); PG8_STAGE(PG8_SA(0, 0), a2, voffA);
            PG8_WAIT_V(8); PG8_WAIT_L(0); PG8_BAR; PG8_MMA(1, 0, At, B0); PG8_MMA(1, 1, At, B1); PG8_BAR; PG8_SCHED;
            PG8_LDB(B0, 1, 0); PG8_LDB(B1, 1, 1); PG8_SCHED; PG8_LDA(At, 1, 0); PG8_STAGE(PG8_SA(0, 1), a2 + hstep, voffA);
            PG8_WAIT_V(8); PG8_WAIT_L(0); PG8_BAR; PG8_MMA(0, 0, At, B0); PG8_MMA(0, 1, At, B1); PG8_BAR; PG8_SCHED;
            PG8_LDA(At, 1, 1); PG8_STAGE(PG8_SB(1, 0), b3, voffB); PG8_STAGE(PG8_SB(1, 1), b3 + hstep, voffB); PG8_STAGE(PG8_SA(1, 0), a3, voffA);
            PG8_WAIT_V(8); PG8_WAIT_L(0); PG8_BAR; PG8_MMA(1, 0, At, B0); PG8_MMA(1, 1, At, B1); PG8_BAR; PG8_SCHED;
        }
        if constexpr (ALIGN_EPI) { if (wr == 0) PG8_BAR; }
        E(acc, cur, wr, wc, fr, fq, ini);
        if (!has_next) break;
#pragma unroll
        for (int a = 0; a < 2; ++a)
#pragma unroll
            for (int b = 0; b < 2; ++b)
#pragma unroll
                for (int m = 0; m < 4; ++m)
#pragma unroll
                    for (int n = 0; n < 2; ++n) acc[a][b][m][n] = (f32x4){0.f, 0.f, 0.f, 0.f};
        cur = nxt; cA = nA; cB = nB; ++ui;
        if constexpr (Epi::RESID) { E.init_load(ini, cur, wr, wc, fr, fq); E.init_acc(acc, ini); }
        if constexpr (ALIGN_EPI) { if (wr == 1) PG8_BAR; }
    }
    PG8_WAIT_V(0);
    if constexpr (!ALIGN_EPI) { if (wr == 0) PG8_BAR; }
    PG8_BAR;
#undef PG8_SA
#undef PG8_SB
#undef PG8_STAGE
#undef PG8_LDA
#undef PG8_LDB
#undef PG8_MMA
#undef PG8_WAIT_V
#undef PG8_WAIT_L
#undef PG8_BAR
#undef PG8_SCHED
}

struct TileDesc { int mode; bf16_t* dst; int ld; const float* g; float ps; };
struct EpiProj {
    int kind;
    const float* rstd;
    const float* ssq;
    bf16_t *Y, *R1, *R2, *R3, *BB, *MK, *MV;
    const float *g_q, *g_k, *g_xq, *g_xk;
    LAS float* xch; bf16_t* GA; bf16_t* GX;
    struct Init { float rv[2][4]; };
    static constexpr bool RESID = true;
    __device__ __forceinline__ void init_load(Init& I, const Unit& u, int wr, int wc, int fr, int fq) const {
        const float* src = kind == 0 ? rstd : ssq;
#pragma unroll
        for (int ai = 0; ai < 2; ++ai)
#pragma unroll
            for (int m = 0; m < 4; ++m) I.rv[ai][m] = kind <= 1 ? src[u.pm * BM + ai * HALF + wr * 64 + m * 16 + fr] : 1.f;
    }
    __device__ __forceinline__ void init_acc(f32x4 (&acc)[2][2][4][2], const Init&) const {
#pragma unroll
        for (int a = 0; a < 2; ++a)
#pragma unroll
            for (int b = 0; b < 2; ++b)
#pragma unroll
                for (int m = 0; m < 4; ++m)
#pragma unroll
                    for (int n = 0; n < 2; ++n) acc[a][b][m][n] = (f32x4){0.f, 0.f, 0.f, 0.f};
    }
    __device__ __forceinline__ TileDesc desc(int pn) const {
        TileDesc d; d.mode = 0; d.dst = nullptr; d.ld = 0; d.g = nullptr; d.ps = 1.f;
        if (kind == 0) {
            if (pn < 4) { d.mode = 1; d.dst = Y + 256 * pn; d.ld = 2048; d.g = g_q; d.ps = C2_64; }
            else if (pn < 8) { d.mode = 1; d.dst = R1 + 256 * (pn - 4); d.ld = 1024; d.g = g_k; }
            else if (pn < 12) { d.dst = R2 + 256 * (pn - 8); d.ld = 1024; }
            else if (pn < 16) { d.mode = 4; d.dst = R3 + 128 * (pn - 12); d.ld = 512; }
            else if (pn < 18) { d.mode = 5; d.dst = BB + 128 * (pn - 16); d.ld = 512; }
            else if (pn < 20) { d.mode = 2; d.dst = Y + 1536 + 256 * (pn - 18); d.ld = 2048; d.g = g_xq; d.ps = C2_128; }
            else if (pn < 24) { d.mode = 3; d.dst = GA + 256 * (pn - 20); d.ld = 1024; }
            else if (pn < 26) { d.mode = 5; d.dst = BB + 256 + 128 * (pn - 24); d.ld = 512; }
            else { d.mode = 3; d.dst = GX + 256 * (pn - 26); d.ld = 512; }
        } else if (kind == 1) {
            if (pn < 6) { d.mode = 2; d.dst = Y + 256 * pn; d.ld = 2048; d.g = g_q; d.ps = C2_128; }
            else if (pn < 12) { d.mode = 2; d.dst = R1 + 256 * (pn - 6); d.ld = 1536; d.g = g_k; }
            else if (pn < 18) { d.dst = R2 + 256 * (pn - 12); d.ld = 1536; }
            else if (pn < 20) { d.mode = 2; d.dst = Y + 1536 + 256 * (pn - 18); d.ld = 2048; d.g = g_xq; d.ps = C2_128; }
            else { d.mode = 3; d.dst = GA + 256 * (pn - 20); d.ld = 2048; }
        } else {
            if (pn < 2) { d.mode = 2; d.dst = MK + 256 * pn; d.ld = 512; d.g = g_xk; }
            else { d.dst = MV + 256 * (pn - 2); d.ld = 512; }
        }
        return d;
    }
    __device__ __forceinline__ float rowscale(float raw) const {
        if (kind == 0) return raw;
        if (kind == 1) return __builtin_amdgcn_rsqf(raw * (1.0f / DM) + EPS);
        return 1.f;
    }
    __device__ __forceinline__ void operator()(const f32x4 (&acc)[2][2][4][2], const Unit& u, int wr, int wc, int fr, int fq, const Init& I) const {
        const TileDesc d = desc(u.pn);
        const int cl = 64 * wc + 8 * fq;
        f32x4 gv[2][2];
#pragma unroll
        for (int bj = 0; bj < 2; ++bj)
#pragma unroll
            for (int n = 0; n < 2; ++n) gv[bj][n] = (f32x4){d.ps, d.ps, d.ps, d.ps};
        if (d.mode == 1 || d.mode == 2) {
            const int gi = (d.mode == 2 ? 64 * (wc & 1) : 0) + 8 * fq;
#pragma unroll
            for (int bj = 0; bj < 2; ++bj)
#pragma unroll
                for (int n = 0; n < 2; ++n) gv[bj][n] = *(const f32x4*)(d.g + gi + 32 * bj + 4 * n) * d.ps;
        }
        float rf[2][4];
#pragma unroll
        for (int ai = 0; ai < 2; ++ai)
#pragma unroll
            for (int m = 0; m < 4; ++m) rf[ai][m] = rowscale(I.rv[ai][m]);
        if (d.mode == 1 || d.mode == 2) {
            float ss[2][4];
#pragma unroll
            for (int ai = 0; ai < 2; ++ai)
#pragma unroll
                for (int m = 0; m < 4; ++m) { float s0 = 0.f;
#pragma unroll
                    for (int bj = 0; bj < 2; ++bj)
#pragma unroll
                        for (int n = 0; n < 2; ++n) { const f32x4 v = acc[ai][bj][m][n]; s0 += (v[0] * v[0] + v[1] * v[1]) + (v[2] * v[2] + v[3] * v[3]); }
                    ss[ai][m] = s0 * rf[ai][m] * rf[ai][m]; }
#pragma unroll
            for (int ai = 0; ai < 2; ++ai)
#pragma unroll
                for (int m = 0; m < 4; ++m) ss[ai][m] += __shfl_xor(ss[ai][m], 16);
#pragma unroll
            for (int ai = 0; ai < 2; ++ai)
#pragma unroll
                for (int m = 0; m < 4; ++m) { auto rr = __builtin_amdgcn_permlane32_swap(__float_as_uint(ss[ai][m]), __float_as_uint(ss[ai][m]), false, false); ss[ai][m] = __uint_as_float(rr[0]) + __uint_as_float(rr[1]); }
            if (d.mode == 2) {
#pragma unroll
                for (int ai = 0; ai < 2; ++ai)
#pragma unroll
                    for (int m = 0; m < 4; ++m) if (fq == 0) xch[(ai * HALF + wr * 64 + m * 16 + fr) * 4 + wc] = ss[ai][m];
                asm volatile("s_waitcnt lgkmcnt(0)" ::: "memory"); __builtin_amdgcn_s_barrier(); asm volatile("" ::: "memory");
#pragma unroll
                for (int ai = 0; ai < 2; ++ai)
#pragma unroll
                    for (int m = 0; m < 4; ++m) ss[ai][m] += xch[(ai * HALF + wr * 64 + m * 16 + fr) * 4 + (wc ^ 1)];
            }
            const float inv = d.mode == 2 ? (1.0f / 128.0f) : (1.0f / 64.0f);
#pragma unroll
            for (int ai = 0; ai < 2; ++ai)
#pragma unroll
                for (int m = 0; m < 4; ++m) rf[ai][m] *= __builtin_amdgcn_rsqf(ss[ai][m] * inv + EPS);
        }
        asm volatile("" :: "v"(rf[0][0]), "v"(rf[0][1]), "v"(rf[0][2]), "v"(rf[0][3]), "v"(rf[1][0]), "v"(rf[1][1]), "v"(rf[1][2]), "v"(rf[1][3]), "v"(gv[0][0]), "v"(gv[0][1]), "v"(gv[1][0]), "v"(gv[1][1]));
        switch (d.mode) {
            case 0: store_tile<0>(acc, d, rf, gv, u, wr, wc, fr, fq); break;
            case 1: case 2: store_tile<1>(acc, d, rf, gv, u, wr, wc, fr, fq); break;
            case 3: store_tile<3>(acc, d, rf, gv, u, wr, wc, fr, fq); break;
            case 4: store_tile<4>(acc, d, rf, gv, u, wr, wc, fr, fq); break;
            default: store_tile<5>(acc, d, rf, gv, u, wr, wc, fr, fq); break;
        }
    }
    template <int MODE>
    __device__ __forceinline__ void store_tile(const f32x4 (&acc)[2][2][4][2], const TileDesc& d, const float (&rf)[2][4], const f32x4 (&gv)[2][2], const Unit& u, int wr, int wc, int fr, int fq) const {
        const int lane_ = fr + 16 * fq, src4 = tr_src4(lane_);
        const int clS = 64 * wc + 8 * (lane_ & 3);
        bf16_t* base = d.dst + (size_t)(u.pm * BM + wr * 64 + (lane_ >> 2)) * d.ld + (MODE >= 4 ? (clS >> 1) : clS);
        const size_t ld16 = (size_t)16 * d.ld;
#pragma unroll
        for (int ai = 0; ai < 2; ++ai) {
        u32x4 wq[1][4][2];
#pragma unroll
            for (int m = 0; m < 4; ++m) {
                const float rs = rf[ai][m];
#pragma unroll
                for (int bj = 0; bj < 2; ++bj) {
                    if (MODE >= 4) {
                        f32x4 v0 = acc[ai][bj][m][0] * rs, v1 = acc[ai][bj][m][1] * rs;
                        if (MODE == 5) {
#pragma unroll
                            for (int i = 0; i < 4; ++i) v1[i] *= __builtin_amdgcn_rcpf(1.0f + __builtin_amdgcn_exp2f(-v1[i] * LOG2E)); }
                        v0 *= v1;
                        u32x2 w; w.x = cvtpk(v0[0], v0[1]); w.y = cvtpk(v0[2], v0[3]);
                        w = lane_tr(w, src4);
                        wq[0][m][bj].x = w.x; wq[0][m][bj].y = w.y;
                    } else {
                        f32x4 v0, v1;
                        if (MODE == 1) { v0 = acc[ai][bj][m][0] * (gv[bj][0] * rs); v1 = acc[ai][bj][m][1] * (gv[bj][1] * rs); }
                        else { v0 = acc[ai][bj][m][0] * rs; v1 = acc[ai][bj][m][1] * rs; }
                        if (MODE == 3) {
#pragma unroll
                            for (int i = 0; i < 4; ++i) { v0[i] *= __builtin_amdgcn_rcpf(1.0f + __builtin_amdgcn_exp2f(-v0[i] * LOG2E)); v1[i] *= __builtin_amdgcn_rcpf(1.0f + __builtin_amdgcn_exp2f(-v1[i] * LOG2E)); } }
                        u32x4 w; w.x = cvtpk(v0[0], v0[1]); w.y = cvtpk(v0[2], v0[3]); w.z = cvtpk(v1[0], v1[1]); w.w = cvtpk(v1[2], v1[3]);
                        wq[0][m][bj] = lane_tr(w, src4);
                    }
                }
            }
#pragma unroll
            for (int m = 0; m < 4; ++m) {
                bf16_t* rowp = base + (size_t)(ai * 8 + m) * ld16;
#pragma unroll
                for (int bj = 0; bj < 2; ++bj) {
                    if (MODE >= 4) { u32x2 w; w.x = wq[0][m][bj].x; w.y = wq[0][m][bj].y; *(u32x2*)(rowp + 16 * bj) = w; }
                    else st16(rowp + 32 * bj, wq[0][m][bj]);
                }
            }
        }
    }
};
template <bool FIRST> struct EpiOut {
    const bf16_t* base; float* hout; bf16_t* hb; float* ssq; int dry;
    struct Init { u32x4 b[2][4][2]; };
    static constexpr bool RESID = true;
    __device__ __forceinline__ void init_load(Init& I, const Unit& u, int wr, int wc, int fr, int fq) const {
        const int cl = u.pn * BM + 64 * wc + 8 * fq;
#pragma unroll
        for (int ai = 0; ai < 2; ++ai)
#pragma unroll
            for (int m = 0; m < 4; ++m)
#pragma unroll
                for (int bj = 0; bj < 2; ++bj) I.b[ai][m][bj] = *(const u32x4*)(base + (size_t)(u.pm * BM + ai * HALF + wr * 64 + m * 16 + fr) * DM + cl + 32 * bj);
    }
    __device__ __forceinline__ void init_acc(f32x4 (&acc)[2][2][4][2], const Init& I) const {
#pragma unroll
        for (int ai = 0; ai < 2; ++ai)
#pragma unroll
            for (int m = 0; m < 4; ++m)
#pragma unroll
                for (int bj = 0; bj < 2; ++bj) { const u32x4 bv = I.b[ai][m][bj];
                    acc[ai][bj][m][0] = (f32x4){bf_lo(bv.x), bf_hi(bv.x), bf_lo(bv.y), bf_hi(bv.y)}; acc[ai][bj][m][1] = (f32x4){bf_lo(bv.z), bf_hi(bv.z), bf_lo(bv.w), bf_hi(bv.w)}; }
    }
    __device__ __forceinline__ void operator()(const f32x4 (&acc)[2][2][4][2], const Unit& u, int wr, int wc, int fr, int fq, const Init&) const {
        const int cl = u.pn * BM + 64 * wc + 8 * fq;
        float sr[2][4];
#pragma unroll
        for (int ai = 0; ai < 2; ++ai) {
#pragma unroll
            for (int m = 0; m < 4; ++m) {
                const int row = u.pm * BM + ai * HALF + wr * 64 + m * 16 + fr; const size_t off = (size_t)row * DM + cl; float s = 0.f;
#pragma unroll
                for (int bj = 0; bj < 2; ++bj) {
                    const f32x4 h0 = acc[ai][bj][m][0], h1 = acc[ai][bj][m][1];
                    if (FIRST) {
                        u32x4 w; w.x = cvtpk(h0[0], h0[1]); w.y = cvtpk(h0[2], h0[3]); w.z = cvtpk(h1[0], h1[1]); w.w = cvtpk(h1[2], h1[3]);
                        st16(hb + off + 32 * bj, w);
                        s += (h0[0] * h0[0] + h0[1] * h0[1]) + (h0[2] * h0[2] + h0[3] * h0[3]) + (h1[0] * h1[0] + h1[1] * h1[1]) + (h1[2] * h1[2] + h1[3] * h1[3]);
                    } else { *(f32x4*)(hout + off + 32 * bj) = h0; *(f32x4*)(hout + off + 32 * bj + 4) = h1; }
                }
                sr[ai][m] = s;
            }
        }
        if (FIRST) {
#pragma unroll
            for (int ai = 0; ai < 2; ++ai)
#pragma unroll
                for (int m = 0; m < 4; ++m) sr[ai][m] += __shfl_xor(sr[ai][m], 16);
#pragma unroll
            for (int ai = 0; ai < 2; ++ai)
#pragma unroll
                for (int m = 0; m < 4; ++m) { auto rr = __builtin_amdgcn_permlane32_swap(__float_as_uint(sr[ai][m]), __float_as_uint(sr[ai][m]), false, false);
                    const float t = __uint_as_float(rr[0]) + __uint_as_float(rr[1]);
                    if (fq == 0) atomicAdd(ssq + u.pm * BM + ai * HALF + wr * 64 + m * 16 + fr, t); }
        }
    }
};
}

namespace att {
constexpr int NW = 8, QBLK = 32, KVBLK = 64;
constexpr int SHM_V = 16384, SHM_K = 16384, NSTG = 3, K_OFF = 0, V_OFF = NSTG * SHM_K;
constexpr int XSTG_END = 69632, WS_OFF = 98304, BIAS_OFF = 100352, SCAN_OFF = 108544;
constexpr float THR = 8.f;
#define KSWZ(row, colB) ((row) * 256 + ((colB) ^ (((row) & 7) << 4)))
#define SBAR() __builtin_amdgcn_sched_barrier(0)
__device__ __forceinline__ int v_st(int k, int c) { const int kk = (k & ~0xC) | ((k & 4) << 1) | ((k & 8) >> 1); return ((kk >> 3) * 4 + (c >> 5)) * 512 + ((kk & 7) * 32 + (c & 31)) * 2; }
__device__ __forceinline__ int v_rd_base(int lane) { return ((lane & 3) << 3) | (((lane >> 2) & 3) << 6) | (((lane >> 4) & 1) << 5) | (((lane >> 5) & 1) << 8); }
constexpr int v_rd_off(int d0, int ks, int half) { return d0 * 512 + ks * 4096 + half * 2048; }
__device__ __forceinline__ int crow(int r, int hi) { return (r & 3) + 8 * (r >> 2) + 4 * hi; }
__device__ __forceinline__ void mask_causal(f32x16& p0, f32x16& p1, int dq) {
    const float NEG = -__builtin_inff();
#pragma unroll
    for (int r = 0; r < 16; ++r) { const int c = (r & 3) + 8 * (r >> 2); if (dq - c < 0) p0[r] = NEG; if (dq - c - 32 < 0) p1[r] = NEG; }
}
__device__ __forceinline__ f32x16 ninf16() { const float n = -__builtin_inff(); return (f32x16){n, n, n, n, n, n, n, n, n, n, n, n, n, n, n, n}; }
template <bool ADD> __device__ __forceinline__ void partialSM(f32x16& p0, f32x16& p1, float rowc) {
    if (ADD) {
#pragma unroll
        for (int r = 0; r < 16; ++r) p0[r] += rowc;
#pragma unroll
        for (int r = 0; r < 16; ++r) p1[r] += rowc;
    }
#pragma unroll
    for (int r = 0; r < 16; ++r) p0[r] = __builtin_amdgcn_exp2f(p0[r]);
}
__device__ __forceinline__ void finishSM(f32x16& p0, f32x16& p1, float& l_reg, bf16x8& pa0, bf16x8& pa1, bf16x8& pa2, bf16x8& pa3) {
#pragma unroll
    for (int r = 0; r < 16; ++r) p1[r] = __builtin_amdgcn_exp2f(p1[r]);
    float ps = 0;
#pragma unroll
    for (int r = 0; r < 16; ++r) ps += p0[r];
#pragma unroll
    for (int r = 0; r < 16; ++r) ps += p1[r];
    { auto rr = __builtin_amdgcn_permlane32_swap(__float_as_uint(ps), __float_as_uint(ps), false, false);
      ps = __uint_as_float(rr[0]) + __uint_as_float(rr[1]); }
    l_reg += ps;
#define PK4(P, B_, OUT) do { unsigned a0 = cvtpk(P[B_+0], P[B_+1]), a1 = cvtpk(P[B_+2], P[B_+3]);                          \
        unsigned b0 = cvtpk(P[B_+4], P[B_+5]), b1 = cvtpk(P[B_+6], P[B_+7]);                                             \
        auto r0 = __builtin_amdgcn_permlane32_swap(a0, b0, false, false); auto r1 = __builtin_amdgcn_permlane32_swap(a1, b1, false, false); \
        u32x4 w = {r0[0], r1[0], r0[1], r1[1]}; OUT = __builtin_bit_cast(bf16x8, w); } while (0)
    PK4(p0, 0, pa0); PK4(p0, 8, pa1); PK4(p1, 0, pa2); PK4(p1, 8, pa3);
#undef PK4
}
template <int ND, int BIAS>
__device__ __forceinline__ void qkt(f32x16& p0, f32x16& p1, LAS const char* K_lds  , int ksub, int r32, int hi, const bf16x8* qr, LAS const float* bl) {
    if (BIAS) {
#pragma unroll
        for (int g = 0; g < 4; ++g) { const f32x4 a = *(LAS const f32x4*)(bl + 8 * g), b = *(LAS const f32x4*)(bl + 32 + 8 * g);
            p0[4 * g] = a[0]; p0[4 * g + 1] = a[1]; p0[4 * g + 2] = a[2]; p0[4 * g + 3] = a[3]; p1[4 * g] = b[0]; p1[4 * g + 1] = b[1]; p1[4 * g + 2] = b[2]; p1[4 * g + 3] = b[3]; }
    } else { p0 = f32x16{}; p1 = f32x16{}; }
    LAS const char* kb[4];
    int r32v = r32; asm volatile("" : "+v"(r32v));
#pragma unroll
    for (int dd = 0; dd < 4; ++dd) kb[dd] = K_lds + KSWZ(r32v, (dd * 16 + hi * 8) * 2) + ksub;
#pragma unroll
    for (int d0 = 0; d0 < ND; ++d0) { LAS const char* a = kb[d0 & 3] + (d0 >> 2) * 128;
        const bf16x8 b0 = *(LAS const bf16x8*)(a);
        const bf16x8 b1 = *(LAS const bf16x8*)(a + 32 * 256);
        p0 = __builtin_amdgcn_mfma_f32_32x32x16_bf16(b0, qr[d0], p0, 0, 0, 0);
        p1 = __builtin_amdgcn_mfma_f32_32x32x16_bf16(b1, qr[d0], p1, 0, 0, 0); }
}
__device__ __forceinline__ void pv_tile(f32x16* o, int vb0  , bf16x8 pa0, bf16x8 pa1, bf16x8 pa2, bf16x8 pa3) {
#define TRRD(dst, off) asm volatile("ds_read_b64_tr_b16 %0, %1 offset:%2" : "=&v"(dst) : "v"(vb0), "i"(off) : "memory")
#define PV_D0(d0) do { s16x4 l0, l1, l2, l3, h0, h1, h2, h3; constexpr int b_ = v_rd_off(d0, 0, 0); \
        TRRD(l0, b_); TRRD(h0, b_ + 2048); TRRD(l1, b_ + 4096); TRRD(h1, b_ + 6144); TRRD(l2, b_ + 8192); TRRD(h2, b_ + 10240); TRRD(l3, b_ + 12288); TRRD(h3, b_ + 14336); \
        asm volatile("s_waitcnt lgkmcnt(0)" ::: "memory"); SBAR(); \
        o[d0] = __builtin_amdgcn_mfma_f32_32x32x16_bf16(pa0, (bf16x8){l0[0], l0[1], l0[2], l0[3], h0[0], h0[1], h0[2], h0[3]}, o[d0], 0, 0, 0);   \
        o[d0] = __builtin_amdgcn_mfma_f32_32x32x16_bf16(pa1, (bf16x8){l1[0], l1[1], l1[2], l1[3], h1[0], h1[1], h1[2], h1[3]}, o[d0], 0, 0, 0);   \
        o[d0] = __builtin_amdgcn_mfma_f32_32x32x16_bf16(pa2, (bf16x8){l2[0], l2[1], l2[2], l2[3], h2[0], h2[1], h2[2], h2[3]}, o[d0], 0, 0, 0);   \
        o[d0] = __builtin_amdgcn_mfma_f32_32x32x16_bf16(pa3, (bf16x8){l3[0], l3[1], l3[2], l3[3], h3[0], h3[1], h3[2], h3[3]}, o[d0], 0, 0, 0); } while (0)
    PV_D0(0); PV_D0(1); PV_D0(2); PV_D0(3);
#undef PV_D0
#undef TRRD
}
template <int ND> struct Pre { bf16x8 qr[ND]; };
template <int ND>
__device__ __forceinline__ void attn_preload(Pre<ND>& P, const bf16_t* Qw, int qp) {
    int tid = threadIdx.x; asm volatile("" : "+v"(tid));
    const int lane = tid & 63, r32 = lane & 31, hi = lane >> 5;
#pragma unroll
    for (int d0 = 0; d0 < ND; ++d0) P.qr[d0] = *(const bf16x8*)(Qw + (size_t)r32 * qp + d0 * 16 + hi * 8);
}
template <int ND, int BIAS, bool CAUSAL>
__device__ __forceinline__ void attn_core(Pre<ND>& P, const bf16_t* Kp, int kp, const bf16_t* Vp, int vp, int NT, int qlo, int ksub, int tsh, float tslope, float eoff,
                                          LAS char* lds, f32x16 (&o)[4], float& l_out) {
    int tid = threadIdx.x; asm volatile("" : "+v"(tid));
    const int wid = __builtin_amdgcn_readfirstlane(tid >> 6), lane = tid & 63, r32 = lane & 31, hi = lane >> 5;
    LAS char* K_lds = lds + K_OFF; LAS char* V_lds = lds + V_OFF;
    LAS const float* biasL = (LAS const float*)(lds + BIAS_OFF) + tsh + 4 * hi;
    const int vb0 = (int)(unsigned)(uintptr_t)V_lds + v_rd_base(lane);
    const int qm = qlo + r32 - 4 * hi;
    const int tl = __builtin_amdgcn_readfirstlane((qlo + 31) >> 6);
    bf16x8 (&qr)[ND] = P.qr;
    const bf16_t* ksrc[2]; const bf16_t* vsrc[2];
#pragma unroll
    for (int i = 0; i < 2; ++i) { const int p = 2 * wid + i;
        const int row = 4 * p + (lane >> 4); ksrc[i] = Kp + (size_t)row * kp + 8 * ((lane & 15) ^ (row & 7));
        const int sbt = 2 * p + (lane >> 5), kk = (sbt >> 2) * 8 + ((lane & 31) >> 2), c = 32 * (sbt & 3) + 8 * (lane & 3), k = (kk & ~0xC) | ((kk & 4) << 1) | ((kk & 8) >> 1);
        vsrc[i] = Vp + (size_t)k * vp + c; }
    const size_t ktile = (size_t)KVBLK * kp, vtile = (size_t)KVBLK * vp;
#define DMA_K(t_, stg) do { const int tt_ = (t_) < NT ? (t_) : NT - 1; _Pragma("unroll") for (int i_ = 0; i_ < 2; ++i_) \
        __builtin_amdgcn_global_load_lds((const unsigned*)(ksrc[i_] + (size_t)tt_ * ktile), (LAS unsigned*)(K_lds + (stg) + (2 * wid + i_) * 1024), 16, 0, 0); } while (0)
#define DMA_V(t_, stg) do { const int tt_ = (t_) < NT ? (t_) : NT - 1; _Pragma("unroll") for (int i_ = 0; i_ < 2; ++i_) \
        __builtin_amdgcn_global_load_lds((const unsigned*)(vsrc[i_] + (size_t)tt_ * vtile), (LAS unsigned*)(V_lds + (stg) + (2 * wid + i_) * 1024), 16, 0, 0); } while (0)
#define WAIT_BAR(N) asm volatile("s_waitcnt vmcnt(" #N ") lgkmcnt(0)\n\ts_barrier" ::: "memory")
#define MASKT(P0_, P1_, t) do { if (CAUSAL) { const int kb_ = (t) * KVBLK; if (kb_ + KVBLK - 1 > qlo) { asm volatile("" ::: "memory"); mask_causal(P0_, P1_, qm - kb_); } } } while (0)
#define BL(t) (biasL + (BIAS == 2 ? (t) * KVBLK : 0))
#define ROWC(t) (BIAS == 1 ? rowc + tslope * (float)(t) : rowc)
    float l_reg = 0.f, rowc = -eoff;
#pragma unroll
    for (int d_ = 0; d_ < 4; ++d_) o[d_] = f32x16{};
    f32x16 pA0, pA1, pB0, pB1; bf16x8 pa0, pa1, pa2, pa3;
    int s_m1 = 2 * SHM_K, s_0 = 0, s_p1 = SHM_K, s_p2 = 2 * SHM_K;
#define ROT() do { s_m1 = s_0; s_0 = s_p1; s_p1 = s_p2; s_p2 = (s_p2 == 2 * SHM_K) ? 0 : s_p2 + SHM_K; } while (0)
    DMA_K(0, 0); DMA_V(0, 0); DMA_K(1, SHM_K);
    asm volatile("s_waitcnt vmcnt(2)" ::: "memory");
    __builtin_amdgcn_s_barrier(); asm volatile("" ::: "memory");
    if (BIAS == 2) rowc -= ((LAS const float*)(lds + BIAS_OFF))[tsh + qlo + r32];
    if (BIAS == 1) rowc -= (tslope * (1.0f / 64.0f)) * (float)(qlo + r32);
    DMA_K(2, 2 * SHM_K); DMA_V(1, SHM_V);
    SBAR(); qkt<ND, BIAS>(pA0, pA1, K_lds + s_0, ksub, r32, hi, qr, BL(0));
    MASKT(pA0, pA1, 0); partialSM<BIAS != 0>(pA0, pA1, ROWC(0));
    WAIT_BAR(4);
    ROT();
#define STEP(PX0, PX1, PY0, PY1, t) do { \
        DMA_K((t) + 2, s_p2); DMA_V((t) + 1, s_p1); \
        const bool act_ = !CAUSAL || (t) <= tl;       \
        SBAR(); if (act_) qkt<ND, BIAS>(PX0, PX1, K_lds + s_0, ksub, r32, hi, qr, BL(t)); \
        if (!CAUSAL || (t) - 1 <= tl) { finishSM(PY0, PY1, l_reg, pa0, pa1, pa2, pa3); SBAR(); \
            pv_tile(o, vb0 + s_m1, pa0, pa1, pa2, pa3); }       \
        if (act_) { MASKT(PX0, PX1, (t)); partialSM<BIAS != 0>(PX0, PX1, ROWC(t)); } else { PX0 = f32x16{}; PX1 = ninf16(); }   \
        WAIT_BAR(4); \
        ROT(); } while (0)
    int t = 1;
    for (; t + 1 < NT; t += 2) {
        STEP(pB0, pB1, pA0, pA1, t);
        STEP(pA0, pA1, pB0, pB1, t + 1);
    }
    const bool even = (NT & 1) == 0;
    const bool actL = !CAUSAL || NT - 1 <= tl;
    if (even && actL) { SBAR(); qkt<ND, BIAS>(pB0, pB1, K_lds + s_0, ksub, r32, hi, qr, BL(NT - 1)); SBAR(); }
    if (!CAUSAL || (even ? NT - 2 : NT - 1) <= tl) { finishSM(pA0, pA1, l_reg, pa0, pa1, pa2, pa3); SBAR();
        pv_tile(o, vb0 + s_m1, pa0, pa1, pa2, pa3); }
    if (even) { if (actL) { MASKT(pB0, pB1, NT - 1); partialSM<BIAS != 0>(pB0, pB1, ROWC(NT - 1)); } WAIT_BAR(0);
        if (actL) { finishSM(pB0, pB1, l_reg, pa0, pa1, pa2, pa3); SBAR(); pv_tile(o, vb0 + s_0, pa0, pa1, pa2, pa3); } }
    asm volatile("s_waitcnt vmcnt(0)" ::: "memory");
    l_out = l_reg;
#undef DMA_K
#undef DMA_V
#undef WAIT_BAR
#undef MASKT
#undef BL
#undef ROWC
#undef ROT
#undef STEP
}
__device__ __forceinline__ void store_rows_bf16(const f32x16 (&o)[4], float l_reg, bf16_t* Ow, int op, LAS char* lds, const bf16_t* Gw, int gp) {
    int tid = threadIdx.x; asm volatile("" : "+v"(tid));
    const int wid = __builtin_amdgcn_readfirstlane(tid >> 6), lane = tid & 63, r32 = lane & 31, hi = lane >> 5;
    LAS float* li_l = (LAS float*)(lds + WS_OFF) + wid * 64;
    if (hi == 0) li_l[r32] = l_reg;
    asm volatile("s_waitcnt lgkmcnt(0)" ::: "memory");
    float rli[16];
#pragma unroll
    for (int r = 0; r < 16; ++r) rli[r] = __builtin_amdgcn_rcpf(li_l[crow(r, hi)]);
    u32x4 gin[8];
#pragma unroll
    for (int i = 0; i < 8; ++i) { const int id = i * 64 + lane, row = id >> 4, ch = id & 15; gin[i] = *(const u32x4*)(Gw + (size_t)row * gp + ch * 8); }
    __syncthreads();
    LAS bf16_t* stg = (LAS bf16_t*)lds + wid * (32 * 136);
#pragma unroll
    for (int r = 0; r < 16; ++r) { const int orow = crow(r, hi);
#pragma unroll
        for (int d0 = 0; d0 < 4; ++d0) { const unsigned w = cvtpk(o[d0][r] * rli[r], 0.f); stg[orow * 136 + d0 * 32 + r32] = (bf16_t)(w & 0xffffu); } }
    asm volatile("s_waitcnt lgkmcnt(0)" ::: "memory");
#pragma unroll
    for (int i = 0; i < 8; ++i) { const int id = i * 64 + lane, row = id >> 4, ch = id & 15;
        const u32x4 v = *(LAS const u32x4*)(stg + row * 136 + ch * 8); const u32x4 gq = gin[i]; u32x4 w;
        w.x = cvtpk(bf_lo(v.x) * bf_lo(gq.x), bf_hi(v.x) * bf_hi(gq.x)); w.y = cvtpk(bf_lo(v.y) * bf_lo(gq.y), bf_hi(v.y) * bf_hi(gq.y));
        w.z = cvtpk(bf_lo(v.z) * bf_lo(gq.z), bf_hi(v.z) * bf_hi(gq.z)); w.w = cvtpk(bf_lo(v.w) * bf_lo(gq.w), bf_hi(v.w) * bf_hi(gq.w));
        st16(Ow + (size_t)row * op + ch * 8, w); }
    asm volatile("s_waitcnt lgkmcnt(0)" ::: "memory");
    __syncthreads();
}
#undef KSWZ
#undef SBAR
}

typedef GAS unsigned gu32;
#define RLX_AGENT __ATOMIC_RELAXED, __HIP_MEMORY_SCOPE_AGENT
#define XB_TMO      128
#define XB_XCNT(j)  (256  + 64 * (j))
#define XB_XSUB(j)  (1280 + 64 * (j))
#define XB_XGEN(j)  (2304 + 64 * (j))
#define XB_TOP      3328
#define XB_TOPGEN   3392
#define XCD_BAR_WORDS 3456
#define XB_SPIN_CAP (1u << 18)
__device__ __forceinline__ unsigned xb_ld(unsigned* p)              { return __hip_atomic_load(p, __ATOMIC_RELAXED, __HIP_MEMORY_SCOPE_AGENT); }
__device__ __forceinline__ unsigned xb_add(unsigned* p, unsigned v) { return __hip_atomic_fetch_add(p, v, __ATOMIC_RELAXED, __HIP_MEMORY_SCOPE_AGENT); }
__device__ __forceinline__ unsigned xb_xcc_id() { return (unsigned)__builtin_amdgcn_s_getreg((3 << 11) | 20) & 0xFu; }
#define XB_SPIN(cond, bar) do { unsigned _sp = 0; while (cond) { __builtin_amdgcn_s_sleep(1); \
    if ((++_sp & 255u) == 0u) { if (xb_ld(&(bar)[XB_TMO])) break; if (_sp > XB_SPIN_CAP) { atomicAdd(&(bar)[XB_TMO], 1u); break; } } } } while (0)
struct XcdBarrier { unsigned* bar; unsigned x; volatile LAS unsigned* st; };
__device__ __forceinline__ XcdBarrier xcd_barrier_post(unsigned* bar, volatile LAS unsigned* st) {
    XcdBarrier b; b.bar = bar; b.x = xb_xcc_id(); b.st = st;
    if (threadIdx.x == 0) (void)xb_add(&bar[XB_XCNT(b.x)], 1u);
    return b;
}
__device__ __forceinline__ void xcd_barrier_complete(unsigned* bar, unsigned x, unsigned& nloc, unsigned& nx) {
    const unsigned G = gridDim.x * gridDim.y * gridDim.z;
    unsigned sum, cnt, mine, sp = 0u;
    for (;;) {
        sum = 0u; cnt = 0u; mine = 0u;
#pragma unroll
        for (unsigned j = 0; j < 16; ++j) { const unsigned c = xb_ld(&bar[XB_XCNT(j)]); sum += c; cnt += (c > 0u) ? 1u : 0u; mine = (j == x) ? c : mine; }
        if (sum == G) break;
        __builtin_amdgcn_s_sleep(1);
        if ((++sp & 255u) == 0u) { if (xb_ld(&bar[XB_TMO])) break; if (sp > XB_SPIN_CAP) { atomicAdd(&bar[XB_TMO], 1u); break; } }
    }
    nloc = mine > 0u ? mine : 1u; nx = cnt > 0u ? cnt : 1u;
}
__device__ __forceinline__ void xcd_barrier(const XcdBarrier& b) {
    asm volatile("s_waitcnt vmcnt(0)" ::: "memory");
    __syncthreads();
    if (threadIdx.x == 0) {
        unsigned* bar = b.bar;
        __builtin_amdgcn_s_waitcnt(0);
        unsigned nloc = b.st[0], nx = b.st[1];
        if (nloc == 0u) { xcd_barrier_complete(bar, b.x, nloc, nx); b.st[0] = nloc; b.st[1] = nx; }
        const unsigned old = xb_add(&bar[XB_XSUB(b.x)], 1u);
        const unsigned gen = old / nloc;
        if (old + 1u == (gen + 1u) * nloc) {
            __builtin_amdgcn_fence(__ATOMIC_RELEASE, "agent");
            asm volatile("s_waitcnt vmcnt(0)" ::: "memory");
            const unsigned og = xb_add(&bar[XB_TOP], 1u);
            const unsigned tg = og / nx;
            if (og + 1u == (tg + 1u) * nx) xb_add(&bar[XB_TOPGEN], 1u);
            else XB_SPIN(xb_ld(&bar[XB_TOPGEN]) == tg, bar);
            __builtin_amdgcn_fence(__ATOMIC_ACQUIRE, "agent");
            xb_add(&bar[XB_XGEN(b.x)], 1u);
            asm volatile("s_waitcnt vmcnt(0)" ::: "memory");
        } else {
            XB_SPIN(xb_ld(&bar[XB_XGEN(b.x)]) == gen, bar);
            __builtin_amdgcn_fence(__ATOMIC_ACQUIRE, "agent");
            asm volatile("s_waitcnt vmcnt(0)" ::: "memory");
        }
    }
    __syncthreads();
}

struct Args { const float* in[25]; float* out; unsigned char* ws; int ph_lo, ph_hi; };
struct Frame {
    LAS unsigned char* lds;
    int tid, lane, wave, vcu, G;
    unsigned char* ws;
};

struct P0Job { const float* W; const float* g; bf16_t* dst; int ldw, src0, K, dst0, nblk, r, src1; };
__device__ __forceinline__ void p0_load(const P0Job& j, int lane, float (&v)[32]) {
    const int kb = j.r / j.nblk, nb = j.r % j.nblk;
    const int n = lane & 31;
    const int col = j.src1 > 0 ? ((n & 4) ? j.src1 : j.src0) + 16 * nb + 4 * (n >> 3) + (n & 3) : j.src0 + 32 * nb + n;
    const float* src = j.W + (size_t)(64 * kb) * j.ldw + col + (size_t)(lane >> 5) * j.ldw;
#pragma unroll
    for (int i = 0; i < 32; ++i) v[i] = src[(size_t)(2 * i) * j.ldw];
}
__device__ __forceinline__ void p0_finish(const P0Job& j, int lane, const float (&v)[32], LAS float* scr) {
    const int kb = j.r / j.nblk, nb = j.r % j.nblk, k0 = 64 * kb;
    const int L = j.dst0 + 32 * nb, c = L & 255, rowbase = (L & ~255) + 128 * ((c >> 5) & 1) + 32 * (c >> 6);
#pragma unroll
    for (int i = 0; i < 32; ++i) scr[(2 * i + (lane >> 5)) * 33 + (lane & 31)] = v[i];
    LDS_WAIT(); asm volatile("" ::: "memory");
    const int cc = lane & 7;
    f32x4 g0 = {1.f, 1.f, 1.f, 1.f}, g1 = {1.f, 1.f, 1.f, 1.f};
    if (j.g) { g0 = *(const f32x4*)(j.g + k0 + 8 * cc); g1 = *(const f32x4*)(j.g + k0 + 8 * cc + 4); }
#pragma unroll
    for (int jj = 0; jj < 4; ++jj) { const int n = (lane >> 3) + 8 * jj; const LAS float* sp = scr + (8 * cc) * 33 + n;
        u32x4 o; o.x = cvtpk(sp[0 * 33] * g0[0], sp[1 * 33] * g0[1]); o.y = cvtpk(sp[2 * 33] * g0[2], sp[3 * 33] * g0[3]);
        o.z = cvtpk(sp[4 * 33] * g1[0], sp[5 * 33] * g1[1]); o.w = cvtpk(sp[6 * 33] * g1[2], sp[7 * 33] * g1[3]);
        *(u32x4*)(j.dst + (size_t)(rowbase + n) * j.K + k0 + 8 * cc) = o; }
    LDS_WAIT(); asm volatile("" ::: "memory");
}
template <bool NORM> __device__ __forceinline__ void row_to_bf16(const float* xrow, bf16_t* orow, float* rstd_out, int lane) {
    const f32x4* xr = (const f32x4*)xrow + lane;
    f32x4 v[4]; float s = 0.f;
#pragma unroll
    for (int j = 0; j < 4; ++j) { v[j] = xr[64 * j]; s += (v[j].x * v[j].x + v[j].y * v[j].y) + (v[j].z * v[j].z + v[j].w * v[j].w); }
    const float rstd = 1.0f / sqrtf(wave_sum(s) * (1.0f / DM) + EPS);
    const float sc = NORM ? rstd : 1.f;
    u32x2* o8 = (u32x2*)orow + lane;
#pragma unroll
    for (int j = 0; j < 4; ++j) { u32x2 w; w.x = cvtpk(v[j].x * sc, v[j].y * sc); w.y = cvtpk(v[j].z * sc, v[j].w * sc); o8[64 * j] = w; }
    if (rstd_out && lane == 0) *rstd_out = rstd;
}

__global__ void __launch_bounds__(512, 2) hybrid_fwd(Args args) {
    extern __shared__ __attribute__((aligned(16))) unsigned char lds_raw[];
    Frame F;
    F.lds = (LAS unsigned char*)lds_raw;
    F.tid = threadIdx.x; F.lane = F.tid & 63; F.wave = __builtin_amdgcn_readfirstlane(F.tid >> 6);
    F.G = gridDim.x; { const int bx = blockIdx.x; F.vcu = (F.G % 8 == 0) ? (bx % 8) * (F.G / 8) + bx / 8 : bx; }
    F.ws = args.ws;
    unsigned char* ws = args.ws;
    volatile LAS unsigned* MISC = (volatile LAS unsigned*)(F.lds + MISC_OFF);
    for (int u = F.tid; u < (LDS_BYTES - LDSCTL_OFF) / 4; u += 512) ((LAS unsigned*)(F.lds + LDSCTL_OFF))[u] = 0u;
    __syncthreads();
    unsigned* ctl = (unsigned*)(ws + WS_CTL);
    XcdBarrier bar; bar.bar = ctl + CW_BAR; bar.x = 0; bar.st = nullptr;
    if (MK_N_LAUNCHES == 1) bar = xcd_barrier_post(ctl + CW_BAR, MISC + 8);
    const int lo = args.ph_lo, hi_ph = args.ph_hi;
#ifndef PHASE_MASK
#define PHASE_MASK 0x1ff
#endif
#define IN(k) (((PHASE_MASK >> (k)) & 1) && lo <= (k) && (k) < hi_ph)
#if DUP_MASK
#define REPS(k) for (int rep_ = ((DUP_MASK >> (k)) & 1) ? 0 : 1; rep_ < 2; ++rep_)
#define DRY (rep_ == 0)
#else
#define REPS(k)
#define DRY false
#endif
#if PROBE_A >= 0
#define STAMP(k) do { if (blockIdx.x == 0 && F.tid == 0) MISC[16 + (k)] = (unsigned)__builtin_amdgcn_s_memrealtime(); } while (0)
#else
#define STAMP(k)
#endif
#define SEAM(k) do { if (MK_N_LAUNCHES == 1 && IN(k) && (IN((k) + 1) || (((k) == 2 || (k) == 6) && IN((k) + 2)))) xcd_barrier(bar); STAMP((k) + 1); } while (0)

    const float* x = args.in[0]; const float* mem = args.in[1];
    bf16_t* xb = (bf16_t*)args.out;
    float* hout = args.out;
    float* rstd0 = (float*)(ws + WS_RSTD0); float* ssq1 = (float*)(ws + WS_SSQ1); float* WF = (float*)(ws + WS_WF); float* LF = (float*)(ws + WS_LF);
    bf16_t *WA_e = (bf16_t*)(ws + WS_WA_E), *WG_e = (bf16_t*)(ws + WS_WG_E), *WO_e = (bf16_t*)(ws + WS_WO_E), *WM_e = (bf16_t*)(ws + WS_WM_E);
    bf16_t *WA_o = (bf16_t*)(ws + WS_WA_O), *WG_o = (bf16_t*)(ws + WS_WG_O), *WO_o = (bf16_t*)(ws + WS_WO_O), *WM_o = (bf16_t*)(ws + WS_WM_O);
    bf16_t *memn = (bf16_t*)(ws + WS_MEMN), *MK_e = (bf16_t*)(ws + WS_MK_E), *MV_e = (bf16_t*)(ws + WS_MV_E), *MK_o = (bf16_t*)(ws + WS_MK_O), *MV_o = (bf16_t*)(ws + WS_MV_O);
    bf16_t *Y = (bf16_t*)(ws + WS_Y), *R1 = (bf16_t*)(ws + WS_R1), *R2 = (bf16_t*)(ws + WS_R2), *R3 = (bf16_t*)(ws + WS_R3), *BB = (bf16_t*)(ws + WS_BB);
    LAS float* xch = (LAS float*)(F.lds + XCH_OFF);
    bf16_t* GA_e = (bf16_t*)args.out + (size_t)M * 1024;
    bf16_t* GX_e = R2 + (size_t)M * 1024;
    bf16_t* G1 = (bf16_t*)args.out;
    LAS char* alds = (LAS char*)F.lds;

    STAMP(0);
    if (IN(0)) REPS(0) {
        LAS float* scr = (LAS float*)(F.lds + F.wave * 16384);
        const int gw = F.vcu * 8 + F.wave, NGW = F.G * 8;
#define P0_DECODE(J, it_) do { int r = (it_); \
            if (r < 16 * 96) { J = P0Job{args.in[3], args.in[2], WA_e, 7168, 0, 1024, 0, 96, r}; break; } r -= 16 * 96;              \
            if (r < 16 * 32) { J = P0Job{args.in[3], args.in[2], WA_e, 7168, 4096, 1024, 3072, 32, r, 4608}; break; } r -= 16 * 32;   \
            if (r < 16 * 16) { J = P0Job{args.in[3], args.in[2], WA_e, 7168, 5120, 1024, 4096, 16, r, 5632}; break; } r -= 16 * 16;   \
            if (r < 16 * 16) { J = P0Job{args.in[3], args.in[2], WA_e, 7168, 6144, 1024, 4608, 16, r}; break; } r -= 16 * 16;        \
            if (r < 16 * 32) { J = P0Job{args.in[3], args.in[2], WG_e, 7168, 3072, 1024, 0, 32, r}; break; } r -= 16 * 32;           \
            if (r < 16 * 16) { J = P0Job{args.in[3], args.in[2], WG_e, 7168, 5376, 1024, 1024, 16, r, 5888}; break; } r -= 16 * 16;   \
            if (r < 16 * 16) { J = P0Job{args.in[3], args.in[2], WG_e, 7168, 6656, 1024, 1536, 16, r}; break; } r -= 16 * 16;        \
            if (r < 32 * 32) { J = P0Job{args.in[4], nullptr, WO_e, 1024, 0, 2048, 0, 32, r}; break; } r -= 32 * 32;                 \
            if (r < 16 * 32) { J = P0Job{args.in[14], args.in[13], WM_e, 1024, 0, 1024, 0, 32, r}; break; } r -= 16 * 32;            \
            if (r < 16 * 144) { J = P0Job{args.in[16], args.in[15], WA_o, 7180, 0, 1024, 0, 144, r}; break; } r -= 16 * 144;         \
            if (r < 16 * 16) { J = P0Job{args.in[16], args.in[15], WA_o, 7180, 6156, 1024, 4608, 16, r}; break; } r -= 16 * 16;      \
            if (r < 16 * 48) { J = P0Job{args.in[16], args.in[15], WG_o, 7180, 4608, 1024, 0, 48, r}; break; } r -= 16 * 48;         \
            if (r < 16 * 16) { J = P0Job{args.in[16], args.in[15], WG_o, 7180, 6668, 1024, 1536, 16, r}; break; } r -= 16 * 16;      \
            if (r < 32 * 32) { J = P0Job{args.in[17], nullptr, WO_o, 1024, 0, 2048, 0, 32, r}; break; } r -= 32 * 32; \
            J = P0Job{args.in[24], args.in[23], WM_o, 1024, 0, 1024, 0, 32, r}; } while (0)
        { int it = gw; P0Job cur{}, nxt{}; float va[32], vb[32];
#define P0_IDX(i_) ((i_) < 3584 ? (i_) : (i_) < 4096 ? (i_) + 1024 : (i_) + 5632)
          if (it < 4608) { P0_DECODE(cur, P0_IDX(it)); p0_load(cur, F.lane, va); }
          while (it < 4608) {
              const int itn = it + NGW; const bool hn = itn < 4608;
              if (hn) { P0_DECODE(nxt, P0_IDX(itn)); p0_load(nxt, F.lane, vb); }
              p0_finish(cur, F.lane, va, scr);
#pragma unroll
              for (int i = 0; i < 32; ++i) va[i] = vb[i];
              cur = nxt; it = itn;
          } }
        for (int m = gw; m < M; m += 4 * NGW) {
            f32x4 v[4][4]; float ss[4];
#pragma unroll
            for (int q = 0; q < 4; ++q) { const int mq = (m + q * NGW < M) ? m + q * NGW : m; const f32x4* xr = (const f32x4*)(x + (size_t)mq * DM) + F.lane;
#pragma unroll
                for (int j = 0; j < 4; ++j) v[q][j] = xr[64 * j]; }
#pragma unroll
            for (int q = 0; q < 4; ++q) { float t = 0.f;
#pragma unroll
                for (int j = 0; j < 4; ++j) t += (v[q][j].x * v[q][j].x + v[q][j].y * v[q][j].y) + (v[q][j].z * v[q][j].z + v[q][j].w * v[q][j].w);
                ss[q] = t; }
#pragma unroll
            for (int o = 1; o < 64; o <<= 1) {
#pragma unroll
                for (int q = 0; q < 4; ++q) ss[q] += __shfl_xor(ss[q], o); }
#pragma unroll
            for (int q = 0; q < 4; ++q) { const int mm = m + q * NGW; if (mm >= M) continue; u32x2* o8 = (u32x2*)(xb + (size_t)mm * DM) + F.lane;
#pragma unroll
                for (int j = 0; j < 4; ++j) { u32x2 w; w.x = cvtpk(v[q][j].x, v[q][j].y); w.y = cvtpk(v[q][j].z, v[q][j].w); o8[64 * j] = w; }
                if (F.lane == 0) rstd0[mm] = 1.0f / sqrtf(ss[q] * (1.0f / DM) + EPS); }
        }
        for (int m = gw; m < MM; m += NGW) row_to_bf16<true>(mem + (size_t)m * DM, memn + (size_t)m * DM, nullptr, F.lane);
        for (int i = (F.vcu * 512 + F.tid); i < 16 * 1024; i += F.G * 512) { const int c = i >> 10, k = i & 1023;
            const float wv_ = c < 12 ? args.in[15][k] * args.in[16][(size_t)k * 7180 + 6144 + c] : 0.f; ((bf16_t*)WF)[i] = (bf16_t)(cvtpk(wv_, 0.f) & 0xffffu); }
    }
    SEAM(0);

    if (IN(1)) REPS(1) {
        if (STAGGER_TICKS > 0 && ((blockIdx.x >> 3) & 1)) { const unsigned long long t0 = __builtin_amdgcn_s_memrealtime(); while (__builtin_amdgcn_s_memrealtime() - t0 < (unsigned long long)STAGGER_TICKS) __builtin_amdgcn_s_sleep(8); }
        pg8::Gemm g{xb, WA_e, M, 7168, DM}; pg8::StaticOrder S; S.init(M, 7168, F.G, (int)blockIdx.x);
        pg8::EpiProj E{0, rstd0, nullptr, Y, R1, R2, R3, BB, nullptr, nullptr, args.in[5], args.in[6], args.in[11], nullptr, xch, GA_e, GX_e};
        pg8::gemm_phase<pg8::EpiProj, pg8::StaticOrder, true>(F.lds, g, S, E);
    }
    SEAM(1);

#define Q_POP_FIRST(qh) do { if (F.tid == 0) MISC[12] = xb_add((qh), 1u); LDS_WAIT(); __syncthreads(); cur = (int)MISC[12]; __syncthreads(); } while (0)
#define Q_PREFETCH(qh) unsigned nxt_reg_ = 0u; if (F.tid == 0) nxt_reg_ = xb_add((qh), 1u)
#define Q_NEXT() do { if (F.tid == 0) MISC[12] = nxt_reg_; LDS_WAIT(); __syncthreads(); cur = (int)MISC[12]; __syncthreads(); } while (0)
    if (IN(2)) REPS(2) {
        bf16_t* dummy = (bf16_t*)(ws + WS_END) + (size_t)(F.vcu * 8 + F.wave) * 2048;
        unsigned* qh = ctl + CW_Q2 + (DRY ? 64 : 0); unsigned* mkv_done = ctl + CW_MKV;
        const int r32 = F.lane & 31, hi = F.lane >> 5;
        float lam;
        { const float* lp = args.in[7]; const float a = wave_sum(lp[F.lane] * lp[64 + F.lane]), b = wave_sum(lp[128 + F.lane] * lp[192 + F.lane]);
          lam = __builtin_bit_cast(float, __builtin_amdgcn_readfirstlane(__builtin_bit_cast(int, expf(a) - expf(b) + LAM_INIT))); }
        float zb, b2;
        { float gq = fabsf(args.in[5][F.lane]), gk = fabsf(args.in[6][F.lane]);
#pragma unroll
          for (int o = 1; o < 64; o <<= 1) { gq = fmaxf(gq, __shfl_xor(gq, o)); gk = fmaxf(gk, __shfl_xor(gk, o)); }
          b2 = __builtin_bit_cast(float, __builtin_amdgcn_readfirstlane(__builtin_bit_cast(int, 16.0f * gq * gk))); zb = ZSKIP + b2; }
        const float eoff64 = fmaxf(0.f, b2 * 0.5f * LOG2E - 100.0f);
        int cur; Q_POP_FIRST(qh);
        while ((P2_PARTS & 1) && cur < 64) {
            Q_PREFETCH(qh);
            { const int lay = cur >> 5, uu = cur & 31; pg8::OneUnit S{uu >> 2, uu & 3};
              pg8::Gemm g{memn, lay ? WM_o : WM_e, MM, 1024, DM};
              pg8::EpiProj E{2, nullptr, nullptr, nullptr, nullptr, nullptr, nullptr, nullptr, lay ? MK_o : MK_e, lay ? MV_o : MV_e, nullptr, nullptr, nullptr, lay ? args.in[22] : args.in[12], xch, nullptr, nullptr};
              pg8::gemm_phase<pg8::EpiProj, pg8::OneUnit, true>(F.lds, g, S, E);
              if (F.tid == 0 && !DRY) { __builtin_amdgcn_fence(__ATOMIC_RELEASE, "agent"); asm volatile("s_waitcnt vmcnt(0)" ::: "memory"); xb_add(mkv_done, 1u); } }
            Q_NEXT();
        }
        asm volatile("" ::: "memory");
#define DIFF_DECODE(c_) const int j = (c_) - 64, qb = 15 - (j >> 6), bh = j & 63, b = bh >> 3, h = bh & 7, sub = F.wave >> 2, w4 = sub ? 3 - (F.wave & 3) : (F.wave & 3);     \
              const float slope = exp2f(-(float)(h + 1)), cslope = slope * LOG2E; \
              int jlo = 0; { const float dz = zb / slope, q0f = (float)(qb * 128); if (q0f > dz) jlo = (int)((q0f - dz) * (1.0f / 64.0f)); } \
              const size_t row0 = (size_t)b * SEQ + qb * 128; \
              bf16_t* Qw = Y + (row0 + w4 * 32) * 2048 + 128 * h + 64 * sub; \
              const bf16_t* Kp = R1 + (size_t)(b * SEQ + 64 * jlo) * 1024 + 128 * h; const bf16_t* Vp = R2 + (size_t)(b * SEQ + 64 * jlo) * 1024 + 128 * h
        att::Pre<4> PD;
        if ((P2_PARTS & 2) && cur < 1088) { DIFF_DECODE(cur); att::attn_preload<4>(PD, Qw, 2048); }
        while ((P2_PARTS & 2) && cur < 1088) {
            unsigned nxt_reg_ = 0u; if (F.tid == 0) nxt_reg_ = xb_add(qh, 1u);
            int nxt;
            { DIFF_DECODE(cur);
              if (F.tid < 64) ((LAS float*)(alds + att::BIAS_OFF))[F.tid] = cslope * (float)F.tid;
              f32x16 o[4]; float l;
              att::attn_core<4, 1, true>(PD, Kp, 1024, Vp, 1024, 2 * (qb + 1) - jlo, qb * 128 + w4 * 32 - 64 * jlo, 128 * sub, 0, cslope * 64.f, eoff64, alds, o, l);
              if (F.tid == 0) MISC[12] = nxt_reg_; LDS_WAIT(); __syncthreads(); nxt = (int)MISC[12];
              if (nxt < 1088) { DIFF_DECODE(nxt); att::attn_preload<4>(PD, Qw, 2048); }
              const int chq = F.lane & 15;
              LAS float* li_l = (LAS float*)(alds + att::WS_OFF) + F.wave * 64;
              if (hi == 0) li_l[r32] = l;
              LDS_WAIT();
              float rli[16];
#pragma unroll
              for (int r = 0; r < 16; ++r) rli[r] = __builtin_amdgcn_rcpf(li_l[att::crow(r, hi)]);
              __syncthreads();
              LAS float* X = (LAS float*)alds + w4 * (32 * 132);
              if (sub == 1) {
#pragma unroll
                  for (int r = 0; r < 16; ++r) { const int orow = att::crow(r, hi); const float f = rli[r] * lam;
#pragma unroll
                      for (int d0 = 0; d0 < 4; ++d0) X[orow * 132 + d0 * 32 + r32] = o[d0][r] * f; }
              }
              LDS_WAIT(); __syncthreads();
              if (sub == 0) {
#pragma unroll
                  for (int r = 0; r < 16; ++r) { const int orow = att::crow(r, hi);
#pragma unroll
                      for (int d0 = 0; d0 < 4; ++d0) { const float t = o[d0][r] * rli[r] - X[orow * 132 + d0 * 32 + r32]; X[orow * 132 + d0 * 32 + r32] = t; } }
                  u32x4 gin[8];
#pragma unroll
                  for (int i = 0; i < 8; ++i) gin[i] = *(const u32x4*)(GA_e + (row0 + w4 * 32 + 4 * i + (F.lane >> 4)) * 1024 + 128 * h + chq * 8);
                  const f32x4 g0 = *(const f32x4*)(args.in[8] + chq * 8), g1 = *(const f32x4*)(args.in[8] + chq * 8 + 4);
                  LDS_WAIT();
                  const LAS float* xr = X + r32 * 132 + hi * 64;
                  float ssum = 0.f;
#pragma unroll
                  for (int c = 0; c < 16; ++c) { const f32x4 t = *(const LAS f32x4*)(xr + 4 * c); ssum += (t[0] * t[0] + t[1] * t[1]) + (t[2] * t[2] + t[3] * t[3]); }
                  { auto rr = __builtin_amdgcn_permlane32_swap(__float_as_uint(ssum), __float_as_uint(ssum), false, false); ssum = __uint_as_float(rr[0]) + __uint_as_float(rr[1]); }
                  const float rn = (1.0f - LAM_INIT) * __builtin_amdgcn_rsqf(ssum * (1.0f / 128.0f) + EPS);
                  if (hi == 0) li_l[32 + r32] = rn;
                  LDS_WAIT();
#pragma unroll
                  for (int i = 0; i < 8; ++i) { const int row = 4 * i + (F.lane >> 4);
                      const LAS float* xs = X + row * 132 + chq * 8;
                      const f32x4 t0 = *(const LAS f32x4*)(xs), t1 = *(const LAS f32x4*)(xs + 4);
                      const float rv = li_l[32 + row];
                      const u32x4 gz = gin[i];
                      u32x4 w; w.x = cvtpk(t0[0] * rv * g0[0] * bf_lo(gz.x), t0[1] * rv * g0[1] * bf_hi(gz.x)); w.y = cvtpk(t0[2] * rv * g0[2] * bf_lo(gz.y), t0[3] * rv * g0[3] * bf_hi(gz.y));
                      w.z = cvtpk(t1[0] * rv * g1[0] * bf_lo(gz.z), t1[1] * rv * g1[1] * bf_hi(gz.z)); w.w = cvtpk(t1[2] * rv * g1[2] * bf_lo(gz.w), t1[3] * rv * g1[3] * bf_hi(gz.w));
                      bf16_t* op_ = DRY ? dummy + row * 32 + chq * 8 : Y + (row0 + w4 * 32 + row) * 2048 + 128 * h + chq * 8;
                      st16(op_, w); }
              }
              LDS_WAIT(); __syncthreads(); }
            cur = nxt;
        }
#undef DIFF_DECODE
        asm volatile("" ::: "memory");
        if (cur < 1344) {
            if (F.tid == 0) { unsigned sp = 0; while (xb_ld(mkv_done) < 64u && !DRY) { __builtin_amdgcn_s_sleep(2); if (++sp > (1u << 22)) break; }
                __builtin_amdgcn_fence(__ATOMIC_ACQUIRE, "agent"); asm volatile("s_waitcnt vmcnt(0)" ::: "memory"); }
            __syncthreads();
        }
#define CROSS_DECODE(c_, base_, MK_, MV_) const int c = (c_) - (base_), b = c >> 5, hd = (c >> 3) & 3, qb = c & 7; \
              bf16_t* Qw = Y + (size_t)(b * SEQ + qb * 256 + F.wave * 32) * 2048 + 1536 + 128 * hd; \
              const bf16_t* Kp = (MK_) + (size_t)(b * MEML) * 512 + 128 * hd; const bf16_t* Vp = (MV_) + (size_t)(b * MEML) * 512 + 128 * hd
        att::Pre<8> PX;
        if ((P2_PARTS & 4) && cur < 1344) { CROSS_DECODE(cur, 1088, MK_e, MV_e); att::attn_preload<8>(PX, Qw, 2048); }
        while ((P2_PARTS & 4) && cur < 1344) {
            unsigned nxt_reg_ = 0u; if (F.tid == 0) nxt_reg_ = xb_add(qh, 1u);
            int nxt;
            { CROSS_DECODE(cur, 1088, MK_e, MV_e);
              f32x16 o[4]; float l;
              att::attn_core<8, 0, false>(PX, Kp, 512, Vp, 512, 4, 0, 0, 0, 0.f, 0.f, alds, o, l);
              if (F.tid == 0) MISC[12] = nxt_reg_; LDS_WAIT(); __syncthreads(); nxt = (int)MISC[12];
              bf16_t* Ow = DRY ? dummy : Qw; const bf16_t* GXw = GX_e + (size_t)(b * SEQ + qb * 256 + F.wave * 32) * 512 + 128 * hd;
              if (nxt < 1344) { CROSS_DECODE(nxt, 1088, MK_e, MV_e); att::attn_preload<8>(PX, Qw, 2048); }
              att::store_rows_bf16(o, l, Ow, DRY ? 32 : 2048, alds, GXw, 512); }
            cur = nxt;
        }
        asm volatile("" ::: "memory");
        while ((P2_PARTS & 8) && cur < 1600) {
            Q_PREFETCH(qh);
            { const int ch = (F.tid & 63) * 8, t0 = 64 * (cur - 1344) + 8 * (F.tid >> 6);
              const float* cw = args.in[9]; const float* cbp = args.in[10];
              u32x4 uin[10], gin[8];
              const bool halo = (t0 & (SEQ - 1)) != 0;
#pragma unroll
              for (int rr = 0; rr < 10; ++rr) { const size_t t = (size_t)((halo || rr >= 2) ? t0 - 2 + rr : t0); uin[rr] = *(const u32x4*)(R3 + t * 512 + ch); }
#pragma unroll
              for (int rr = 0; rr < 8; ++rr) gin[rr] = *(const u32x4*)(BB + (size_t)(t0 + rr) * 512 + ch);
              float w0[8], w1[8], w2[8], bsv[8], um2[8], um1[8];
#pragma unroll
              for (int j = 0; j < 8; ++j) { w0[j] = cw[ch + j]; w1[j] = cw[512 + ch + j]; w2[j] = cw[1024 + ch + j]; bsv[j] = cbp[ch + j]; }
#define CONV_U(dst, U_) do { dst[0] = bf_lo(U_.x); dst[1] = bf_hi(U_.x); dst[2] = bf_lo(U_.y); dst[3] = bf_hi(U_.y); dst[4] = bf_lo(U_.z); dst[5] = bf_hi(U_.z); dst[6] = bf_lo(U_.w); dst[7] = bf_hi(U_.w); } while (0)
              CONV_U(um2, uin[0]); CONV_U(um1, uin[1]);
              if (!halo) {
#pragma unroll
                  for (int j = 0; j < 8; ++j) { um2[j] = 0.f; um1[j] = 0.f; } }
#pragma unroll
              for (int rr = 0; rr < 8; ++rr) { const size_t t = (size_t)(t0 + rr);
                  float u0[8], gv[8], yv[8];
                  CONV_U(u0, uin[rr + 2]); CONV_U(gv, gin[rr]);
#pragma unroll
                  for (int j = 0; j < 8; ++j) { yv[j] = gv[j] * (w0[j] * um2[j] + w1[j] * um1[j] + w2[j] * u0[j] + bsv[j]); um2[j] = um1[j]; um1[j] = u0[j]; }
                  u32x4 w; w.x = cvtpk(yv[0], yv[1]); w.y = cvtpk(yv[2], yv[3]); w.z = cvtpk(yv[4], yv[5]); w.w = cvtpk(yv[6], yv[7]);
                  *(u32x4*)(DRY ? dummy + (rr & 7) * 64 : Y + t * 2048 + 1024 + ch) = w; }
#undef CONV_U
            }
            Q_NEXT();
        }
        asm volatile("" ::: "memory");
        while (cur < 2176) {
            Q_PREFETCH(qh);
            { const int n_ = 8 * (cur - 1600) + F.wave; P0Job jb{}; P0_DECODE(jb, (n_ < 1024 ? 3584 + n_ : 4096 + n_)); float vv[32];
              p0_load(jb, F.lane, vv); p0_finish(jb, F.lane, vv, (LAS float*)(F.lds + F.wave * 16384)); }
            Q_NEXT();
        }
    }
    SEAM(2);

    if (IN(4)) REPS(4) {
        pg8::Gemm g{Y, WO_e, M, DM, 2048}; pg8::StaticOrder S; S.init(M, DM, F.G, (int)blockIdx.x);
        pg8::EpiOut<true> E{xb, nullptr, R3, ssq1, DRY ? 1 : 0};
        pg8::gemm_phase<pg8::EpiOut<true>, pg8::StaticOrder, true>(F.lds, g, S, E);
    }
    SEAM(4);

    if (IN(5)) REPS(5) {
        for (int v = F.vcu; v < 256; v += F.G) {
            const int w4 = F.wave & 3, kh = F.wave >> 2, fr = F.lane & 15, fq = F.lane >> 4, row0 = 64 * v + 16 * w4;
            const bf16_t* ap = R3 + (size_t)(row0 + fr) * DM + kh * 512 + 8 * fq;
            const bf16_t* bp = (const bf16_t*)WF + (size_t)fr * DM + kh * 512 + 8 * fq;
            f32x4 facc = {0.f, 0.f, 0.f, 0.f};
#pragma unroll 8
            for (int ks = 0; ks < 16; ++ks) { const bf16x8 a = *(const bf16x8*)(ap + 32 * ks), bb = *(const bf16x8*)(bp + 32 * ks);
                facc = __builtin_amdgcn_mfma_f32_16x16x32_bf16(a, bb, facc, 0, 0, 0); }
            LAS f32x4* fx = (LAS f32x4*)F.lds + w4 * 64 + F.lane;
            if (kh == 1) *fx = facc;
            LDS_WAIT(); __syncthreads();
            if (kh == 0) { const f32x4 o2 = *fx; facc += o2;
                const float fbc = args.in[20][fr < 12 ? fr : 0];
                float sq[4];
#pragma unroll
                for (int r = 0; r < 4; ++r) sq[r] = ssq1[row0 + 4 * fq + r];
#pragma unroll
                for (int r = 0; r < 4; ++r) { const int row = row0 + 4 * fq + r;
                    const float f = facc[r] * __builtin_amdgcn_rsqf(sq[r] * (1.0f / DM) + EPS) + fbc;
                    const float ls = fminf(f, 0.f) - __logf(1.0f + __expf(-fabsf(f)));
                    if (fr < 12) LF[(size_t)row * 12 + fr] = ls; } }
            LDS_WAIT(); __syncthreads();
        }
        if (STAGGER_TICKS > 0 && ((blockIdx.x >> 3) & 1)) { const unsigned long long t0 = __builtin_amdgcn_s_memrealtime(); while (__builtin_amdgcn_s_memrealtime() - t0 < (unsigned long long)STAGGER_TICKS) __builtin_amdgcn_s_sleep(8); }
        pg8::Gemm g{R3, WA_o, M, 7168, DM}; pg8::StaticOrder S; S.init(M, 7168, F.G, (int)blockIdx.x);
        pg8::EpiProj E{1, nullptr, ssq1, Y, R1, R2, nullptr, nullptr, nullptr, nullptr, args.in[18], args.in[19], args.in[21], nullptr, xch, G1, nullptr};
        pg8::gemm_phase<pg8::EpiProj, pg8::StaticOrder, true>(F.lds, g, S, E);
    }
    SEAM(5);

    if (IN(6)) REPS(6) {
        bf16_t* dummy = (bf16_t*)(ws + WS_END) + (size_t)(F.vcu * 8 + F.wave) * 2048;
        unsigned* qh = ctl + CW_Q6 + (DRY ? 64 : 0);
        float eoff128, zbF;
        { float gq = fmaxf(fabsf(args.in[18][F.lane]), fabsf(args.in[18][64 + F.lane])), gk = fmaxf(fabsf(args.in[19][F.lane]), fabsf(args.in[19][64 + F.lane]));
#pragma unroll
          for (int o = 1; o < 64; o <<= 1) { gq = fmaxf(gq, __shfl_xor(gq, o)); gk = fmaxf(gk, __shfl_xor(gk, o)); }
          eoff128 = __builtin_bit_cast(float, __builtin_amdgcn_readfirstlane(__builtin_bit_cast(int, fmaxf(0.f, 11.3137085f * gq * gk * LOG2E - 100.0f))));
          zbF = __builtin_bit_cast(float, __builtin_amdgcn_readfirstlane(__builtin_bit_cast(int, (ZSKIP + 2.0f * 11.3137085f * gq * gk) * LOG2E))); }
        int cur; Q_POP_FIRST(qh);
#define FOX_DECODE(c_) const int qb = 7 - (c_) / 96, bh = (c_) % 96, b = bh / 12, h = bh % 12; \
              bf16_t* Qw = Y + (size_t)(b * SEQ + qb * 256 + F.wave * 32) * 2048 + 128 * h; \
              const bf16_t* Kp = R1 + (size_t)(b * SEQ) * 1536 + 128 * h; const bf16_t* Vp = R2 + (size_t)(b * SEQ) * 1536 + 128 * h
        att::Pre<8> PF; float lfp[4] = {0.f, 0.f, 0.f, 0.f};
#define FOX_LF_LOAD() do { const int n_ = 256 * (qb + 1), t0_ = 4 * F.tid; lfp[0] = lfp[1] = lfp[2] = lfp[3] = 0.f; \
            if (t0_ < n_) { const float* lf = LF + ((size_t)b * SEQ + t0_) * 12 + h; lfp[0] = lf[0]; lfp[1] = lf[12]; lfp[2] = lf[24]; lfp[3] = lf[36]; } } while (0)
        if (cur < 768) { FOX_DECODE(cur); att::attn_preload<8>(PF, Qw, 2048); FOX_LF_LOAD(); }
        while (cur < 768) {
            unsigned nxt_reg_ = 0u; if (F.tid == 0) nxt_reg_ = xb_add(qh, 1u);
            int nxt;
            { FOX_DECODE(cur);
              { const int n = 256 * (qb + 1), t0 = 4 * F.tid; const float v0 = lfp[0], v1 = lfp[1], v2 = lfp[2], v3 = lfp[3];
                const float s1 = v0, s2 = s1 + v1, s3 = s2 + v2, s4 = s3 + v3;
                float xs = s4;
#pragma unroll
                for (int off = 1; off < 64; off <<= 1) { const float t = __shfl_up(xs, off); if (F.lane >= off) xs += t; }
                LAS float* wtot = (LAS float*)(alds + att::SCAN_OFF);
                if (F.lane == 63) wtot[F.wave] = xs;
                LDS_WAIT(); __syncthreads();
                float pre = 0.f;
#pragma unroll
                for (int w = 0; w < 8; ++w) { const float t = wtot[w]; if (w < F.wave) pre += t; }
                const float ex = pre + (xs - s4);
                if (t0 < n) { LAS float* bl = (LAS float*)(alds + att::BIAS_OFF) + t0;
                    *(LAS f32x4*)bl = (f32x4){-(ex + s1) * LOG2E, -(ex + s2) * LOG2E, -(ex + s3) * LOG2E, -(ex + s4) * LOG2E}; }
              }
              f32x16 o[4]; float l;
              int jlo = 0;
              if (FOX_SKIP) { LDS_WAIT(); __syncthreads();
                  LAS const float* tb = (LAS const float*)(alds + att::BIAS_OFF);
                  const float d = tb[F.lane < 4 * qb ? 64 * F.lane + 63 : 0] - tb[256 * qb];
                  jlo = __builtin_popcountll(__ballot(F.lane < 4 * qb && d < -zbF)); }
              att::attn_core<8, 2, true>(PF, Kp + (size_t)(64 * jlo) * 1536, 1536, Vp + (size_t)(64 * jlo) * 1536, 1536, 4 * (qb + 1) - jlo, qb * 256 + F.wave * 32 - 64 * jlo, 0, 64 * jlo, 0.f, eoff128, alds, o, l);
              if (F.tid == 0) MISC[12] = nxt_reg_; LDS_WAIT(); __syncthreads(); nxt = (int)MISC[12];
              bf16_t* Ow = DRY ? dummy : Qw; const bf16_t* Gw = G1 + (size_t)(b * SEQ + qb * 256 + F.wave * 32) * 2048 + 128 * h;
              if (nxt < 768) { FOX_DECODE(nxt); att::attn_preload<8>(PF, Qw, 2048); FOX_LF_LOAD(); }
              att::store_rows_bf16(o, l, Ow, DRY ? 32 : 2048, alds, Gw, 2048); }
            cur = nxt;
        }
#undef FOX_DECODE
#undef FOX_LF_LOAD
        asm volatile("" ::: "memory");
        att::Pre<8> PX;
        if (cur < 1024) { CROSS_DECODE(cur, 768, MK_o, MV_o); att::attn_preload<8>(PX, Qw, 2048); }
        while (cur < 1024) {
            unsigned nxt_reg_ = 0u; if (F.tid == 0) nxt_reg_ = xb_add(qh, 1u);
            int nxt;
            { CROSS_DECODE(cur, 768, MK_o, MV_o);
              f32x16 o[4]; float l;
              att::attn_core<8, 0, false>(PX, Kp, 512, Vp, 512, 4, 0, 0, 0, 0.f, 0.f, alds, o, l);
              if (F.tid == 0) MISC[12] = nxt_reg_; LDS_WAIT(); __syncthreads(); nxt = (int)MISC[12];
              bf16_t* Ow = DRY ? dummy : Qw; const bf16_t* Gw = G1 + (size_t)(b * SEQ + qb * 256 + F.wave * 32) * 2048 + 1536 + 128 * hd;
              if (nxt < 1024) { CROSS_DECODE(nxt, 768, MK_o, MV_o); att::attn_preload<8>(PX, Qw, 2048); }
              att::store_rows_bf16(o, l, Ow, DRY ? 32 : 2048, alds, Gw, 2048); }
            cur = nxt;
        }
#undef CROSS_DECODE
        asm volatile("" ::: "memory");
        while (cur < 1152) {
            Q_PREFETCH(qh);
            { P0Job jb{}; P0_DECODE(jb, 8704 + 8 * (cur - 1024) + F.wave); float vv[32];
              p0_load(jb, F.lane, vv); p0_finish(jb, F.lane, vv, (LAS float*)(F.lds + F.wave * 16384)); }
            Q_NEXT();
        }
    }
    SEAM(6);

    if (IN(8)) REPS(8) {
        pg8::Gemm g{Y, WO_o, M, DM, 2048}; pg8::StaticOrder S; S.init(M, DM, F.G, (int)blockIdx.x);
        pg8::EpiOut<false> E{R3, hout, nullptr, nullptr, DRY ? 1 : 0};
        pg8::gemm_phase<pg8::EpiOut<false>, pg8::StaticOrder, true>(F.lds, g, S, E);
    }
#if PROBE_A >= 0
    xcd_barrier(bar); STAMP(9);
    if (blockIdx.x == 0) {
        const float ta = (float)(MISC[16 + PROBE_A + 1] - MISC[16 + PROBE_A]) * 0.000001f;
        const float tb = (PROBE_B >= 0) ? (float)(MISC[16 + (PROBE_B >= 0 ? PROBE_B : 0) + 1] - MISC[16 + (PROBE_B >= 0 ? PROBE_B : 0)]) * 0.0000025f : 0.05f;
        if (F.tid == 0) hout[0] += ta;
        for (int i = F.tid; i < (1 << 22); i += 512) hout[1024 + i] += tb;
    }
#endif
#undef P0_DECODE
#undef P0_IDX
#undef IN
#undef SEAM
#undef REPS
#undef DRY
}

extern "C" void kernel_launch(void* const* d_in, const int* in_sizes, int n_in, void* d_out, int out_size, void* d_ws, size_t ws_size, hipStream_t stream) {
    static int grid = 0;
    if (grid == 0) {
        if (n_in != 25 || in_sizes[0] != M * DM || out_size != M * DM || ws_size < WS_END) {
            fprintf(stderr, "kernel_launch: unexpected shapes (n_in %d, in0 %d, out %d, ws %zu); nothing launched\n", n_in, n_in > 0 ? in_sizes[0] : -1, out_size, ws_size); grid = -1; return; }
        int dev = 0, cus = 0, per_cu = 0;
        if (hipGetDevice(&dev) != hipSuccess || hipDeviceGetAttribute(&cus, hipDeviceAttributeMultiprocessorCount, dev) != hipSuccess) { fprintf(stderr, "kernel_launch: device query failed\n"); grid = -1; return; }
        if (hipFuncSetAttribute((const void*)hybrid_fwd, hipFuncAttributeMaxDynamicSharedMemorySize, LDS_BYTES) != hipSuccess) { fprintf(stderr, "kernel_launch: hipFuncSetAttribute failed\n"); grid = -1; return; }
        if (hipOccupancyMaxActiveBlocksPerMultiprocessor(&per_cu, (const void*)hybrid_fwd, 512, LDS_BYTES) != hipSuccess || per_cu < 1) {
            fprintf(stderr, "kernel_launch: occupancy query reports %d workgroups per CU\n", per_cu); per_cu = 1; }
        (void)hipGetLastError();
        grid = cus;
        if (grid > 256) grid = 256;
    }
    if (grid < 0) return;
    if (hipMemsetAsync((char*)d_ws + WS_CTL, 0, CTL_ZERO_BYTES, stream) != hipSuccess) { fprintf(stderr, "kernel_launch: memset failed\n"); return; }
    Args a{};
    for (int i = 0; i < 25; ++i) a.in[i] = (const float*)d_in[i];
    a.out = (float*)d_out; a.ws = (unsigned char*)d_ws;
    if (MK_N_LAUNCHES == 1) { a.ph_lo = 0; a.ph_hi = 9; hipLaunchKernelGGL(hybrid_fwd, dim3(grid), dim3(512), LDS_BYTES, stream, a); }
    else { for (int p = 0; p < 9; ++p) { a.ph_lo = p; a.ph_hi = p + 1; hipLaunchKernelGGL(hybrid_fwd, dim3(grid), dim3(512), LDS_BYTES, stream, a); } }
    const hipError_t le = hipPeekAtLastError();
    if (le != hipSuccess) fprintf(stderr, "kernel_launch: launch failed: %s\n", hipGetErrorName(le));
}
```

```cpp
#include <hip/hip_runtime.h>
#include <cstdio>
#include <cstdint>

#ifndef PROBE_A
#define PROBE_A -1
#define PROBE_B -1
#endif
#ifndef ZSKIP
#define ZSKIP 30.0f
#endif
#ifndef FOX_SKIP
#define FOX_SKIP 1
#endif
#ifndef DRY_MODE
#define DRY_MODE 1
#endif
#ifndef STAGGER_TICKS
#define STAGGER_TICKS 0
#endif
#ifndef DUP_MASK
#define DUP_MASK 0
#endif
#ifndef P2_PARTS
#define P2_PARTS 15
#endif
#ifndef MK_N_LAUNCHES
#define MK_N_LAUNCHES 1
#endif

#define LAS __attribute__((address_space(3)))
#define GAS __attribute__((address_space(1)))
typedef unsigned short bf16_t;
typedef short bf16x8 __attribute__((ext_vector_type(8)));
typedef short s16x4 __attribute__((ext_vector_type(4)));
typedef float f32x4 __attribute__((ext_vector_type(4)));
typedef float f32x2 __attribute__((ext_vector_type(2)));
typedef float f32x16 __attribute__((ext_vector_type(16)));
typedef unsigned u32x4 __attribute__((ext_vector_type(4)));
typedef unsigned u32x2 __attribute__((ext_vector_type(2)));
typedef __bf16 bf16x2_t __attribute__((ext_vector_type(2)));

constexpr int BATCH = 8, SEQ = 2048, DM = 1024, M = BATCH * SEQ;
constexpr int MEML = 256, MM = BATCH * MEML;
constexpr float EPS = 1e-6f;
constexpr float LOG2E = 1.4426950408889634f;
constexpr float C2_64 = 0.125f * LOG2E;
constexpr float C2_128 = 0.08838834764831845f * LOG2E;
constexpr float LAM_INIT = 0.2f;

constexpr size_t MiB = 1u << 20;
constexpr size_t WS_CTL = 0, CTL_ZERO_BYTES = 1 * MiB;
constexpr size_t WS_SSQ1 = 512 * 1024;
constexpr size_t WS_RSTD0 = 1 * MiB;
constexpr size_t WS_WF = 1 * MiB + 256 * 1024;
constexpr size_t WS_LF = 2 * MiB;
constexpr size_t WS_WA_E = 3 * MiB, WS_WG_E = 13 * MiB, WS_WO_E = 17 * MiB, WS_WM_E = 21 * MiB;
constexpr size_t WS_WA_O = 3 * MiB, WS_WG_O = 13 * MiB, WS_WO_O = 17 * MiB, WS_WM_O = 41 * MiB;
constexpr size_t WS_MEMN = 43 * MiB;
constexpr size_t WS_MK_E = 47 * MiB, WS_MV_E = 49 * MiB, WS_MK_O = 51 * MiB, WS_MV_O = 53 * MiB;
constexpr size_t WS_Y = 56 * MiB, WS_R1 = 120 * MiB, WS_R2 = 168 * MiB, WS_R3 = 216 * MiB, WS_END = 248 * MiB;
constexpr size_t WS_BB = WS_R1 + 32 * MiB;
constexpr int CW_BAR = 4096, CW_Q2 = 8192, CW_Q6 = 8448, CW_MKV = 8704;

constexpr int RING_BYTES = 131072;
constexpr int LDSCTL_OFF = RING_BYTES, MISC_OFF = LDSCTL_OFF + 320, XCH_OFF = LDSCTL_OFF + 1024;
constexpr int LDS_BYTES = 147456;

__device__ __forceinline__ unsigned cvtpk(float lo, float hi) { f32x2 v = {lo, hi}; bf16x2_t b = __builtin_convertvector(v, bf16x2_t); return __builtin_bit_cast(unsigned, b); }
__device__ __forceinline__ float bf_lo(unsigned w) { return __builtin_bit_cast(float, w << 16); }
__device__ __forceinline__ float bf_hi(unsigned w) { return __builtin_bit_cast(float, w & 0xffff0000u); }
__device__ __forceinline__ float wave_sum(float v) {
#pragma unroll
    for (int o = 1; o < 64; o <<= 1) v += __shfl_xor(v, o);
    return v;
}
template <int CTRL> __device__ __forceinline__ float dpp_mov(float v) { return __builtin_bit_cast(float, __builtin_amdgcn_update_dpp(0, __builtin_bit_cast(int, v), CTRL, 0xF, 0xF, true)); }
__device__ __forceinline__ float reduce8(const float (&d)[8], int lane) {
    float y[4];
#pragma unroll
    for (int i = 0; i < 4; ++i) { auto rr = __builtin_amdgcn_permlane32_swap(__float_as_uint(d[i]), __float_as_uint(d[i + 4]), false, false); y[i] = __uint_as_float(rr[0]) + __uint_as_float(rr[1]); }
    const bool b4 = (lane & 16) != 0, b3 = (lane & 8) != 0;
    float snd[2], kp[2], z[2];
#pragma unroll
    for (int j = 0; j < 2; ++j) { snd[j] = b4 ? y[j] : y[j + 2]; kp[j] = b4 ? y[j + 2] : y[j]; }
#pragma unroll
    for (int j = 0; j < 2; ++j) snd[j] = __shfl_xor(snd[j], 16);
#pragma unroll
    for (int j = 0; j < 2; ++j) z[j] = kp[j] + snd[j];
    const float s3 = b3 ? z[0] : z[1], k3 = b3 ? z[1] : z[0];
    float w = k3 + dpp_mov<0x128>(s3);
    w += dpp_mov<0xB1>(w); w += dpp_mov<0x4E>(w); w += dpp_mov<0x141>(w);
    return w;
}
#ifndef WT_STORES
#define WT_STORES 0
#endif
__device__ __forceinline__ void st16(void* p, u32x4 v) {
#if WT_STORES
    asm volatile("global_store_dwordx4 %0, %1, off sc1\n\ts_nop 1" :: "v"(p), "v"(v) : "memory");
#else
    *(u32x4*)p = v;
#endif
}
#ifndef EPI_TR
#define EPI_TR 1
#endif
__device__ __forceinline__ int tr_src4(int lane) { return 4 * ((lane >> 2) + 16 * (lane & 3)); }
__device__ __forceinline__ u32x4 lane_tr(u32x4 w, int src4) {
    w.x = (unsigned)__builtin_amdgcn_ds_bpermute(src4, (int)w.x); w.y = (unsigned)__builtin_amdgcn_ds_bpermute(src4, (int)w.y);
    w.z = (unsigned)__builtin_amdgcn_ds_bpermute(src4, (int)w.z); w.w = (unsigned)__builtin_amdgcn_ds_bpermute(src4, (int)w.w); return w; }
__device__ __forceinline__ u32x2 lane_tr(u32x2 w, int src4) {
    w.x = (unsigned)__builtin_amdgcn_ds_bpermute(src4, (int)w.x); w.y = (unsigned)__builtin_amdgcn_ds_bpermute(src4, (int)w.y); return w; }
#define LDS_WAIT() asm volatile("s_waitcnt lgkmcnt(0)" ::: "memory")
#define VM_WAIT() asm volatile("s_waitcnt vmcnt(0)" ::: "memory")

namespace pg8 {
constexpr int BM = 256, BK = 64, HALF = 128, HTB = HALF * BK * 2, STAGE_BYTES = 8 * HTB, NXCD = 8, WGM = 8;
__host__ __device__ __forceinline__ int lds_byte(int r, int c) { const int st = (r >> 4) * 2 + (c >> 5), rr = r & 15, cc = c & 31, ob = rr * 64 + cc * 2; return st * 1024 + (ob ^ (((ob >> 9) & 1) << 5)); }
__host__ __device__ __forceinline__ void stage_rc(int b, int& R, int& C) { const int st = b / 1024, sb = b % 1024, swz = sb ^ (((sb >> 9) & 1) << 5); R = (st >> 1) * 16 + swz / 64; C = (st & 1) * 32 + (swz % 64) / 2; }
__host__ __device__ __forceinline__ int perm32(int rho) { const int n = rho >> 4, i = rho & 15; return 8 * (i >> 2) + 4 * n + (i & 3); }
struct Unit { int pm, pn; };
struct Gemm { const bf16_t* A; const bf16_t* Bt; int M, N, K; };
struct StaticOrder {
    int nM, nN, nwg, G, c;
    __host__ __device__ void init(int M_, int N_, int G_, int c_) { nM = M_ / BM; nN = N_ / BM; nwg = nM * nN; G = G_; c = c_; }
    __host__ __device__ bool next(int i, Unit& u) const {
        const long L = (long)i * G + c; if (L >= nwg) return false;
        int wgid = (int)L; { const int q = nwg / NXCD, r = nwg % NXCD, xcd = wgid % NXCD, off = wgid / NXCD; wgid = (xcd < r ? xcd * (q + 1) : r * (q + 1) + (xcd - r) * q) + off; }
        const int nig = WGM * nN, gid = wgid / nig, fm = gid * WGM, gsz = (nM - fm) < WGM ? (nM - fm) : WGM;
        u.pm = fm + ((wgid % nig) % gsz); u.pn = (wgid % nig) / gsz; return true;
    }
};
struct OneUnit { int pm, pn; __host__ __device__ bool next(int i, Unit& u) const { if (i != 0) return false; u.pm = pm; u.pn = pn; return true; } };
template <class Epi, class Sched, bool ALIGN_EPI>
__device__ __forceinline__ void gemm_phase(LAS unsigned char* lds, const Gemm g, const Sched& S, const Epi& E) {
    const int tid = threadIdx.x, wid = __builtin_amdgcn_readfirstlane(tid >> 6), lane = tid & 63, wr = wid >> 2, wc = wid & 3, fr = lane & 15, fq = lane >> 4;
    const int K = g.K, nt = K / BK;
    unsigned voffA[2], voffB[2];
#pragma unroll
    for (int i = 0; i < 2; ++i) { int R, C; stage_rc(tid * 16 + i * 8192, R, C); const int Rb = (R & ~31) + perm32(R & 31);
        voffA[i] = (unsigned)(R * K + C) * 2u; voffB[i] = (unsigned)(Rb * K + C) * 2u; }
    const size_t kstep = (size_t)(BK * 2);
    const size_t hstep = (size_t)HALF * K * 2;
    const size_t tstep = 2 * hstep;
    const unsigned ldsw = (unsigned)wid * 1024u;
    const int aoff = lds_byte(wr * 64 + fr, fq * 8), boff = lds_byte(wc * 32 + fr, fq * 8);
#define PG8_SA(b, h) (((b) * 2 + (h)) * HTB)
#define PG8_SB(b, h) ((4 + (b) * 2 + (h)) * HTB)
#define PG8_STAGE(bufoff, gbase, voff) do { _Pragma("unroll") for (int _i = 0; _i < 2; ++_i) \
        __builtin_amdgcn_global_load_lds((const unsigned*)((const char*)(gbase) + (voff)[_i]), (LAS unsigned*)(lds + (bufoff) + ldsw + _i * 8192), 16, 0, 0); } while (0)
#define PG8_LDA(dst, b, h) do { _Pragma("unroll") for (int m = 0; m < 4; ++m) _Pragma("unroll") for (int k = 0; k < 2; ++k) dst[m][k] = *(const LAS bf16x8*)(lds + PG8_SA(b, h) + aoff + m * 2048 + k * 1024); } while (0)
#define PG8_LDB(dst, b, h) do { _Pragma("unroll") for (int n = 0; n < 2; ++n) _Pragma("unroll") for (int k = 0; k < 2; ++k) dst[n][k] = *(const LAS bf16x8*)(lds + PG8_SB(b, h) + boff + n * 2048 + k * 1024); } while (0)
#define PG8_MMA(ai, bj, At, Bt) do { __builtin_amdgcn_s_setprio(1); _Pragma("unroll") for (int m = 0; m < 4; ++m) _Pragma("unroll") for (int n = 0; n < 2; ++n) _Pragma("unroll") for (int k = 0; k < 2; ++k) \
        acc[ai][bj][m][n] = __builtin_amdgcn_mfma_f32_16x16x32_bf16(Bt[n][k], At[m][k], acc[ai][bj][m][n], 0, 0, 0); __builtin_amdgcn_s_setprio(0); } while (0)
#define PG8_WAIT_V(n) asm volatile("s_waitcnt vmcnt(" #n ")" ::: "memory")
#define PG8_WAIT_L(n) asm volatile("s_waitcnt lgkmcnt(" #n ")" ::: "memory")
#define PG8_BAR __builtin_amdgcn_s_barrier()
#define PG8_SCHED __builtin_amdgcn_sched_barrier(0)
    Unit cur, nxt; int ui = 0;
    if (!S.next(0, cur)) return;
    f32x4 acc[2][2][4][2];
    bf16x8 At[4][2], B0[2][2], B1[2][2];
    const char* cA = (const char*)g.A + (size_t)cur.pm * tstep; const char* cB = (const char*)g.Bt + (size_t)cur.pn * tstep;
    typename Epi::Init ini;
    E.init_load(ini, cur, wr, wc, fr, fq);
    PG8_STAGE(PG8_SB(0, 0), cB, voffB); PG8_STAGE(PG8_SB(0, 1), cB + hstep, voffB); PG8_STAGE(PG8_SA(0, 0), cA, voffA); PG8_STAGE(PG8_SA(0, 1), cA + hstep, voffA);
    E.init_acc(acc, ini);
    if (wr == 1) PG8_BAR;
    PG8_WAIT_V(2); PG8_BAR;
    PG8_STAGE(PG8_SB(1, 0), cB + kstep, voffB); PG8_STAGE(PG8_SA(1, 0), cA + kstep, voffA); PG8_STAGE(PG8_SB(1, 1), cB + hstep + kstep, voffB);
    PG8_WAIT_V(6); PG8_BAR;
    for (;;) {
        const bool has_next = S.next(ui + 1, nxt);
        const char* nA = has_next ? (const char*)g.A + (size_t)nxt.pm * tstep : cA; const char* nB = has_next ? (const char*)g.Bt + (size_t)nxt.pn * tstep : cB;
        for (int t = 0; t < nt; t += 2) {
            const bool last = (t == nt - 2);
            const char* a1 = cA + (size_t)(t + 1) * kstep;
            const char* a2 = last ? nA : cA + (size_t)(t + 2) * kstep; const char* b2 = last ? nB : cB + (size_t)(t + 2) * kstep;
            const char* a3 = a2 + kstep; const char* b3 = b2 + kstep;
            PG8_LDB(B0, 0, 0); PG8_LDB(B1, 0, 1); PG8_SCHED; PG8_LDA(At, 0, 0); PG8_STAGE(PG8_SA(1, 1), a1 + hstep, voffA);
            PG8_WAIT_V(8); PG8_WAIT_L(0); PG8_BAR; PG8_MMA(0, 0, At, B0); PG8_MMA(0, 1, At, B1); PG8_BAR; PG8_SCHED;
            PG8_LDA(At, 0, 1); PG8_STAGE(PG8_SB(0, 0), b2, voffB); PG8_STAGE(PG8_SB(0, 1), b2 + hstep, voffB); PG8_STAGE(PG8_SA(0, 0), a2, voffA);
            PG8_WAIT_V(8); PG8_WAIT_L(0); PG8_BAR; PG8_MMA(1, 0, At, B0); PG8_MMA(1, 1, At, B1); PG8_BAR; PG8_SCHED;
            PG8_LDB(B0, 1, 0); PG8_LDB(B1, 1, 1); PG8_SCHED; PG8_LDA(At, 1, 0); PG8_STAGE(PG8_SA(0, 1), a2 + hstep, voffA);
            PG8_WAIT_V(8); PG8_WAIT_L(0); PG8_BAR; PG8_MMA(0, 0, At, B0); PG8_MMA(0, 1, At, B1); PG8_BAR; PG8_SCHED;
            PG8_LDA(At, 1, 1); PG8_STAGE(PG8_SB(1, 0), b3, voffB); PG8_STAGE(PG8_SB(1, 1), b3 + hstep, voffB); PG8_STAGE(PG8_SA(1, 0), a3, voffA);
            PG8_WAIT_V(8); PG8_WAIT_L(0); PG8_BAR; PG8_MMA(1, 0, At, B0); PG8_MMA(1, 1, At, B1); PG8_BAR; PG8_SCHED;
        }
        if constexpr (ALIGN_EPI) { if (wr == 0) PG8_BAR; }
        E(acc, cur, wr, wc, fr, fq, ini);
        if (!has_next) break;
#pragma unroll
        for (int a = 0; a < 2; ++a)
#pragma unroll
            for (int b = 0; b < 2; ++b)
#pragma unroll
                for (int m = 0; m < 4; ++m)
#pragma unroll
                    for (int n = 0; n < 2; ++n) acc[a][b][m][n] = (f32x4){0.f, 0.f, 0.f, 0.f};
        cur = nxt; cA = nA; cB = nB; ++ui;
        if constexpr (Epi::RESID) { E.init_load(ini, cur, wr, wc, fr, fq); E.init_acc(acc, ini); }
        if constexpr (ALIGN_EPI) { if (wr == 1) PG8_BAR; }
    }
    PG8_WAIT_V(0);
    if constexpr (!ALIGN_EPI) { if (wr == 0) PG8_BAR; }
    PG8_BAR;
#undef PG8_SA
#undef PG8_SB
#undef PG8_STAGE
#undef PG8_LDA
#undef PG8_LDB
#undef PG8_MMA
#undef PG8_WAIT_V
#undef PG8_WAIT_L
#undef PG8_BAR
#undef PG8_SCHED
}

struct TileDesc { int mode; bf16_t* dst; int ld; const float* g; float ps; };
struct EpiProj {
    int kind;
    const float* rstd;
    const float* ssq;
    bf16_t *Y, *R1, *R2, *R3, *BB, *MK, *MV;
    const float *g_q, *g_k, *g_xq, *g_xk;
    LAS float* xch; bf16_t* GA; bf16_t* GX;
    struct Init { float rv[2][4]; };
    static constexpr bool RESID = true;
    __device__ __forceinline__ void init_load(Init& I, const Unit& u, int wr, int wc, int fr, int fq) const {
        const float* src = kind == 0 ? rstd : ssq;
#pragma unroll
        for (int ai = 0; ai < 2; ++ai)
#pragma unroll
            for (int m = 0; m < 4; ++m) I.rv[ai][m] = kind <= 1 ? src[u.pm * BM + ai * HALF + wr * 64 + m * 16 + fr] : 1.f;
    }
    __device__ __forceinline__ void init_acc(f32x4 (&acc)[2][2][4][2], const Init&) const {
#pragma unroll
        for (int a = 0; a < 2; ++a)
#pragma unroll
            for (int b = 0; b < 2; ++b)
#pragma unroll
                for (int m = 0; m < 4; ++m)
#pragma unroll
                    for (int n = 0; n < 2; ++n) acc[a][b][m][n] = (f32x4){0.f, 0.f, 0.f, 0.f};
    }
    __device__ __forceinline__ TileDesc desc(int pn) const {
        TileDesc d; d.mode = 0; d.dst = nullptr; d.ld = 0; d.g = nullptr; d.ps = 1.f;
        if (kind == 0) {
            if (pn < 4) { d.mode = 1; d.dst = Y + 256 * pn; d.ld = 2048; d.g = g_q; d.ps = C2_64; }
            else if (pn < 8) { d.mode = 1; d.dst = R1 + 256 * (pn - 4); d.ld = 1024; d.g = g_k; }
            else if (pn < 12) { d.dst = R2 + 256 * (pn - 8); d.ld = 1024; }
            else if (pn < 16) { d.mode = 4; d.dst = R3 + 128 * (pn - 12); d.ld = 512; }
            else if (pn < 18) { d.mode = 5; d.dst = BB + 128 * (pn - 16); d.ld = 512; }
            else if (pn < 20) { d.mode = 2; d.dst = Y + 1536 + 256 * (pn - 18); d.ld = 2048; d.g = g_xq; d.ps = C2_128; }
            else if (pn < 24) { d.mode = 3; d.dst = GA + 256 * (pn - 20); d.ld = 1024; }
            else if (pn < 26) { d.mode = 5; d.dst = BB + 256 + 128 * (pn - 24); d.ld = 512; }
            else { d.mode = 3; d.dst = GX + 256 * (pn - 26); d.ld = 512; }
        } else if (kind == 1) {
            if (pn < 6) { d.mode = 2; d.dst = Y + 256 * pn; d.ld = 2048; d.g = g_q; d.ps = C2_128; }
            else if (pn < 12) { d.mode = 2; d.dst = R1 + 256 * (pn - 6); d.ld = 1536; d.g = g_k; }
            else if (pn < 18) { d.dst = R2 + 256 * (pn - 12); d.ld = 1536; }
            else if (pn < 20) { d.mode = 2; d.dst = Y + 1536 + 256 * (pn - 18); d.ld = 2048; d.g = g_xq; d.ps = C2_128; }
            else { d.mode = 3; d.dst = GA + 256 * (pn - 20); d.ld = 2048; }
        } else {
            if (pn < 2) { d.mode = 2; d.dst = MK + 256 * pn; d.ld = 512; d.g = g_xk; }
            else { d.dst = MV + 256 * (pn - 2); d.ld = 512; }
        }
        return d;
    }
    __device__ __forceinline__ float rowscale(float raw) const {
        if (kind == 0) return raw;
        if (kind == 1) return __builtin_amdgcn_rsqf(raw * (1.0f / DM) + EPS);
        return 1.f;
    }
    __device__ __forceinline__ void operator()(const f32x4 (&acc)[2][2][4][2], const Unit& u, int wr, int wc, int fr, int fq, const Init& I) const {
        const TileDesc d = desc(u.pn);
        const int cl = 64 * wc + 8 * fq;
        f32x4 gv[2][2];
#pragma unroll
        for (int bj = 0; bj < 2; ++bj)
#pragma unroll
            for (int n = 0; n < 2; ++n) gv[bj][n] = (f32x4){d.ps, d.ps, d.ps, d.ps};
        if (d.mode == 1 || d.mode == 2) {
            const int gi = (d.mode == 2 ? 64 * (wc & 1) : 0) + 8 * fq;
#pragma unroll
            for (int bj = 0; bj < 2; ++bj)
#pragma unroll
                for (int n = 0; n < 2; ++n) gv[bj][n] = *(const f32x4*)(d.g + gi + 32 * bj + 4 * n) * d.ps;
        }
        float rf[2][4];
#pragma unroll
        for (int ai = 0; ai < 2; ++ai)
#pragma unroll
            for (int m = 0; m < 4; ++m) rf[ai][m] = rowscale(I.rv[ai][m]);
        if (d.mode == 1 || d.mode == 2) {
            float ss[2][4];
#pragma unroll
            for (int ai = 0; ai < 2; ++ai)
#pragma unroll
                for (int m = 0; m < 4; ++m) { float s0 = 0.f;
#pragma unroll
                    for (int bj = 0; bj < 2; ++bj)
#pragma unroll
                        for (int n = 0; n < 2; ++n) { const f32x4 v = acc[ai][bj][m][n]; s0 += (v[0] * v[0] + v[1] * v[1]) + (v[2] * v[2] + v[3] * v[3]); }
                    ss[ai][m] = s0 * rf[ai][m] * rf[ai][m]; }
#pragma unroll
            for (int ai = 0; ai < 2; ++ai)
#pragma unroll
                for (int m = 0; m < 4; ++m) ss[ai][m] += __shfl_xor(ss[ai][m], 16);
#pragma unroll
            for (int ai = 0; ai < 2; ++ai)
#pragma unroll
                for (int m = 0; m < 4; ++m) { auto rr = __builtin_amdgcn_permlane32_swap(__float_as_uint(ss[ai][m]), __float_as_uint(ss[ai][m]), false, false); ss[ai][m] = __uint_as_float(rr[0]) + __uint_as_float(rr[1]); }
            if (d.mode == 2) {
#pragma unroll
                for (int ai = 0; ai < 2; ++ai)
#pragma unroll
                    for (int m = 0; m < 4; ++m) if (fq == 0) xch[(ai * HALF + wr * 64 + m * 16 + fr) * 4 + wc] = ss[ai][m];
                asm volatile("s_waitcnt lgkmcnt(0)" ::: "memory"); __builtin_amdgcn_s_barrier(); asm volatile("" ::: "memory");
#pragma unroll
                for (int ai = 0; ai < 2; ++ai)
#pragma unroll
                    for (int m = 0; m < 4; ++m) ss[ai][m] += xch[(ai * HALF + wr * 64 + m * 16 + fr) * 4 + (wc ^ 1)];
            }
            const float inv = d.mode == 2 ? (1.0f / 128.0f) : (1.0f / 64.0f);
#pragma unroll
            for (int ai = 0; ai < 2; ++ai)
#pragma unroll
                for (int m = 0; m < 4; ++m) rf[ai][m] *= __builtin_amdgcn_rsqf(ss[ai][m] * inv + EPS);
        }
        asm volatile("" :: "v"(rf[0][0]), "v"(rf[0][1]), "v"(rf[0][2]), "v"(rf[0][3]), "v"(rf[1][0]), "v"(rf[1][1]), "v"(rf[1][2]), "v"(rf[1][3]), "v"(gv[0][0]), "v"(gv[0][1]), "v"(gv[1][0]), "v"(gv[1][1]));
        switch (d.mode) {
            case 0: store_tile<0>(acc, d, rf, gv, u, wr, wc, fr, fq); break;
            case 1: case 2: store_tile<1>(acc, d, rf, gv, u, wr, wc, fr, fq); break;
            case 3: store_tile<3>(acc, d, rf, gv, u, wr, wc, fr, fq); break;
            case 4: store_tile<4>(acc, d, rf, gv, u, wr, wc, fr, fq); break;
            default: store_tile<5>(acc, d, rf, gv, u, wr, wc, fr, fq); break;
        }
    }
    template <int MODE>
    __device__ __forceinline__ void store_tile(const f32x4 (&acc)[2][2][4][2], const TileDesc& d, const float (&rf)[2][4], const f32x4 (&gv)[2][2], const Unit& u, int wr, int wc, int fr, int fq) const {
        const int lane_ = fr + 16 * fq, src4 = tr_src4(lane_);
        const int clS = 64 * wc + 8 * (lane_ & 3);
        bf16_t* base = d.dst + (size_t)(u.pm * BM + wr * 64 + (lane_ >> 2)) * d.ld + (MODE >= 4 ? (clS >> 1) : clS);
        const size_t ld16 = (size_t)16 * d.ld;
#pragma unroll
        for (int ai = 0; ai < 2; ++ai) {
        u32x4 wq[1][4][2];
#pragma unroll
            for (int m = 0; m < 4; ++m) {
                const float rs = rf[ai][m];
#pragma unroll
                for (int bj = 0; bj < 2; ++bj) {
                    if (MODE >= 4) {
                        f32x4 v0 = acc[ai][bj][m][0] * rs, v1 = acc[ai][bj][m][1] * rs;
                        if (MODE == 5) {
#pragma unroll
                            for (int i = 0; i < 4; ++i) v1[i] *= __builtin_amdgcn_rcpf(1.0f + __builtin_amdgcn_exp2f(-v1[i] * LOG2E)); }
                        v0 *= v1;
                        u32x2 w; w.x = cvtpk(v0[0], v0[1]); w.y = cvtpk(v0[2], v0[3]);
                        w = lane_tr(w, src4);
                        wq[0][m][bj].x = w.x; wq[0][m][bj].y = w.y;
                    } else {
                        f32x4 v0, v1;
                        if (MODE == 1) { v0 = acc[ai][bj][m][0] * (gv[bj][0] * rs); v1 = acc[ai][bj][m][1] * (gv[bj][1] * rs); }
                        else { v0 = acc[ai][bj][m][0] * rs; v1 = acc[ai][bj][m][1] * rs; }
                        if (MODE == 3) {
#pragma unroll
                            for (int i = 0; i < 4; ++i) { v0[i] *= __builtin_amdgcn_rcpf(1.0f + __builtin_amdgcn_exp2f(-v0[i] * LOG2E)); v1[i] *= __builtin_amdgcn_rcpf(1.0f + __builtin_amdgcn_exp2f(-v1[i] * LOG2E)); } }
                        u32x4 w; w.x = cvtpk(v0[0], v0[1]); w.y = cvtpk(v0[2], v0[3]); w.z = cvtpk(v1[0], v1[1]); w.w = cvtpk(v1[2], v1[3]);
                        wq[0][m][bj] = lane_tr(w, src4);
                    }
                }
            }
#pragma unroll
            for (int m = 0; m < 4; ++m) {
                bf16_t* rowp = base + (size_t)(ai * 8 + m) * ld16;
#pragma unroll
                for (int bj = 0; bj < 2; ++bj) {
                    if (MODE >= 4) { u32x2 w; w.x = wq[0][m][bj].x; w.y = wq[0][m][bj].y; *(u32x2*)(rowp + 16 * bj) = w; }
                    else st16(rowp + 32 * bj, wq[0][m][bj]);
                }
            }
        }
    }
};
template <bool FIRST> struct EpiOut {
    const bf16_t* base; float* hout; bf16_t* hb; float* ssq; int dry;
    struct Init { u32x4 b[2][4][2]; };
    static constexpr bool RESID = true;
    __device__ __forceinline__ void init_load(Init& I, const Unit& u, int wr, int wc, int fr, int fq) const {
        const int cl = u.pn * BM + 64 * wc + 8 * fq;
#pragma unroll
        for (int ai = 0; ai < 2; ++ai)
#pragma unroll
            for (int m = 0; m < 4; ++m)
#pragma unroll
                for (int bj = 0; bj < 2; ++bj) I.b[ai][m][bj] = *(const u32x4*)(base + (size_t)(u.pm * BM + ai * HALF + wr * 64 + m * 16 + fr) * DM + cl + 32 * bj);
    }
    __device__ __forceinline__ void init_acc(f32x4 (&acc)[2][2][4][2], const Init& I) const {
#pragma unroll
        for (int ai = 0; ai < 2; ++ai)
#pragma unroll
            for (int m = 0; m < 4; ++m)
#pragma unroll
                for (int bj = 0; bj < 2; ++bj) { const u32x4 bv = I.b[ai][m][bj];
                    acc[ai][bj][m][0] = (f32x4){bf_lo(bv.x), bf_hi(bv.x), bf_lo(bv.y), bf_hi(bv.y)}; acc[ai][bj][m][1] = (f32x4){bf_lo(bv.z), bf_hi(bv.z), bf_lo(bv.w), bf_hi(bv.w)}; }
    }
    __device__ __forceinline__ void operator()(const f32x4 (&acc)[2][2][4][2], const Unit& u, int wr, int wc, int fr, int fq, const Init&) const {
        const int cl = u.pn * BM + 64 * wc + 8 * fq;
        float sr[2][4];
#pragma unroll
        for (int ai = 0; ai < 2; ++ai) {
#pragma unroll
            for (int m = 0; m < 4; ++m) {
                const int row = u.pm * BM + ai * HALF + wr * 64 + m * 16 + fr; const size_t off = (size_t)row * DM + cl; float s = 0.f;
#pragma unroll
                for (int bj = 0; bj < 2; ++bj) {
                    const f32x4 h0 = acc[ai][bj][m][0], h1 = acc[ai][bj][m][1];
                    if (FIRST) {
                        u32x4 w; w.x = cvtpk(h0[0], h0[1]); w.y = cvtpk(h0[2], h0[3]); w.z = cvtpk(h1[0], h1[1]); w.w = cvtpk(h1[2], h1[3]);
                        st16(hb + off + 32 * bj, w);
                        s += (h0[0] * h0[0] + h0[1] * h0[1]) + (h0[2] * h0[2] + h0[3] * h0[3]) + (h1[0] * h1[0] + h1[1] * h1[1]) + (h1[2] * h1[2] + h1[3] * h1[3]);
                    } else { *(f32x4*)(hout + off + 32 * bj) = h0; *(f32x4*)(hout + off + 32 * bj + 4) = h1; }
                }
                sr[ai][m] = s;
            }
        }
        if (FIRST) {
#pragma unroll
            for (int ai = 0; ai < 2; ++ai)
#pragma unroll
                for (int m = 0; m < 4; ++m) sr[ai][m] += __shfl_xor(sr[ai][m], 16);
#pragma unroll
            for (int ai = 0; ai < 2; ++ai)
#pragma unroll
                for (int m = 0; m < 4; ++m) { auto rr = __builtin_amdgcn_permlane32_swap(__float_as_uint(sr[ai][m]), __float_as_uint(sr[ai][m]), false, false);
                    const float t = __uint_as_float(rr[0]) + __uint_as_float(rr[1]);
                    if (fq == 0) atomicAdd(ssq + u.pm * BM + ai * HALF + wr * 64 + m * 16 + fr, t); }
        }
    }
};
}

namespace att {
constexpr int NW = 8, QBLK = 32, KVBLK = 64;
constexpr int SHM_V = 16384, SHM_K = 16384, NSTG = 3, K_OFF = 0, V_OFF = NSTG * SHM_K;
constexpr int XSTG_END = 69632, WS_OFF = 98304, BIAS_OFF = 100352, SCAN_OFF = 108544;
constexpr float THR = 8.f;
#define KSWZ(row, colB) ((row) * 256 + ((colB) ^ (((row) & 7) << 4)))
#define SBAR() __builtin_amdgcn_sched_barrier(0)
__device__ __forceinline__ int v_st(int k, int c) { const int kk = (k & ~0xC) | ((k & 4) << 1) | ((k & 8) >> 1); return ((kk >> 3) * 4 + (c >> 5)) * 512 + ((kk & 7) * 32 + (c & 31)) * 2; }
__device__ __forceinline__ int v_rd_base(int lane) { return ((lane & 3) << 3) | (((lane >> 2) & 3) << 6) | (((lane >> 4) & 1) << 5) | (((lane >> 5) & 1) << 8); }
constexpr int v_rd_off(int d0, int ks, int half) { return d0 * 512 + ks * 4096 + half * 2048; }
__device__ __forceinline__ int crow(int r, int hi) { return (r & 3) + 8 * (r >> 2) + 4 * hi; }
__device__ __forceinline__ void mask_causal(f32x16& p0, f32x16& p1, int dq) {
    const float NEG = -__builtin_inff();
#pragma unroll
    for (int r = 0; r < 16; ++r) { const int c = (r & 3) + 8 * (r >> 2); if (dq - c < 0) p0[r] = NEG; if (dq - c - 32 < 0) p1[r] = NEG; }
}
__device__ __forceinline__ f32x16 ninf16() { const float n = -__builtin_inff(); return (f32x16){n, n, n, n, n, n, n, n, n, n, n, n, n, n, n, n}; }
template <bool ADD> __device__ __forceinline__ void partialSM(f32x16& p0, f32x16& p1, float rowc) {
    if (ADD) {
#pragma unroll
        for (int r = 0; r < 16; ++r) p0[r] += rowc;
#pragma unroll
        for (int r = 0; r < 16; ++r) p1[r] += rowc;
    }
#pragma unroll
    for (int r = 0; r < 16; ++r) p0[r] = __builtin_amdgcn_exp2f(p0[r]);
}
__device__ __forceinline__ void finishSM(f32x16& p0, f32x16& p1, float& l_reg, bf16x8& pa0, bf16x8& pa1, bf16x8& pa2, bf16x8& pa3) {
#pragma unroll
    for (int r = 0; r < 16; ++r) p1[r] = __builtin_amdgcn_exp2f(p1[r]);
    float ps = 0;
#pragma unroll
    for (int r = 0; r < 16; ++r) ps += p0[r];
#pragma unroll
    for (int r = 0; r < 16; ++r) ps += p1[r];
    { auto rr = __builtin_amdgcn_permlane32_swap(__float_as_uint(ps), __float_as_uint(ps), false, false);
      ps = __uint_as_float(rr[0]) + __uint_as_float(rr[1]); }
    l_reg += ps;
#define PK4(P, B_, OUT) do { unsigned a0 = cvtpk(P[B_+0], P[B_+1]), a1 = cvtpk(P[B_+2], P[B_+3]);                          \
        unsigned b0 = cvtpk(P[B_+4], P[B_+5]), b1 = cvtpk(P[B_+6], P[B_+7]);                                             \
        auto r0 = __builtin_amdgcn_permlane32_swap(a0, b0, false, false); auto r1 = __builtin_amdgcn_permlane32_swap(a1, b1, false, false); \
        u32x4 w = {r0[0], r1[0], r0[1], r1[1]}; OUT = __builtin_bit_cast(bf16x8, w); } while (0)
    PK4(p0, 0, pa0); PK4(p0, 8, pa1); PK4(p1, 0, pa2); PK4(p1, 8, pa3);
#undef PK4
}
template <int ND, int BIAS>
__device__ __forceinline__ void qkt(f32x16& p0, f32x16& p1, LAS const char* K_lds  , int ksub, int r32, int hi, const bf16x8* qr, LAS const float* bl) {
    if (BIAS) {
#pragma unroll
        for (int g = 0; g < 4; ++g) { const f32x4 a = *(LAS const f32x4*)(bl + 8 * g), b = *(LAS const f32x4*)(bl + 32 + 8 * g);
            p0[4 * g] = a[0]; p0[4 * g + 1] = a[1]; p0[4 * g + 2] = a[2]; p0[4 * g + 3] = a[3]; p1[4 * g] = b[0]; p1[4 * g + 1] = b[1]; p1[4 * g + 2] = b[2]; p1[4 * g + 3] = b[3]; }
    } else { p0 = f32x16{}; p1 = f32x16{}; }
    LAS const char* kb[4];
    int r32v = r32; asm volatile("" : "+v"(r32v));
#pragma unroll
    for (int dd = 0; dd < 4; ++dd) kb[dd] = K_lds + KSWZ(r32v, (dd * 16 + hi * 8) * 2) + ksub;
#pragma unroll
    for (int d0 = 0; d0 < ND; ++d0) { LAS const char* a = kb[d0 & 3] + (d0 >> 2) * 128;
        const bf16x8 b0 = *(LAS const bf16x8*)(a);
        const bf16x8 b1 = *(LAS const bf16x8*)(a + 32 * 256);
        p0 = __builtin_amdgcn_mfma_f32_32x32x16_bf16(b0, qr[d0], p0, 0, 0, 0);
        p1 = __builtin_amdgcn_mfma_f32_32x32x16_bf16(b1, qr[d0], p1, 0, 0, 0); }
}
__device__ __forceinline__ void pv_tile(f32x16* o, int vb0  , bf16x8 pa0, bf16x8 pa1, bf16x8 pa2, bf16x8 pa3) {
#define TRRD(dst, off) asm volatile("ds_read_b64_tr_b16 %0, %1 offset:%2" : "=&v"(dst) : "v"(vb0), "i"(off) : "memory")
#define PV_D0(d0) do { s16x4 l0, l1, l2, l3, h0, h1, h2, h3; constexpr int b_ = v_rd_off(d0, 0, 0); \
        TRRD(l0, b_); TRRD(h0, b_ + 2048); TRRD(l1, b_ + 4096); TRRD(h1, b_ + 6144); TRRD(l2, b_ + 8192); TRRD(h2, b_ + 10240); TRRD(l3, b_ + 12288); TRRD(h3, b_ + 14336); \
        asm volatile("s_waitcnt lgkmcnt(0)" ::: "memory"); SBAR(); \
        o[d0] = __builtin_amdgcn_mfma_f32_32x32x16_bf16(pa0, (bf16x8){l0[0], l0[1], l0[2], l0[3], h0[0], h0[1], h0[2], h0[3]}, o[d0], 0, 0, 0);   \
        o[d0] = __builtin_amdgcn_mfma_f32_32x32x16_bf16(pa1, (bf16x8){l1[0], l1[1], l1[2], l1[3], h1[0], h1[1], h1[2], h1[3]}, o[d0], 0, 0, 0);   \
        o[d0] = __builtin_amdgcn_mfma_f32_32x32x16_bf16(pa2, (bf16x8){l2[0], l2[1], l2[2], l2[3], h2[0], h2[1], h2[2], h2[3]}, o[d0], 0, 0, 0);   \
        o[d0] = __builtin_amdgcn_mfma_f32_32x32x16_bf16(pa3, (bf16x8){l3[0], l3[1], l3[2], l3[3], h3[0], h3[1], h3[2], h3[3]}, o[d0], 0, 0, 0); } while (0)
    PV_D0(0); PV_D0(1); PV_D0(2); PV_D0(3);
#undef PV_D0
#undef TRRD
}
template <int ND> struct Pre { bf16x8 qr[ND]; };
template <int ND>
__device__ __forceinline__ void attn_preload(Pre<ND>& P, const bf16_t* Qw, int qp) {
    int tid = threadIdx.x; asm volatile("" : "+v"(tid));
    const int lane = tid & 63, r32 = lane & 31, hi = lane >> 5;
#pragma unroll
    for (int d0 = 0; d0 < ND; ++d0) P.qr[d0] = *(const bf16x8*)(Qw + (size_t)r32 * qp + d0 * 16 + hi * 8);
}
template <int ND, int BIAS, bool CAUSAL>
__device__ __forceinline__ void attn_core(Pre<ND>& P, const bf16_t* Kp, int kp, const bf16_t* Vp, int vp, int NT, int qlo, int ksub, int tsh, float tslope, float eoff,
                                          LAS char* lds, f32x16 (&o)[4], float& l_out) {
    int tid = threadIdx.x; asm volatile("" : "+v"(tid));
    const int wid = __builtin_amdgcn_readfirstlane(tid >> 6), lane = tid & 63, r32 = lane & 31, hi = lane >> 5;
    LAS char* K_lds = lds + K_OFF; LAS char* V_lds = lds + V_OFF;
    LAS const float* biasL = (LAS const float*)(lds + BIAS_OFF) + tsh + 4 * hi;
    const int vb0 = (int)(unsigned)(uintptr_t)V_lds + v_rd_base(lane);
    const int qm = qlo + r32 - 4 * hi;
    const int tl = __builtin_amdgcn_readfirstlane((qlo + 31) >> 6);
    bf16x8 (&qr)[ND] = P.qr;
    const bf16_t* ksrc[2]; const bf16_t* vsrc[2];
#pragma unroll
    for (int i = 0; i < 2; ++i) { const int p = 2 * wid + i;
        const int row = 4 * p + (lane >> 4); ksrc[i] = Kp + (size_t)row * kp + 8 * ((lane & 15) ^ (row & 7));
        const int sbt = 2 * p + (lane >> 5), kk = (sbt >> 2) * 8 + ((lane & 31) >> 2), c = 32 * (sbt & 3) + 8 * (lane & 3), k = (kk & ~0xC) | ((kk & 4) << 1) | ((kk & 8) >> 1);
        vsrc[i] = Vp + (size_t)k * vp + c; }
    const size_t ktile = (size_t)KVBLK * kp, vtile = (size_t)KVBLK * vp;
#define DMA_K(t_, stg) do { const int tt_ = (t_) < NT ? (t_) : NT - 1; _Pragma("unroll") for (int i_ = 0; i_ < 2; ++i_) \
        __builtin_amdgcn_global_load_lds((const unsigned*)(ksrc[i_] + (size_t)tt_ * ktile), (LAS unsigned*)(K_lds + (stg) + (2 * wid + i_) * 1024), 16, 0, 0); } while (0)
#define DMA_V(t_, stg) do { const int tt_ = (t_) < NT ? (t_) : NT - 1; _Pragma("unroll") for (int i_ = 0; i_ < 2; ++i_) \
        __builtin_amdgcn_global_load_lds((const unsigned*)(vsrc[i_] + (size_t)tt_ * vtile), (LAS unsigned*)(V_lds + (stg) + (2 * wid + i_) * 1024), 16, 0, 0); } while (0)
#define WAIT_BAR(N) asm volatile("s_waitcnt vmcnt(" #N ") lgkmcnt(0)\n\ts_barrier" ::: "memory")
#define MASKT(P0_, P1_, t) do { if (CAUSAL) { const int kb_ = (t) * KVBLK; if (kb_ + KVBLK - 1 > qlo) { asm volatile("" ::: "memory"); mask_causal(P0_, P1_, qm - kb_); } } } while (0)
#define BL(t) (biasL + (BIAS == 2 ? (t) * KVBLK : 0))
#define ROWC(t) (BIAS == 1 ? rowc + tslope * (float)(t) : rowc)
    float l_reg = 0.f, rowc = -eoff;
#pragma unroll
    for (int d_ = 0; d_ < 4; ++d_) o[d_] = f32x16{};
    f32x16 pA0, pA1, pB0, pB1; bf16x8 pa0, pa1, pa2, pa3;
    int s_m1 = 2 * SHM_K, s_0 = 0, s_p1 = SHM_K, s_p2 = 2 * SHM_K;
#define ROT() do { s_m1 = s_0; s_0 = s_p1; s_p1 = s_p2; s_p2 = (s_p2 == 2 * SHM_K) ? 0 : s_p2 + SHM_K; } while (0)
    DMA_K(0, 0); DMA_V(0, 0); DMA_K(1, SHM_K);
    asm volatile("s_waitcnt vmcnt(2)" ::: "memory");
    __builtin_amdgcn_s_barrier(); asm volatile("" ::: "memory");
    if (BIAS == 2) rowc -= ((LAS const float*)(lds + BIAS_OFF))[tsh + qlo + r32];
    if (BIAS == 1) rowc -= (tslope * (1.0f / 64.0f)) * (float)(qlo + r32);
    DMA_K(2, 2 * SHM_K); DMA_V(1, SHM_V);
    SBAR(); qkt<ND, BIAS>(pA0, pA1, K_lds + s_0, ksub, r32, hi, qr, BL(0));
    MASKT(pA0, pA1, 0); partialSM<BIAS != 0>(pA0, pA1, ROWC(0));
    WAIT_BAR(4);
    ROT();
#define STEP(PX0, PX1, PY0, PY1, t) do { \
        DMA_K((t) + 2, s_p2); DMA_V((t) + 1, s_p1); \
        const bool act_ = !CAUSAL || (t) <= tl;       \
        SBAR(); if (act_) qkt<ND, BIAS>(PX0, PX1, K_lds + s_0, ksub, r32, hi, qr, BL(t)); \
        if (!CAUSAL || (t) - 1 <= tl) { finishSM(PY0, PY1, l_reg, pa0, pa1, pa2, pa3); SBAR(); \
            pv_tile(o, vb0 + s_m1, pa0, pa1, pa2, pa3); }       \
        if (act_) { MASKT(PX0, PX1, (t)); partialSM<BIAS != 0>(PX0, PX1, ROWC(t)); } else { PX0 = f32x16{}; PX1 = ninf16(); }   \
        WAIT_BAR(4); \
        ROT(); } while (0)
    int t = 1;
    for (; t + 1 < NT; t += 2) {
        STEP(pB0, pB1, pA0, pA1, t);
        STEP(pA0, pA1, pB0, pB1, t + 1);
    }
    const bool even = (NT & 1) == 0;
    const bool actL = !CAUSAL || NT - 1 <= tl;
    if (even && actL) { SBAR(); qkt<ND, BIAS>(pB0, pB1, K_lds + s_0, ksub, r32, hi, qr, BL(NT - 1)); SBAR(); }
    if (!CAUSAL || (even ? NT - 2 : NT - 1) <= tl) { finishSM(pA0, pA1, l_reg, pa0, pa1, pa2, pa3); SBAR();
        pv_tile(o, vb0 + s_m1, pa0, pa1, pa2, pa3); }
    if (even) { if (actL) { MASKT(pB0, pB1, NT - 1); partialSM<BIAS != 0>(pB0, pB1, ROWC(NT - 1)); } WAIT_BAR(0);
        if (actL) { finishSM(pB0, pB1, l_reg, pa0, pa1, pa2, pa3); SBAR(); pv_tile(o, vb0 + s_0, pa0, pa1, pa2, pa3); } }
    asm volatile("s_waitcnt vmcnt(0)" ::: "memory");
    l_out = l_reg;
#undef DMA_K
#undef DMA_V
#undef WAIT_BAR
#undef MASKT
#undef BL
#undef ROWC
#undef ROT
#undef STEP
}
__device__ __forceinline__ void store_rows_bf16(const f32x16 (&o)[4], float l_reg, bf16_t* Ow, int op, LAS char* lds, const bf16_t* Gw, int gp) {
    int tid = threadIdx.x; asm volatile("" : "+v"(tid));
    const int wid = __builtin_amdgcn_readfirstlane(tid >> 6), lane = tid & 63, r32 = lane & 31, hi = lane >> 5;
    LAS float* li_l = (LAS float*)(lds + WS_OFF) + wid * 64;
    if (hi == 0) li_l[r32] = l_reg;
    asm volatile("s_waitcnt lgkmcnt(0)" ::: "memory");
    float rli[16];
#pragma unroll
    for (int r = 0; r < 16; ++r) rli[r] = __builtin_amdgcn_rcpf(li_l[crow(r, hi)]);
    u32x4 gin[8];
#pragma unroll
    for (int i = 0; i < 8; ++i) { const int id = i * 64 + lane, row = id >> 4, ch = id & 15; gin[i] = *(const u32x4*)(Gw + (size_t)row * gp + ch * 8); }
    __syncthreads();
    LAS bf16_t* stg = (LAS bf16_t*)lds + wid * (32 * 136);
#pragma unroll
    for (int r = 0; r < 16; ++r) { const int orow = crow(r, hi);
#pragma unroll
        for (int d0 = 0; d0 < 4; ++d0) { const unsigned w = cvtpk(o[d0][r] * rli[r], 0.f); stg[orow * 136 + d0 * 32 + r32] = (bf16_t)(w & 0xffffu); } }
    asm volatile("s_waitcnt lgkmcnt(0)" ::: "memory");
#pragma unroll
    for (int i = 0; i < 8; ++i) { const int id = i * 64 + lane, row = id >> 4, ch = id & 15;
        const u32x4 v = *(LAS const u32x4*)(stg + row * 136 + ch * 8); const u32x4 gq = gin[i]; u32x4 w;
        w.x = cvtpk(bf_lo(v.x) * bf_lo(gq.x), bf_hi(v.x) * bf_hi(gq.x)); w.y = cvtpk(bf_lo(v.y) * bf_lo(gq.y), bf_hi(v.y) * bf_hi(gq.y));
        w.z = cvtpk(bf_lo(v.z) * bf_lo(gq.z), bf_hi(v.z) * bf_hi(gq.z)); w.w = cvtpk(bf_lo(v.w) * bf_lo(gq.w), bf_hi(v.w) * bf_hi(gq.w));
        st16(Ow + (size_t)row * op + ch * 8, w); }
    asm volatile("s_waitcnt lgkmcnt(0)" ::: "memory");
    __syncthreads();
}
#undef KSWZ
#undef SBAR
}

typedef GAS unsigned gu32;
#define RLX_AGENT __ATOMIC_RELAXED, __HIP_MEMORY_SCOPE_AGENT
#define XB_TMO      128
#define XB_XCNT(j)  (256  + 64 * (j))
#define XB_XSUB(j)  (1280 + 64 * (j))
#define XB_XGEN(j)  (2304 + 64 * (j))
#define XB_TOP      3328
#define XB_TOPGEN   3392
#define XCD_BAR_WORDS 3456
#define XB_SPIN_CAP (1u << 18)
__device__ __forceinline__ unsigned xb_ld(unsigned* p)              { return __hip_atomic_load(p, __ATOMIC_RELAXED, __HIP_MEMORY_SCOPE_AGENT); }
__device__ __forceinline__ unsigned xb_add(unsigned* p, unsigned v) { return __hip_atomic_fetch_add(p, v, __ATOMIC_RELAXED, __HIP_MEMORY_SCOPE_AGENT); }
__device__ __forceinline__ unsigned xb_xcc_id() { return (unsigned)__builtin_amdgcn_s_getreg((3 << 11) | 20) & 0xFu; }
#define XB_SPIN(cond, bar) do { unsigned _sp = 0; while (cond) { __builtin_amdgcn_s_sleep(1); \
    if ((++_sp & 255u) == 0u) { if (xb_ld(&(bar)[XB_TMO])) break; if (_sp > XB_SPIN_CAP) { atomicAdd(&(bar)[XB_TMO], 1u); break; } } } } while (0)
struct XcdBarrier { unsigned* bar; unsigned x; volatile LAS unsigned* st; };
__device__ __forceinline__ XcdBarrier xcd_barrier_post(unsigned* bar, volatile LAS unsigned* st) {
    XcdBarrier b; b.bar = bar; b.x = xb_xcc_id(); b.st = st;
    if (threadIdx.x == 0) (void)xb_add(&bar[XB_XCNT(b.x)], 1u);
    return b;
}
__device__ __forceinline__ void xcd_barrier_complete(unsigned* bar, unsigned x, unsigned& nloc, unsigned& nx) {
    const unsigned G = gridDim.x * gridDim.y * gridDim.z;
    unsigned sum, cnt, mine, sp = 0u;
    for (;;) {
        sum = 0u; cnt = 0u; mine = 0u;
#pragma unroll
        for (unsigned j = 0; j < 16; ++j) { const unsigned c = xb_ld(&bar[XB_XCNT(j)]); sum += c; cnt += (c > 0u) ? 1u : 0u; mine = (j == x) ? c : mine; }
        if (sum == G) break;
        __builtin_amdgcn_s_sleep(1);
        if ((++sp & 255u) == 0u) { if (xb_ld(&bar[XB_TMO])) break; if (sp > XB_SPIN_CAP) { atomicAdd(&bar[XB_TMO], 1u); break; } }
    }
    nloc = mine > 0u ? mine : 1u; nx = cnt > 0u ? cnt : 1u;
}
__device__ __forceinline__ void xcd_barrier(const XcdBarrier& b) {
    asm volatile("s_waitcnt vmcnt(0)" ::: "memory");
    __syncthreads();
    if (threadIdx.x == 0) {
        unsigned* bar = b.bar;
        __builtin_amdgcn_s_waitcnt(0);
        unsigned nloc = b.st[0], nx = b.st[1];
        if (nloc == 0u) { xcd_barrier_complete(bar, b.x, nloc, nx); b.st[0] = nloc; b.st[1] = nx; }
        const unsigned old = xb_add(&bar[XB_XSUB(b.x)], 1u);
        const unsigned gen = old / nloc;
        if (old + 1u == (gen + 1u) * nloc) {
            __builtin_amdgcn_fence(__ATOMIC_RELEASE, "agent");
            asm volatile("s_waitcnt vmcnt(0)" ::: "memory");
            const unsigned og = xb_add(&bar[XB_TOP], 1u);
            const unsigned tg = og / nx;
            if (og + 1u == (tg + 1u) * nx) xb_add(&bar[XB_TOPGEN], 1u);
            else XB_SPIN(xb_ld(&bar[XB_TOPGEN]) == tg, bar);
            __builtin_amdgcn_fence(__ATOMIC_ACQUIRE, "agent");
            xb_add(&bar[XB_XGEN(b.x)], 1u);
            asm volatile("s_waitcnt vmcnt(0)" ::: "memory");
        } else {
            XB_SPIN(xb_ld(&bar[XB_XGEN(b.x)]) == gen, bar);
            __builtin_amdgcn_fence(__ATOMIC_ACQUIRE, "agent");
            asm volatile("s_waitcnt vmcnt(0)" ::: "memory");
        }
    }
    __syncthreads();
}

struct Args { const float* in[25]; float* out; unsigned char* ws; int ph_lo, ph_hi; };
struct Frame {
    LAS unsigned char* lds;
    int tid, lane, wave, vcu, G;
    unsigned char* ws;
};

struct P0Job { const float* W; const float* g; bf16_t* dst; int ldw, src0, K, dst0, nblk, r, src1; };
__device__ __forceinline__ void p0_load(const P0Job& j, int lane, float (&v)[32]) {
    const int kb = j.r / j.nblk, nb = j.r % j.nblk;
    const int n = lane & 31;
    const int col = j.src1 > 0 ? ((n & 4) ? j.src1 : j.src0) + 16 * nb + 4 * (n >> 3) + (n & 3) : j.src0 + 32 * nb + n;
    const float* src = j.W + (size_t)(64 * kb) * j.ldw + col + (size_t)(lane >> 5) * j.ldw;
#pragma unroll
    for (int i = 0; i < 32; ++i) v[i] = __builtin_nontemporal_load(src + (size_t)(2 * i) * j.ldw);
}
__device__ __forceinline__ void p0_finish(const P0Job& j, int lane, const float (&v)[32], LAS float* scr) {
    const int kb = j.r / j.nblk, nb = j.r % j.nblk, k0 = 64 * kb;
    const int L = j.dst0 + 32 * nb, c = L & 255, rowbase = (L & ~255) + 128 * ((c >> 5) & 1) + 32 * (c >> 6);
#pragma unroll
    for (int i = 0; i < 32; ++i) scr[(2 * i + (lane >> 5)) * 33 + (lane & 31)] = v[i];
    LDS_WAIT(); asm volatile("" ::: "memory");
    const int cc = lane & 7;
    f32x4 g0 = {1.f, 1.f, 1.f, 1.f}, g1 = {1.f, 1.f, 1.f, 1.f};
    if (j.g) { g0 = *(const f32x4*)(j.g + k0 + 8 * cc); g1 = *(const f32x4*)(j.g + k0 + 8 * cc + 4); }
#pragma unroll
    for (int jj = 0; jj < 4; ++jj) { const int n = (lane >> 3) + 8 * jj; const LAS float* sp = scr + (8 * cc) * 33 + n;
        u32x4 o; o.x = cvtpk(sp[0 * 33] * g0[0], sp[1 * 33] * g0[1]); o.y = cvtpk(sp[2 * 33] * g0[2], sp[3 * 33] * g0[3]);
        o.z = cvtpk(sp[4 * 33] * g1[0], sp[5 * 33] * g1[1]); o.w = cvtpk(sp[6 * 33] * g1[2], sp[7 * 33] * g1[3]);
        *(u32x4*)(j.dst + (size_t)(rowbase + n) * j.K + k0 + 8 * cc) = o; }
    LDS_WAIT(); asm volatile("" ::: "memory");
}
template <bool NORM> __device__ __forceinline__ void row_to_bf16(const float* xrow, bf16_t* orow, float* rstd_out, int lane) {
    const f32x4* xr = (const f32x4*)xrow + lane;
    f32x4 v[4]; float s = 0.f;
#pragma unroll
    for (int j = 0; j < 4; ++j) { v[j] = __builtin_nontemporal_load(xr + 64 * j); s += (v[j].x * v[j].x + v[j].y * v[j].y) + (v[j].z * v[j].z + v[j].w * v[j].w); }
    const float rstd = 1.0f / sqrtf(wave_sum(s) * (1.0f / DM) + EPS);
    const float sc = NORM ? rstd : 1.f;
    u32x2* o8 = (u32x2*)orow + lane;
#pragma unroll
    for (int j = 0; j < 4; ++j) { u32x2 w; w.x = cvtpk(v[j].x * sc, v[j].y * sc); w.y = cvtpk(v[j].z * sc, v[j].w * sc); o8[64 * j] = w; }
    if (rstd_out && lane == 0) *rstd_out = rstd;
}

__global__ void __launch_bounds__(512, 2) hybrid_fwd(Args args) {
    extern __shared__ __attribute__((aligned(16))) unsigned char lds_raw[];
    Frame F;
    F.lds = (LAS unsigned char*)lds_raw;
    F.tid = threadIdx.x; F.lane = F.tid & 63; F.wave = __builtin_amdgcn_readfirstlane(F.tid >> 6);
    F.G = gridDim.x; { const int bx = blockIdx.x; F.vcu = (F.G % 8 == 0) ? (bx % 8) * (F.G / 8) + bx / 8 : bx; }
    F.ws = args.ws;
    unsigned char* ws = args.ws;
    volatile LAS unsigned* MISC = (volatile LAS unsigned*)(F.lds + MISC_OFF);
    for (int u = F.tid; u < (LDS_BYTES - LDSCTL_OFF) / 4; u += 512) ((LAS unsigned*)(F.lds + LDSCTL_OFF))[u] = 0u;
    __syncthreads();
    unsigned* ctl = (unsigned*)(ws + WS_CTL);
    XcdBarrier bar; bar.bar = ctl + CW_BAR; bar.x = 0; bar.st = nullptr;
    if (MK_N_LAUNCHES == 1) bar = xcd_barrier_post(ctl + CW_BAR, MISC + 8);
    const int lo = args.ph_lo, hi_ph = args.ph_hi;
#ifndef PHASE_MASK
#define PHASE_MASK 0x1ff
#endif
#define IN(k) (((PHASE_MASK >> (k)) & 1) && lo <= (k) && (k) < hi_ph)
#if DUP_MASK
#define REPS(k) for (int rep_ = ((DUP_MASK >> (k)) & 1) ? 0 : 1; rep_ < 2; ++rep_)
#define DRY (rep_ == 0)
#else
#define REPS(k)
#define DRY false
#endif
#if PROBE_A >= 0
#define STAMP(k) do { if (blockIdx.x == 0 && F.tid == 0) MISC[16 + (k)] = (unsigned)__builtin_amdgcn_s_memrealtime(); } while (0)
#else
#define STAMP(k)
#endif
#define SEAM(k) do { if (MK_N_LAUNCHES == 1 && IN(k) && (IN((k) + 1) || (((k) == 2 || (k) == 6) && IN((k) + 2)))) xcd_barrier(bar); STAMP((k) + 1); } while (0)

    const float* x = args.in[0]; const float* mem = args.in[1];
    bf16_t* xb = (bf16_t*)args.out;
    float* hout = args.out;
    float* rstd0 = (float*)(ws + WS_RSTD0); float* ssq1 = (float*)(ws + WS_SSQ1); float* WF = (float*)(ws + WS_WF); float* LF = (float*)(ws + WS_LF);
    bf16_t *WA_e = (bf16_t*)(ws + WS_WA_E), *WG_e = (bf16_t*)(ws + WS_WG_E), *WO_e = (bf16_t*)(ws + WS_WO_E), *WM_e = (bf16_t*)(ws + WS_WM_E);
    bf16_t *WA_o = (bf16_t*)(ws + WS_WA_O), *WG_o = (bf16_t*)(ws + WS_WG_O), *WO_o = (bf16_t*)(ws + WS_WO_O), *WM_o = (bf16_t*)(ws + WS_WM_O);
    bf16_t *memn = (bf16_t*)(ws + WS_MEMN), *MK_e = (bf16_t*)(ws + WS_MK_E), *MV_e = (bf16_t*)(ws + WS_MV_E), *MK_o = (bf16_t*)(ws + WS_MK_O), *MV_o = (bf16_t*)(ws + WS_MV_O);
    bf16_t *Y = (bf16_t*)(ws + WS_Y), *R1 = (bf16_t*)(ws + WS_R1), *R2 = (bf16_t*)(ws + WS_R2), *R3 = (bf16_t*)(ws + WS_R3), *BB = (bf16_t*)(ws + WS_BB);
    LAS float* xch = (LAS float*)(F.lds + XCH_OFF);
    bf16_t* GA_e = (bf16_t*)args.out + (size_t)M * 1024;
    bf16_t* GX_e = R2 + (size_t)M * 1024;
    bf16_t* G1 = (bf16_t*)args.out;
    LAS char* alds = (LAS char*)F.lds;

    STAMP(0);
    if (IN(0)) REPS(0) {
        LAS float* scr = (LAS float*)(F.lds + F.wave * 16384);
        const int gw = F.vcu * 8 + F.wave, NGW = F.G * 8;
#define P0_DECODE(J, it_) do { int r = (it_); \
            if (r < 16 * 96) { J = P0Job{args.in[3], args.in[2], WA_e, 7168, 0, 1024, 0, 96, r}; break; } r -= 16 * 96;              \
            if (r < 16 * 32) { J = P0Job{args.in[3], args.in[2], WA_e, 7168, 4096, 1024, 3072, 32, r, 4608}; break; } r -= 16 * 32;   \
            if (r < 16 * 16) { J = P0Job{args.in[3], args.in[2], WA_e, 7168, 5120, 1024, 4096, 16, r, 5632}; break; } r -= 16 * 16;   \
            if (r < 16 * 16) { J = P0Job{args.in[3], args.in[2], WA_e, 7168, 6144, 1024, 4608, 16, r}; break; } r -= 16 * 16;        \
            if (r < 16 * 32) { J = P0Job{args.in[3], args.in[2], WG_e, 7168, 3072, 1024, 0, 32, r}; break; } r -= 16 * 32;           \
            if (r < 16 * 16) { J = P0Job{args.in[3], args.in[2], WG_e, 7168, 5376, 1024, 1024, 16, r, 5888}; break; } r -= 16 * 16;   \
            if (r < 16 * 16) { J = P0Job{args.in[3], args.in[2], WG_e, 7168, 6656, 1024, 1536, 16, r}; break; } r -= 16 * 16;        \
            if (r < 32 * 32) { J = P0Job{args.in[4], nullptr, WO_e, 1024, 0, 2048, 0, 32, r}; break; } r -= 32 * 32;                 \
            if (r < 16 * 32) { J = P0Job{args.in[14], args.in[13], WM_e, 1024, 0, 1024, 0, 32, r}; break; } r -= 16 * 32;            \
            if (r < 16 * 144) { J = P0Job{args.in[16], args.in[15], WA_o, 7180, 0, 1024, 0, 144, r}; break; } r -= 16 * 144;         \
            if (r < 16 * 16) { J = P0Job{args.in[16], args.in[15], WA_o, 7180, 6156, 1024, 4608, 16, r}; break; } r -= 16 * 16;      \
            if (r < 16 * 48) { J = P0Job{args.in[16], args.in[15], WG_o, 7180, 4608, 1024, 0, 48, r}; break; } r -= 16 * 48;         \
            if (r < 16 * 16) { J = P0Job{args.in[16], args.in[15], WG_o, 7180, 6668, 1024, 1536, 16, r}; break; } r -= 16 * 16;      \
            if (r < 32 * 32) { J = P0Job{args.in[17], nullptr, WO_o, 1024, 0, 2048, 0, 32, r}; break; } r -= 32 * 32; \
            J = P0Job{args.in[24], args.in[23], WM_o, 1024, 0, 1024, 0, 32, r}; } while (0)
        { int it = gw; P0Job cur{}, nxt{}; float va[32], vb[32];
#define P0_IDX(i_) ((i_) < 3584 ? (i_) : (i_) < 4096 ? (i_) + 1024 : (i_) + 5632)
          if (it < 4608) { P0_DECODE(cur, P0_IDX(it)); p0_load(cur, F.lane, va); }
          while (it < 4608) {
              const int itn = it + NGW; const bool hn = itn < 4608;
              if (hn) { P0_DECODE(nxt, P0_IDX(itn)); p0_load(nxt, F.lane, vb); }
              p0_finish(cur, F.lane, va, scr);
#pragma unroll
              for (int i = 0; i < 32; ++i) va[i] = vb[i];
              cur = nxt; it = itn;
          } }
        for (int m = gw; m < M; m += 4 * NGW) {
            f32x4 v[4][4]; float ss[4];
#pragma unroll
            for (int q = 0; q < 4; ++q) { const int mq = (m + q * NGW < M) ? m + q * NGW : m; const f32x4* xr = (const f32x4*)(x + (size_t)mq * DM) + F.lane;
#pragma unroll
                for (int j = 0; j < 4; ++j) v[q][j] = __builtin_nontemporal_load(xr + 64 * j); }
#pragma unroll
            for (int q = 0; q < 4; ++q) { float t = 0.f;
#pragma unroll
                for (int j = 0; j < 4; ++j) t += (v[q][j].x * v[q][j].x + v[q][j].y * v[q][j].y) + (v[q][j].z * v[q][j].z + v[q][j].w * v[q][j].w);
                ss[q] = t; }
#pragma unroll
            for (int o = 1; o < 64; o <<= 1) {
#pragma unroll
                for (int q = 0; q < 4; ++q) ss[q] += __shfl_xor(ss[q], o); }
#pragma unroll
            for (int q = 0; q < 4; ++q) { const int mm = m + q * NGW; if (mm >= M) continue; u32x2* o8 = (u32x2*)(xb + (size_t)mm * DM) + F.lane;
#pragma unroll
                for (int j = 0; j < 4; ++j) { u32x2 w; w.x = cvtpk(v[q][j].x, v[q][j].y); w.y = cvtpk(v[q][j].z, v[q][j].w); o8[64 * j] = w; }
                if (F.lane == 0) rstd0[mm] = 1.0f / sqrtf(ss[q] * (1.0f / DM) + EPS); }
        }
        for (int m = gw; m < MM; m += NGW) row_to_bf16<true>(mem + (size_t)m * DM, memn + (size_t)m * DM, nullptr, F.lane);
        for (int i = (F.vcu * 512 + F.tid); i < 16 * 1024; i += F.G * 512) { const int c = i >> 10, k = i & 1023;
            const float wv_ = c < 12 ? args.in[15][k] * args.in[16][(size_t)k * 7180 + 6144 + c] : 0.f; ((bf16_t*)WF)[i] = (bf16_t)(cvtpk(wv_, 0.f) & 0xffffu); }
    }
    SEAM(0);

    if (IN(1)) REPS(1) {
        if (STAGGER_TICKS > 0 && ((blockIdx.x >> 3) & 1)) { const unsigned long long t0 = __builtin_amdgcn_s_memrealtime(); while (__builtin_amdgcn_s_memrealtime() - t0 < (unsigned long long)STAGGER_TICKS) __builtin_amdgcn_s_sleep(8); }
        pg8::Gemm g{xb, WA_e, M, 7168, DM}; pg8::StaticOrder S; S.init(M, 7168, F.G, (int)blockIdx.x);
        pg8::EpiProj E{0, rstd0, nullptr, Y, R1, R2, R3, BB, nullptr, nullptr, args.in[5], args.in[6], args.in[11], nullptr, xch, GA_e, GX_e};
        pg8::gemm_phase<pg8::EpiProj, pg8::StaticOrder, true>(F.lds, g, S, E);
    }
    SEAM(1);

#define Q_POP_FIRST(qh) do { if (F.tid == 0) MISC[12] = xb_add((qh), 1u); LDS_WAIT(); __syncthreads(); cur = (int)MISC[12]; __syncthreads(); } while (0)
#define Q_PREFETCH(qh) unsigned nxt_reg_ = 0u; if (F.tid == 0) nxt_reg_ = xb_add((qh), 1u)
#define Q_NEXT() do { if (F.tid == 0) MISC[12] = nxt_reg_; LDS_WAIT(); __syncthreads(); cur = (int)MISC[12]; __syncthreads(); } while (0)
    if (IN(2)) REPS(2) {
        bf16_t* dummy = (bf16_t*)(ws + WS_END) + (size_t)(F.vcu * 8 + F.wave) * 2048;
        unsigned* qh = ctl + CW_Q2 + (DRY ? 64 : 0); unsigned* mkv_done = ctl + CW_MKV;
        const int r32 = F.lane & 31, hi = F.lane >> 5;
        float lam;
        { const float* lp = args.in[7]; const float a = wave_sum(lp[F.lane] * lp[64 + F.lane]), b = wave_sum(lp[128 + F.lane] * lp[192 + F.lane]);
          lam = __builtin_bit_cast(float, __builtin_amdgcn_readfirstlane(__builtin_bit_cast(int, expf(a) - expf(b) + LAM_INIT))); }
        float zb, b2;
        { float gq = fabsf(args.in[5][F.lane]), gk = fabsf(args.in[6][F.lane]);
#pragma unroll
          for (int o = 1; o < 64; o <<= 1) { gq = fmaxf(gq, __shfl_xor(gq, o)); gk = fmaxf(gk, __shfl_xor(gk, o)); }
          b2 = __builtin_bit_cast(float, __builtin_amdgcn_readfirstlane(__builtin_bit_cast(int, 16.0f * gq * gk))); zb = ZSKIP + b2; }
        const float eoff64 = fmaxf(0.f, b2 * 0.5f * LOG2E - 100.0f);
        int cur; Q_POP_FIRST(qh);
        while ((P2_PARTS & 1) && cur < 64) {
            Q_PREFETCH(qh);
            { const int lay = cur >> 5, uu = cur & 31; pg8::OneUnit S{uu >> 2, uu & 3};
              pg8::Gemm g{memn, lay ? WM_o : WM_e, MM, 1024, DM};
              pg8::EpiProj E{2, nullptr, nullptr, nullptr, nullptr, nullptr, nullptr, nullptr, lay ? MK_o : MK_e, lay ? MV_o : MV_e, nullptr, nullptr, nullptr, lay ? args.in[22] : args.in[12], xch, nullptr, nullptr};
              pg8::gemm_phase<pg8::EpiProj, pg8::OneUnit, true>(F.lds, g, S, E);
              if (F.tid == 0 && !DRY) { __builtin_amdgcn_fence(__ATOMIC_RELEASE, "agent"); asm volatile("s_waitcnt vmcnt(0)" ::: "memory"); xb_add(mkv_done, 1u); } }
            Q_NEXT();
        }
        asm volatile("" ::: "memory");
#define DIFF_DECODE(c_) const int j = (c_) - 64, qb = 15 - (j >> 6), bh = j & 63, b = bh >> 3, h = bh & 7, sub = F.wave >> 2, w4 = sub ? 3 - (F.wave & 3) : (F.wave & 3);     \
              const float slope = exp2f(-(float)(h + 1)), cslope = slope * LOG2E; \
              int jlo = 0; { const float dz = zb / slope, q0f = (float)(qb * 128); if (q0f > dz) jlo = (int)((q0f - dz) * (1.0f / 64.0f)); } \
              const size_t row0 = (size_t)b * SEQ + qb * 128; \
              bf16_t* Qw = Y + (row0 + w4 * 32) * 2048 + 128 * h + 64 * sub; \
              const bf16_t* Kp = R1 + (size_t)(b * SEQ + 64 * jlo) * 1024 + 128 * h; const bf16_t* Vp = R2 + (size_t)(b * SEQ + 64 * jlo) * 1024 + 128 * h
        att::Pre<4> PD;
        if ((P2_PARTS & 2) && cur < 1088) { DIFF_DECODE(cur); att::attn_preload<4>(PD, Qw, 2048); }
        while ((P2_PARTS & 2) && cur < 1088) {
            unsigned nxt_reg_ = 0u; if (F.tid == 0) nxt_reg_ = xb_add(qh, 1u);
            int nxt;
            { DIFF_DECODE(cur);
              if (F.tid < 64) ((LAS float*)(alds + att::BIAS_OFF))[F.tid] = cslope * (float)F.tid;
              f32x16 o[4]; float l;
              att::attn_core<4, 1, true>(PD, Kp, 1024, Vp, 1024, 2 * (qb + 1) - jlo, qb * 128 + w4 * 32 - 64 * jlo, 128 * sub, 0, cslope * 64.f, eoff64, alds, o, l);
              if (F.tid == 0) MISC[12] = nxt_reg_; LDS_WAIT(); __syncthreads(); nxt = (int)MISC[12];
              if (nxt < 1088) { DIFF_DECODE(nxt); att::attn_preload<4>(PD, Qw, 2048); }
              const int chq = F.lane & 15;
              LAS float* li_l = (LAS float*)(alds + att::WS_OFF) + F.wave * 64;
              if (hi == 0) li_l[r32] = l;
              LDS_WAIT();
              float rli[16];
#pragma unroll
              for (int r = 0; r < 16; ++r) rli[r] = __builtin_amdgcn_rcpf(li_l[att::crow(r, hi)]);
              __syncthreads();
              LAS float* X = (LAS float*)alds + w4 * (32 * 132);
              if (sub == 1) {
#pragma unroll
                  for (int r = 0; r < 16; ++r) { const int orow = att::crow(r, hi); const float f = rli[r] * lam;
#pragma unroll
                      for (int d0 = 0; d0 < 4; ++d0) X[orow * 132 + d0 * 32 + r32] = o[d0][r] * f; }
              }
              LDS_WAIT(); __syncthreads();
              if (sub == 0) {
#pragma unroll
                  for (int r = 0; r < 16; ++r) { const int orow = att::crow(r, hi);
#pragma unroll
                      for (int d0 = 0; d0 < 4; ++d0) { const float t = o[d0][r] * rli[r] - X[orow * 132 + d0 * 32 + r32]; X[orow * 132 + d0 * 32 + r32] = t; } }
                  u32x4 gin[8];
#pragma unroll
                  for (int i = 0; i < 8; ++i) gin[i] = *(const u32x4*)(GA_e + (row0 + w4 * 32 + 4 * i + (F.lane >> 4)) * 1024 + 128 * h + chq * 8);
                  const f32x4 g0 = *(const f32x4*)(args.in[8] + chq * 8), g1 = *(const f32x4*)(args.in[8] + chq * 8 + 4);
                  LDS_WAIT();
                  const LAS float* xr = X + r32 * 132 + hi * 64;
                  float ssum = 0.f;
#pragma unroll
                  for (int c = 0; c < 16; ++c) { const f32x4 t = *(const LAS f32x4*)(xr + 4 * c); ssum += (t[0] * t[0] + t[1] * t[1]) + (t[2] * t[2] + t[3] * t[3]); }
                  { auto rr = __builtin_amdgcn_permlane32_swap(__float_as_uint(ssum), __float_as_uint(ssum), false, false); ssum = __uint_as_float(rr[0]) + __uint_as_float(rr[1]); }
                  const float rn = (1.0f - LAM_INIT) * __builtin_amdgcn_rsqf(ssum * (1.0f / 128.0f) + EPS);
                  if (hi == 0) li_l[32 + r32] = rn;
                  LDS_WAIT();
#pragma unroll
                  for (int i = 0; i < 8; ++i) { const int row = 4 * i + (F.lane >> 4);
                      const LAS float* xs = X + row * 132 + chq * 8;
                      const f32x4 t0 = *(const LAS f32x4*)(xs), t1 = *(const LAS f32x4*)(xs + 4);
                      const float rv = li_l[32 + row];
                      const u32x4 gz = gin[i];
                      u32x4 w; w.x = cvtpk(t0[0] * rv * g0[0] * bf_lo(gz.x), t0[1] * rv * g0[1] * bf_hi(gz.x)); w.y = cvtpk(t0[2] * rv * g0[2] * bf_lo(gz.y), t0[3] * rv * g0[3] * bf_hi(gz.y));
                      w.z = cvtpk(t1[0] * rv * g1[0] * bf_lo(gz.z), t1[1] * rv * g1[1] * bf_hi(gz.z)); w.w = cvtpk(t1[2] * rv * g1[2] * bf_lo(gz.w), t1[3] * rv * g1[3] * bf_hi(gz.w));
                      bf16_t* op_ = DRY ? dummy + row * 32 + chq * 8 : Y + (row0 + w4 * 32 + row) * 2048 + 128 * h + chq * 8;
                      st16(op_, w); }
              }
              LDS_WAIT(); __syncthreads(); }
            cur = nxt;
        }
#undef DIFF_DECODE
        asm volatile("" ::: "memory");
        if (cur < 1344) {
            if (F.tid == 0) { unsigned sp = 0; while (xb_ld(mkv_done) < 64u && !DRY) { __builtin_amdgcn_s_sleep(2); if (++sp > (1u << 22)) break; }
                __builtin_amdgcn_fence(__ATOMIC_ACQUIRE, "agent"); asm volatile("s_waitcnt vmcnt(0)" ::: "memory"); }
            __syncthreads();
        }
#define CROSS_DECODE(c_, base_, MK_, MV_) const int c = (c_) - (base_), b = c >> 5, hd = (c >> 3) & 3, qb = c & 7; \
              bf16_t* Qw = Y + (size_t)(b * SEQ + qb * 256 + F.wave * 32) * 2048 + 1536 + 128 * hd; \
              const bf16_t* Kp = (MK_) + (size_t)(b * MEML) * 512 + 128 * hd; const bf16_t* Vp = (MV_) + (size_t)(b * MEML) * 512 + 128 * hd
        att::Pre<8> PX;
        if ((P2_PARTS & 4) && cur < 1344) { CROSS_DECODE(cur, 1088, MK_e, MV_e); att::attn_preload<8>(PX, Qw, 2048); }
        while ((P2_PARTS & 4) && cur < 1344) {
            unsigned nxt_reg_ = 0u; if (F.tid == 0) nxt_reg_ = xb_add(qh, 1u);
            int nxt;
            { CROSS_DECODE(cur, 1088, MK_e, MV_e);
              f32x16 o[4]; float l;
              att::attn_core<8, 0, false>(PX, Kp, 512, Vp, 512, 4, 0, 0, 0, 0.f, 0.f, alds, o, l);
              if (F.tid == 0) MISC[12] = nxt_reg_; LDS_WAIT(); __syncthreads(); nxt = (int)MISC[12];
              bf16_t* Ow = DRY ? dummy : Qw; const bf16_t* GXw = GX_e + (size_t)(b * SEQ + qb * 256 + F.wave * 32) * 512 + 128 * hd;
              if (nxt < 1344) { CROSS_DECODE(nxt, 1088, MK_e, MV_e); att::attn_preload<8>(PX, Qw, 2048); }
              att::store_rows_bf16(o, l, Ow, DRY ? 32 : 2048, alds, GXw, 512); }
            cur = nxt;
        }
        asm volatile("" ::: "memory");
        while ((P2_PARTS & 8) && cur < 1600) {
            Q_PREFETCH(qh);
            { const int ch = (F.tid & 63) * 8, t0 = 64 * (cur - 1344) + 8 * (F.tid >> 6);
              const float* cw = args.in[9]; const float* cbp = args.in[10];
              u32x4 uin[10], gin[8];
              const bool halo = (t0 & (SEQ - 1)) != 0;
#pragma unroll
              for (int rr = 0; rr < 10; ++rr) { const size_t t = (size_t)((halo || rr >= 2) ? t0 - 2 + rr : t0); uin[rr] = *(const u32x4*)(R3 + t * 512 + ch); }
#pragma unroll
              for (int rr = 0; rr < 8; ++rr) gin[rr] = *(const u32x4*)(BB + (size_t)(t0 + rr) * 512 + ch);
              float w0[8], w1[8], w2[8], bsv[8], um2[8], um1[8];
#pragma unroll
              for (int j = 0; j < 8; ++j) { w0[j] = cw[ch + j]; w1[j] = cw[512 + ch + j]; w2[j] = cw[1024 + ch + j]; bsv[j] = cbp[ch + j]; }
#define CONV_U(dst, U_) do { dst[0] = bf_lo(U_.x); dst[1] = bf_hi(U_.x); dst[2] = bf_lo(U_.y); dst[3] = bf_hi(U_.y); dst[4] = bf_lo(U_.z); dst[5] = bf_hi(U_.z); dst[6] = bf_lo(U_.w); dst[7] = bf_hi(U_.w); } while (0)
              CONV_U(um2, uin[0]); CONV_U(um1, uin[1]);
              if (!halo) {
#pragma unroll
                  for (int j = 0; j < 8; ++j) { um2[j] = 0.f; um1[j] = 0.f; } }
#pragma unroll
              for (int rr = 0; rr < 8; ++rr) { const size_t t = (size_t)(t0 + rr);
                  float u0[8], gv[8], yv[8];
                  CONV_U(u0, uin[rr + 2]); CONV_U(gv, gin[rr]);
#pragma unroll
                  for (int j = 0; j < 8; ++j) { yv[j] = gv[j] * (w0[j] * um2[j] + w1[j] * um1[j] + w2[j] * u0[j] + bsv[j]); um2[j] = um1[j]; um1[j] = u0[j]; }
                  u32x4 w; w.x = cvtpk(yv[0], yv[1]); w.y = cvtpk(yv[2], yv[3]); w.z = cvtpk(yv[4], yv[5]); w.w = cvtpk(yv[6], yv[7]);
                  *(u32x4*)(DRY ? dummy + (rr & 7) * 64 : Y + t * 2048 + 1024 + ch) = w; }
#undef CONV_U
            }
            Q_NEXT();
        }
        asm volatile("" ::: "memory");
        while (cur < 2176) {
            Q_PREFETCH(qh);
            { const int n_ = 8 * (cur - 1600) + F.wave; P0Job jb{}; P0_DECODE(jb, (n_ < 1024 ? 3584 + n_ : 4096 + n_)); float vv[32];
              p0_load(jb, F.lane, vv); p0_finish(jb, F.lane, vv, (LAS float*)(F.lds + F.wave * 16384)); }
            Q_NEXT();
        }
    }
    SEAM(2);

    if (IN(4)) REPS(4) {
        pg8::Gemm g{Y, WO_e, M, DM, 2048}; pg8::StaticOrder S; S.init(M, DM, F.G, (int)blockIdx.x);
        pg8::EpiOut<true> E{xb, nullptr, R3, ssq1, DRY ? 1 : 0};
        pg8::gemm_phase<pg8::EpiOut<true>, pg8::StaticOrder, true>(F.lds, g, S, E);
    }
    SEAM(4);

    if (IN(5)) REPS(5) {
        for (int v = F.vcu; v < 256; v += F.G) {
            const int w4 = F.wave & 3, kh = F.wave >> 2, fr = F.lane & 15, fq = F.lane >> 4, row0 = 64 * v + 16 * w4;
            const bf16_t* ap = R3 + (size_t)(row0 + fr) * DM + kh * 512 + 8 * fq;
            const bf16_t* bp = (const bf16_t*)WF + (size_t)fr * DM + kh * 512 + 8 * fq;
            f32x4 facc = {0.f, 0.f, 0.f, 0.f};
#pragma unroll 8
            for (int ks = 0; ks < 16; ++ks) { const bf16x8 a = *(const bf16x8*)(ap + 32 * ks), bb = *(const bf16x8*)(bp + 32 * ks);
                facc = __builtin_amdgcn_mfma_f32_16x16x32_bf16(a, bb, facc, 0, 0, 0); }
            LAS f32x4* fx = (LAS f32x4*)F.lds + w4 * 64 + F.lane;
            if (kh == 1) *fx = facc;
            LDS_WAIT(); __syncthreads();
            if (kh == 0) { const f32x4 o2 = *fx; facc += o2;
                const float fbc = args.in[20][fr < 12 ? fr : 0];
                float sq[4];
#pragma unroll
                for (int r = 0; r < 4; ++r) sq[r] = ssq1[row0 + 4 * fq + r];
#pragma unroll
                for (int r = 0; r < 4; ++r) { const int row = row0 + 4 * fq + r;
                    const float f = facc[r] * __builtin_amdgcn_rsqf(sq[r] * (1.0f / DM) + EPS) + fbc;
                    const float ls = fminf(f, 0.f) - __logf(1.0f + __expf(-fabsf(f)));
                    if (fr < 12) LF[(size_t)row * 12 + fr] = ls; } }
            LDS_WAIT(); __syncthreads();
        }
        if (STAGGER_TICKS > 0 && ((blockIdx.x >> 3) & 1)) { const unsigned long long t0 = __builtin_amdgcn_s_memrealtime(); while (__builtin_amdgcn_s_memrealtime() - t0 < (unsigned long long)STAGGER_TICKS) __builtin_amdgcn_s_sleep(8); }
        pg8::Gemm g{R3, WA_o, M, 7168, DM}; pg8::StaticOrder S; S.init(M, 7168, F.G, (int)blockIdx.x);
        pg8::EpiProj E{1, nullptr, ssq1, Y, R1, R2, nullptr, nullptr, nullptr, nullptr, args.in[18], args.in[19], args.in[21], nullptr, xch, G1, nullptr};
        pg8::gemm_phase<pg8::EpiProj, pg8::StaticOrder, true>(F.lds, g, S, E);
    }
    SEAM(5);

    if (IN(6)) REPS(6) {
        bf16_t* dummy = (bf16_t*)(ws + WS_END) + (size_t)(F.vcu * 8 + F.wave) * 2048;
        unsigned* qh = ctl + CW_Q6 + (DRY ? 64 : 0);
        float eoff128, zbF;
        { float gq = fmaxf(fabsf(args.in[18][F.lane]), fabsf(args.in[18][64 + F.lane])), gk = fmaxf(fabsf(args.in[19][F.lane]), fabsf(args.in[19][64 + F.lane]));
#pragma unroll
          for (int o = 1; o < 64; o <<= 1) { gq = fmaxf(gq, __shfl_xor(gq, o)); gk = fmaxf(gk, __shfl_xor(gk, o)); }
          eoff128 = __builtin_bit_cast(float, __builtin_amdgcn_readfirstlane(__builtin_bit_cast(int, fmaxf(0.f, 11.3137085f * gq * gk * LOG2E - 100.0f))));
          zbF = __builtin_bit_cast(float, __builtin_amdgcn_readfirstlane(__builtin_bit_cast(int, (ZSKIP + 2.0f * 11.3137085f * gq * gk) * LOG2E))); }
        int cur; Q_POP_FIRST(qh);
#define FOX_DECODE(c_) const int qb = 7 - (c_) / 96, bh = (c_) % 96, b = bh / 12, h = bh % 12; \
              bf16_t* Qw = Y + (size_t)(b * SEQ + qb * 256 + F.wave * 32) * 2048 + 128 * h; \
              const bf16_t* Kp = R1 + (size_t)(b * SEQ) * 1536 + 128 * h; const bf16_t* Vp = R2 + (size_t)(b * SEQ) * 1536 + 128 * h
        att::Pre<8> PF; float lfp[4] = {0.f, 0.f, 0.f, 0.f};
#define FOX_LF_LOAD() do { const int n_ = 256 * (qb + 1), t0_ = 4 * F.tid; lfp[0] = lfp[1] = lfp[2] = lfp[3] = 0.f; \
            if (t0_ < n_) { const float* lf = LF + ((size_t)b * SEQ + t0_) * 12 + h; lfp[0] = lf[0]; lfp[1] = lf[12]; lfp[2] = lf[24]; lfp[3] = lf[36]; } } while (0)
        if (cur < 768) { FOX_DECODE(cur); att::attn_preload<8>(PF, Qw, 2048); FOX_LF_LOAD(); }
        while (cur < 768) {
            unsigned nxt_reg_ = 0u; if (F.tid == 0) nxt_reg_ = xb_add(qh, 1u);
            int nxt;
            { FOX_DECODE(cur);
              { const int n = 256 * (qb + 1), t0 = 4 * F.tid; const float v0 = lfp[0], v1 = lfp[1], v2 = lfp[2], v3 = lfp[3];
                const float s1 = v0, s2 = s1 + v1, s3 = s2 + v2, s4 = s3 + v3;
                float xs = s4;
#pragma unroll
                for (int off = 1; off < 64; off <<= 1) { const float t = __shfl_up(xs, off); if (F.lane >= off) xs += t; }
                LAS float* wtot = (LAS float*)(alds + att::SCAN_OFF);
                if (F.lane == 63) wtot[F.wave] = xs;
                LDS_WAIT(); __syncthreads();
                float pre = 0.f;
#pragma unroll
                for (int w = 0; w < 8; ++w) { const float t = wtot[w]; if (w < F.wave) pre += t; }
                const float ex = pre + (xs - s4);
                if (t0 < n) { LAS float* bl = (LAS float*)(alds + att::BIAS_OFF) + t0;
                    *(LAS f32x4*)bl = (f32x4){-(ex + s1) * LOG2E, -(ex + s2) * LOG2E, -(ex + s3) * LOG2E, -(ex + s4) * LOG2E}; }
              }
              f32x16 o[4]; float l;
              int jlo = 0;
              if (FOX_SKIP) { LDS_WAIT(); __syncthreads();
                  LAS const float* tb = (LAS const float*)(alds + att::BIAS_OFF);
                  const float d = tb[F.lane < 4 * qb ? 64 * F.lane + 63 : 0] - tb[256 * qb];
                  jlo = __builtin_popcountll(__ballot(F.lane < 4 * qb && d < -zbF)); }
              att::attn_core<8, 2, true>(PF, Kp + (size_t)(64 * jlo) * 1536, 1536, Vp + (size_t)(64 * jlo) * 1536, 1536, 4 * (qb + 1) - jlo, qb * 256 + F.wave * 32 - 64 * jlo, 0, 64 * jlo, 0.f, eoff128, alds, o, l);
              if (F.tid == 0) MISC[12] = nxt_reg_; LDS_WAIT(); __syncthreads(); nxt = (int)MISC[12];
              bf16_t* Ow = DRY ? dummy : Qw; const bf16_t* Gw = G1 + (size_t)(b * SEQ + qb * 256 + F.wave * 32) * 2048 + 128 * h;
              if (nxt < 768) { FOX_DECODE(nxt); att::attn_preload<8>(PF, Qw, 2048); FOX_LF_LOAD(); }
              att::store_rows_bf16(o, l, Ow, DRY ? 32 : 2048, alds, Gw, 2048); }
            cur = nxt;
        }
#undef FOX_DECODE
#undef FOX_LF_LOAD
        asm volatile("" ::: "memory");
        att::Pre<8> PX;
        if (cur < 1024) { CROSS_DECODE(cur, 768, MK_o, MV_o); att::attn_preload<8>(PX, Qw, 2048); }
        while (cur < 1024) {
            unsigned nxt_reg_ = 0u; if (F.tid == 0) nxt_reg_ = xb_add(qh, 1u);
            int nxt;
            { CROSS_DECODE(cur, 768, MK_o, MV_o);
              f32x16 o[4]; float l;
              att::attn_core<8, 0, false>(PX, Kp, 512, Vp, 512, 4, 0, 0, 0, 0.f, 0.f, alds, o, l);
              if (F.tid == 0) MISC[12] = nxt_reg_; LDS_WAIT(); __syncthreads(); nxt = (int)MISC[12];
              bf16_t* Ow = DRY ? dummy : Qw; const bf16_t* Gw = G1 + (size_t)(b * SEQ + qb * 256 + F.wave * 32) * 2048 + 1536 + 128 * hd;
              if (nxt < 1024) { CROSS_DECODE(nxt, 768, MK_o, MV_o); att::attn_preload<8>(PX, Qw, 2048); }
              att::store_rows_bf16(o, l, Ow, DRY ? 32 : 2048, alds, Gw, 2048); }
            cur = nxt;
        }
#undef CROSS_DECODE
        asm volatile("" ::: "memory");
        while (cur < 1152) {
            Q_PREFETCH(qh);
            { P0Job jb{}; P0_DECODE(jb, 8704 + 8 * (cur - 1024) + F.wave); float vv[32];
              p0_load(jb, F.lane, vv); p0_finish(jb, F.lane, vv, (LAS float*)(F.lds + F.wave * 16384)); }
            Q_NEXT();
        }
    }
    SEAM(6);

    if (IN(8)) REPS(8) {
        pg8::Gemm g{Y, WO_o, M, DM, 2048}; pg8::StaticOrder S; S.init(M, DM, F.G, (int)blockIdx.x);
        pg8::EpiOut<false> E{R3, hout, nullptr, nullptr, DRY ? 1 : 0};
        pg8::gemm_phase<pg8::EpiOut<false>, pg8::StaticOrder, true>(F.lds, g, S, E);
    }
#if PROBE_A >= 0
    xcd_barrier(bar); STAMP(9);
    if (blockIdx.x == 0) {
        const float ta = (float)(MISC[16 + PROBE_A + 1] - MISC[16 + PROBE_A]) * 0.000001f;
        const float tb = (PROBE_B >= 0) ? (float)(MISC[16 + (PROBE_B >= 0 ? PROBE_B : 0) + 1] - MISC[16 + (PROBE_B >= 0 ? PROBE_B : 0)]) * 0.0000025f : 0.05f;
        if (F.tid == 0) hout[0] += ta;
        for (int i = F.tid; i < (1 << 22); i += 512) hout[1024 + i] += tb;
    }
#endif
#undef P0_DECODE
#undef P0_IDX
#undef IN
#undef SEAM
#undef REPS
#undef DRY
}

extern "C" void kernel_launch(void* const* d_in, const int* in_sizes, int n_in, void* d_out, int out_size, void* d_ws, size_t ws_size, hipStream_t stream) {
    static int grid = 0;
    if (grid == 0) {
        if (n_in != 25 || in_sizes[0] != M * DM || out_size != M * DM || ws_size < WS_END) {
            fprintf(stderr, "kernel_launch: unexpected shapes (n_in %d, in0 %d, out %d, ws %zu); nothing launched\n", n_in, n_in > 0 ? in_sizes[0] : -1, out_size, ws_size); grid = -1; return; }
        int dev = 0, cus = 0, per_cu = 0;
        if (hipGetDevice(&dev) != hipSuccess || hipDeviceGetAttribute(&cus, hipDeviceAttributeMultiprocessorCount, dev) != hipSuccess) { fprintf(stderr, "kernel_launch: device query failed\n"); grid = -1; return; }
        if (hipFuncSetAttribute((const void*)hybrid_fwd, hipFuncAttributeMaxDynamicSharedMemorySize, LDS_BYTES) != hipSuccess) { fprintf(stderr, "kernel_launch: hipFuncSetAttribute failed\n"); grid = -1; return; }
        if (hipOccupancyMaxActiveBlocksPerMultiprocessor(&per_cu, (const void*)hybrid_fwd, 512, LDS_BYTES) != hipSuccess || per_cu < 1) {
            fprintf(stderr, "kernel_launch: occupancy query reports %d workgroups per CU\n", per_cu); per_cu = 1; }
        (void)hipGetLastError();
        grid = cus;
        if (grid > 256) grid = 256;
    }
    if (grid < 0) return;
    if (hipMemsetAsync((char*)d_ws + WS_CTL, 0, CTL_ZERO_BYTES, stream) != hipSuccess) { fprintf(stderr, "kernel_launch: memset failed\n"); return; }
    Args a{};
    for (int i = 0; i < 25; ++i) a.in[i] = (const float*)d_in[i];
    a.out = (float*)d_out; a.ws = (unsigned char*)d_ws;
    if (MK_N_LAUNCHES == 1) { a.ph_lo = 0; a.ph_hi = 9; hipLaunchKernelGGL(hybrid_fwd, dim3(grid), dim3(512), LDS_BYTES, stream, a); }
    else { for (int p = 0; p < 9; ++p) { a.ph_lo = p; a.ph_hi = p + 1; hipLaunchKernelGGL(hybrid_fwd, dim3(grid), dim3(512), LDS_BYTES, stream, a); } }
    const hipError_t le = hipPeekAtLastError();
    if (le != hipSuccess) fprintf(stderr, "kernel_launch: launch failed: %s\n", hipGetErrorName(le));
}
```

```cpp
#include <hip/hip_runtime.h>
#include <cstdio>
#include <cstdint>

#ifndef PROBE_A
#define PROBE_A -1
#define PROBE_B -1
#endif
#ifndef ZSKIP
#define ZSKIP 30.0f
#endif
#ifndef FOX_SKIP
#define FOX_SKIP 1
#endif
#ifndef DRY_MODE
#define DRY_MODE 1
#endif
#ifndef STAGGER_TICKS
#define STAGGER_TICKS 0
#endif
#ifndef DUP_MASK
#define DUP_MASK 0
#endif
#ifndef P2_PARTS
#define P2_PARTS 15
#endif
#ifndef MK_N_LAUNCHES
#define MK_N_LAUNCHES 1
#endif

#define LAS __attribute__((address_space(3)))
#define GAS __attribute__((address_space(1)))
typedef unsigned short bf16_t;
typedef short bf16x8 __attribute__((ext_vector_type(8)));
typedef short s16x4 __attribute__((ext_vector_type(4)));
typedef float f32x4 __attribute__((ext_vector_type(4)));
typedef float f32x2 __attribute__((ext_vector_type(2)));
typedef float f32x16 __attribute__((ext_vector_type(16)));
typedef unsigned u32x4 __attribute__((ext_vector_type(4)));
typedef unsigned u32x2 __attribute__((ext_vector_type(2)));
typedef __bf16 bf16x2_t __attribute__((ext_vector_type(2)));

constexpr int BATCH = 8, SEQ = 2048, DM = 1024, M = BATCH * SEQ;
constexpr int MEML = 256, MM = BATCH * MEML;
constexpr float EPS = 1e-6f;
constexpr float LOG2E = 1.4426950408889634f;
constexpr float C2_64 = 0.125f * LOG2E;
constexpr float C2_128 = 0.08838834764831845f * LOG2E;
constexpr float LAM_INIT = 0.2f;

constexpr size_t MiB = 1u << 20;
constexpr size_t WS_CTL = 0, CTL_ZERO_BYTES = 1 * MiB;
constexpr size_t WS_SSQ1 = 512 * 1024;
constexpr size_t WS_RSTD0 = 1 * MiB;
constexpr size_t WS_WF = 1 * MiB + 256 * 1024;
constexpr size_t WS_LF = 2 * MiB;
constexpr size_t WS_WA_E = 3 * MiB, WS_WG_E = 13 * MiB, WS_WO_E = 17 * MiB, WS_WM_E = 21 * MiB;
constexpr size_t WS_WA_O = 3 * MiB, WS_WG_O = 13 * MiB, WS_WO_O = 17 * MiB, WS_WM_O = 41 * MiB;
constexpr size_t WS_MEMN = 43 * MiB;
constexpr size_t WS_MK_E = 47 * MiB, WS_MV_E = 49 * MiB, WS_MK_O = 51 * MiB, WS_MV_O = 53 * MiB;
constexpr size_t WS_Y = 56 * MiB, WS_R1 = 120 * MiB, WS_R2 = 168 * MiB, WS_R3 = 216 * MiB, WS_END = 248 * MiB;
constexpr size_t WS_BB = WS_R1 + 32 * MiB;
#ifndef USE_MEMSET
#define USE_MEMSET 0
#endif
constexpr int CW_FLAG = 64;
constexpr unsigned long long INIT_MAGIC = 0x5EED0FBA221E2C0Dull;
constexpr int CW_ZERO_LO = 4096, CW_ZERO_HI = 9216;
constexpr int CW_BAR = 4096, CW_Q2 = 8192, CW_Q6 = 8448, CW_MKV = 8704;

constexpr int RING_BYTES = 131072;
constexpr int LDSCTL_OFF = RING_BYTES, MISC_OFF = LDSCTL_OFF + 320, XCH_OFF = LDSCTL_OFF + 1024;
constexpr int LDS_BYTES = 147456;

__device__ __forceinline__ unsigned cvtpk(float lo, float hi) { f32x2 v = {lo, hi}; bf16x2_t b = __builtin_convertvector(v, bf16x2_t); return __builtin_bit_cast(unsigned, b); }
__device__ __forceinline__ float bf_lo(unsigned w) { return __builtin_bit_cast(float, w << 16); }
__device__ __forceinline__ float bf_hi(unsigned w) { return __builtin_bit_cast(float, w & 0xffff0000u); }
__device__ __forceinline__ float wave_sum(float v) {
#pragma unroll
    for (int o = 1; o < 64; o <<= 1) v += __shfl_xor(v, o);
    return v;
}
template <int CTRL> __device__ __forceinline__ float dpp_mov(float v) { return __builtin_bit_cast(float, __builtin_amdgcn_update_dpp(0, __builtin_bit_cast(int, v), CTRL, 0xF, 0xF, true)); }
__device__ __forceinline__ float reduce8(const float (&d)[8], int lane) {
    float y[4];
#pragma unroll
    for (int i = 0; i < 4; ++i) { auto rr = __builtin_amdgcn_permlane32_swap(__float_as_uint(d[i]), __float_as_uint(d[i + 4]), false, false); y[i] = __uint_as_float(rr[0]) + __uint_as_float(rr[1]); }
    const bool b4 = (lane & 16) != 0, b3 = (lane & 8) != 0;
    float snd[2], kp[2], z[2];
#pragma unroll
    for (int j = 0; j < 2; ++j) { snd[j] = b4 ? y[j] : y[j + 2]; kp[j] = b4 ? y[j + 2] : y[j]; }
#pragma unroll
    for (int j = 0; j < 2; ++j) snd[j] = __shfl_xor(snd[j], 16);
#pragma unroll
    for (int j = 0; j < 2; ++j) z[j] = kp[j] + snd[j];
    const float s3 = b3 ? z[0] : z[1], k3 = b3 ? z[1] : z[0];
    float w = k3 + dpp_mov<0x128>(s3);
    w += dpp_mov<0xB1>(w); w += dpp_mov<0x4E>(w); w += dpp_mov<0x141>(w);
    return w;
}
#ifndef WT_STORES
#define WT_STORES 0
#endif
__device__ __forceinline__ void st16(void* p, u32x4 v) {
#if WT_STORES
    asm volatile("global_store_dwordx4 %0, %1, off sc1\n\ts_nop 1" :: "v"(p), "v"(v) : "memory");
#else
    *(u32x4*)p = v;
#endif
}
#ifndef EPI_TR
#define EPI_TR 1
#endif
__device__ __forceinline__ int tr_src4(int lane) { return 4 * ((lane >> 2) + 16 * (lane & 3)); }
__device__ __forceinline__ u32x4 lane_tr(u32x4 w, int src4) {
    w.x = (unsigned)__builtin_amdgcn_ds_bpermute(src4, (int)w.x); w.y = (unsigned)__builtin_amdgcn_ds_bpermute(src4, (int)w.y);
    w.z = (unsigned)__builtin_amdgcn_ds_bpermute(src4, (int)w.z); w.w = (unsigned)__builtin_amdgcn_ds_bpermute(src4, (int)w.w); return w; }
__device__ __forceinline__ u32x2 lane_tr(u32x2 w, int src4) {
    w.x = (unsigned)__builtin_amdgcn_ds_bpermute(src4, (int)w.x); w.y = (unsigned)__builtin_amdgcn_ds_bpermute(src4, (int)w.y); return w; }
#define LDS_WAIT() asm volatile("s_waitcnt lgkmcnt(0)" ::: "memory")
#define VM_WAIT() asm volatile("s_waitcnt vmcnt(0)" ::: "memory")

namespace pg8 {
constexpr int BM = 256, BK = 64, HALF = 128, HTB = HALF * BK * 2, STAGE_BYTES = 8 * HTB, NXCD = 8, WGM = 4;
__host__ __device__ __forceinline__ int lds_byte(int r, int c) { const int st = (r >> 4) * 2 + (c >> 5), rr = r & 15, cc = c & 31, ob = rr * 64 + cc * 2; return st * 1024 + (ob ^ (((ob >> 9) & 1) << 5)); }
__host__ __device__ __forceinline__ void stage_rc(int b, int& R, int& C) { const int st = b / 1024, sb = b % 1024, swz = sb ^ (((sb >> 9) & 1) << 5); R = (st >> 1) * 16 + swz / 64; C = (st & 1) * 32 + (swz % 64) / 2; }
__host__ __device__ __forceinline__ int perm32(int rho) { const int n = rho >> 4, i = rho & 15; return 8 * (i >> 2) + 4 * n + (i & 3); }
struct Unit { int pm, pn; };
struct Gemm { const bf16_t* A; const bf16_t* Bt; int M, N, K; };
struct StaticOrder {
    int nM, nN, nwg, G, c, wgm;
    __host__ __device__ void init(int M_, int N_, int G_, int c_, int wgm_ = WGM) { nM = M_ / BM; nN = N_ / BM; nwg = nM * nN; G = G_; c = c_; wgm = wgm_; }
    __host__ __device__ bool next(int i, Unit& u) const {
        const long L = (long)i * G + c; if (L >= nwg) return false;
        int wgid = (int)L; { const int q = nwg / NXCD, r = nwg % NXCD, xcd = wgid % NXCD, off = wgid / NXCD; wgid = (xcd < r ? xcd * (q + 1) : r * (q + 1) + (xcd - r) * q) + off; }
        const int nig = wgm * nN, gid = wgid / nig, fm = gid * wgm, gsz = (nM - fm) < wgm ? (nM - fm) : wgm;
        u.pm = fm + ((wgid % nig) % gsz); u.pn = (wgid % nig) / gsz; if (gid & 1) u.pn = nN - 1 - u.pn;
        return true;
    }
};
struct OneUnit { int pm, pn; __host__ __device__ bool next(int i, Unit& u) const { if (i != 0) return false; u.pm = pm; u.pn = pn; return true; } };
template <class Epi, class Sched, bool ALIGN_EPI>
__device__ __forceinline__ void gemm_phase(LAS unsigned char* lds, const Gemm g, const Sched& S, const Epi& E) {
    const int tid = threadIdx.x, wid = __builtin_amdgcn_readfirstlane(tid >> 6), lane = tid & 63, wr = wid >> 2, wc = wid & 3, fr = lane & 15, fq = lane >> 4;
    const int K = g.K, nt = K / BK;
    unsigned voffA[2], voffB[2];
#pragma unroll
    for (int i = 0; i < 2; ++i) { int R, C; stage_rc(tid * 16 + i * 8192, R, C); const int Rb = (R & ~31) + perm32(R & 31);
        voffA[i] = (unsigned)(R * K + C) * 2u; voffB[i] = (unsigned)(Rb * K + C) * 2u; }
    const size_t kstep = (size_t)(BK * 2);
    const size_t hstep = (size_t)HALF * K * 2;
    const size_t tstep = 2 * hstep;
    const unsigned ldsw = (unsigned)wid * 1024u;
    const int aoff = lds_byte(wr * 64 + fr, fq * 8), boff = lds_byte(wc * 32 + fr, fq * 8);
#define PG8_SA(b, h) (((b) * 2 + (h)) * HTB)
#define PG8_SB(b, h) ((4 + (b) * 2 + (h)) * HTB)
#define PG8_STAGE(bufoff, gbase, voff) do { _Pragma("unroll") for (int _i = 0; _i < 2; ++_i) \
        __builtin_amdgcn_global_load_lds((const unsigned*)((const char*)(gbase) + (voff)[_i]), (LAS unsigned*)(lds + (bufoff) + ldsw + _i * 8192), 16, 0, 0); } while (0)
#define PG8_LDA(dst, b, h) do { _Pragma("unroll") for (int m = 0; m < 4; ++m) _Pragma("unroll") for (int k = 0; k < 2; ++k) dst[m][k] = *(const LAS bf16x8*)(lds + PG8_SA(b, h) + aoff + m * 2048 + k * 1024); } while (0)
#define PG8_LDB(dst, b, h) do { _Pragma("unroll") for (int n = 0; n < 2; ++n) _Pragma("unroll") for (int k = 0; k < 2; ++k) dst[n][k] = *(const LAS bf16x8*)(lds + PG8_SB(b, h) + boff + n * 2048 + k * 1024); } while (0)
#define PG8_MMA(ai, bj, At, Bt) do { __builtin_amdgcn_s_setprio(1); _Pragma("unroll") for (int m = 0; m < 4; ++m) _Pragma("unroll") for (int n = 0; n < 2; ++n) _Pragma("unroll") for (int k = 0; k < 2; ++k) \
        acc[ai][bj][m][n] = __builtin_amdgcn_mfma_f32_16x16x32_bf16(Bt[n][k], At[m][k], acc[ai][bj][m][n], 0, 0, 0); __builtin_amdgcn_s_setprio(0); } while (0)
#define PG8_WAIT_V(n) asm volatile("s_waitcnt vmcnt(" #n ")" ::: "memory")
#define PG8_WAIT_L(n) asm volatile("s_waitcnt lgkmcnt(" #n ")" ::: "memory")
#define PG8_BAR __builtin_amdgcn_s_barrier()
#define PG8_SCHED __builtin_amdgcn_sched_barrier(0)
    Unit cur, nxt; int ui = 0;
    if (!S.next(0, cur)) return;
    f32x4 acc[2][2][4][2];
    bf16x8 At[4][2], B0[2][2], B1[2][2];
    const char* cA = (const char*)g.A + (size_t)cur.pm * tstep; const char* cB = (const char*)g.Bt + (size_t)cur.pn * tstep;
    typename Epi::Init ini;
    E.init_load(ini, cur, wr, wc, fr, fq);
    PG8_STAGE(PG8_SB(0, 0), cB, voffB); PG8_STAGE(PG8_SB(0, 1), cB + hstep, voffB); PG8_STAGE(PG8_SA(0, 0), cA, voffA); PG8_STAGE(PG8_SA(0, 1), cA + hstep, voffA);
    E.init_acc(acc, ini);
    if (wr == 1) PG8_BAR;
    PG8_WAIT_V(2); PG8_BAR;
    PG8_STAGE(PG8_SB(1, 0), cB + kstep, voffB); PG8_STAGE(PG8_SA(1, 0), cA + kstep, voffA); PG8_STAGE(PG8_SB(1, 1), cB + hstep + kstep, voffB);
    PG8_WAIT_V(6); PG8_BAR;
    for (;;) {
        const bool has_next = S.next(ui + 1, nxt);
        const char* nA = has_next ? (const char*)g.A + (size_t)nxt.pm * tstep : cA; const char* nB = has_next ? (const char*)g.Bt + (size_t)nxt.pn * tstep : cB;
        for (int t = 0; t < nt; t += 2) {
            const bool last = (t == nt - 2);
            const char* a1 = cA + (size_t)(t + 1) * kstep;
            const char* a2 = last ? nA : cA + (size_t)(t + 2) * kstep; const char* b2 = last ? nB : cB + (size_t)(t + 2) * kstep;
            const char* a3 = a2 + kstep; const char* b3 = b2 + kstep;
            PG8_LDB(B0, 0, 0); PG8_LDB(B1, 0, 1); PG8_SCHED; PG8_LDA(At, 0, 0); PG8_STAGE(PG8_SA(1, 1), a1 + hstep, voffA);
            PG8_WAIT_V(8); PG8_WAIT_L(0); PG8_BAR; PG8_MMA(0, 0, At, B0); PG8_MMA(0, 1, At, B1); PG8_BAR; PG8_SCHED;
            PG8_LDA(At, 0, 1); PG8_STAGE(PG8_SB(0, 0), b2, voffB); PG8_STAGE(PG8_SB(0, 1), b2 + hstep, voffB); PG8_STAGE(PG8_SA(0, 0), a2, voffA);
            PG8_WAIT_V(8); PG8_WAIT_L(0); PG8_BAR; PG8_MMA(1, 0, At, B0); PG8_MMA(1, 1, At, B1); PG8_BAR; PG8_SCHED;
            PG8_LDB(B0, 1, 0); PG8_LDB(B1, 1, 1); PG8_SCHED; PG8_LDA(At, 1, 0); PG8_STAGE(PG8_SA(0, 1), a2 + hstep, voffA);
            PG8_WAIT_V(8); PG8_WAIT_L(0); PG8_BAR; PG8_MMA(0, 0, At, B0); PG8_MMA(0, 1, At, B1); PG8_BAR; PG8_SCHED;
            PG8_LDA(At, 1, 1); PG8_STAGE(PG8_SB(1, 0), b3, voffB); PG8_STAGE(PG8_SB(1, 1), b3 + hstep, voffB); PG8_STAGE(PG8_SA(1, 0), a3, voffA);
            PG8_WAIT_V(8); PG8_WAIT_L(0); PG8_BAR; PG8_MMA(1, 0, At, B0); PG8_MMA(1, 1, At, B1); PG8_BAR; PG8_SCHED;
        }
        if constexpr (ALIGN_EPI) { if (wr == 0) PG8_BAR; }
        E(acc, cur, wr, wc, fr, fq, ini, has_next ? 0 : 1);
        if (!has_next) break;
#pragma unroll
        for (int a = 0; a < 2; ++a)
#pragma unroll
            for (int b = 0; b < 2; ++b)
#pragma unroll
                for (int m = 0; m < 4; ++m)
#pragma unroll
                    for (int n = 0; n < 2; ++n) acc[a][b][m][n] = (f32x4){0.f, 0.f, 0.f, 0.f};
        cur = nxt; cA = nA; cB = nB; ++ui;
        if constexpr (Epi::RESID) { E.init_load(ini, cur, wr, wc, fr, fq); E.init_acc(acc, ini); }
        if constexpr (ALIGN_EPI) { if (wr == 1) PG8_BAR; }
    }
    PG8_WAIT_V(0);
    if constexpr (!ALIGN_EPI) { if (wr == 0) PG8_BAR; }
    PG8_BAR;
#undef PG8_SA
#undef PG8_SB
#undef PG8_STAGE
#undef PG8_LDA
#undef PG8_LDB
#undef PG8_MMA
#undef PG8_WAIT_V
#undef PG8_WAIT_L
#undef PG8_BAR
#undef PG8_SCHED
}

struct TileDesc { int mode; bf16_t* dst; int ld; const float* g; float ps; };
struct EpiProj {
    int kind;
    const float* rstd;
    const float* ssq;
    bf16_t *Y, *R1, *R2, *R3, *BB, *MK, *MV;
    const float *g_q, *g_k, *g_xq, *g_xk;
    LAS float* xch; bf16_t* GA; bf16_t* GX;
    struct Init { float rv[2][4]; };
    static constexpr bool RESID = true;
    __device__ __forceinline__ void init_load(Init& I, const Unit& u, int wr, int wc, int fr, int fq) const {
        const float* src = kind == 0 ? rstd : ssq;
#pragma unroll
        for (int ai = 0; ai < 2; ++ai)
#pragma unroll
            for (int m = 0; m < 4; ++m) I.rv[ai][m] = kind <= 1 ? src[u.pm * BM + ai * HALF + wr * 64 + m * 16 + fr] : 1.f;
    }
    __device__ __forceinline__ void init_acc(f32x4 (&acc)[2][2][4][2], const Init&) const {
#pragma unroll
        for (int a = 0; a < 2; ++a)
#pragma unroll
            for (int b = 0; b < 2; ++b)
#pragma unroll
                for (int m = 0; m < 4; ++m)
#pragma unroll
                    for (int n = 0; n < 2; ++n) acc[a][b][m][n] = (f32x4){0.f, 0.f, 0.f, 0.f};
    }
    __device__ __forceinline__ TileDesc desc(int pn) const {
        TileDesc d; d.mode = 0; d.dst = nullptr; d.ld = 0; d.g = nullptr; d.ps = 1.f;
        if (kind == 0) {
            if (pn < 4) { d.mode = 1; d.dst = Y + 256 * pn; d.ld = 2048; d.g = g_q; d.ps = C2_64; }
            else if (pn < 8) { d.mode = 1; d.dst = R1 + 256 * (pn - 4); d.ld = 1024; d.g = g_k; }
            else if (pn < 12) { d.dst = R2 + 256 * (pn - 8); d.ld = 1024; }
            else if (pn < 16) { d.mode = 4; d.dst = R3 + 128 * (pn - 12); d.ld = 512; }
            else if (pn < 18) { d.mode = 5; d.dst = BB + 128 * (pn - 16); d.ld = 512; }
            else if (pn < 20) { d.mode = 2; d.dst = Y + 1536 + 256 * (pn - 18); d.ld = 2048; d.g = g_xq; d.ps = C2_128; }
            else if (pn < 24) { d.mode = 3; d.dst = GA + 256 * (pn - 20); d.ld = 1024; }
            else if (pn < 26) { d.mode = 5; d.dst = BB + 256 + 128 * (pn - 24); d.ld = 512; }
            else { d.mode = 3; d.dst = GX + 256 * (pn - 26); d.ld = 512; }
        } else if (kind == 1) {
            if (pn < 6) { d.mode = 2; d.dst = Y + 256 * pn; d.ld = 2048; d.g = g_q; d.ps = C2_128; }
            else if (pn < 12) { d.mode = 2; d.dst = R1 + 256 * (pn - 6); d.ld = 1536; d.g = g_k; }
            else if (pn < 18) { d.dst = R2 + 256 * (pn - 12); d.ld = 1536; }
            else if (pn < 20) { d.mode = 2; d.dst = Y + 1536 + 256 * (pn - 18); d.ld = 2048; d.g = g_xq; d.ps = C2_128; }
            else { d.mode = 3; d.dst = GA + 256 * (pn - 20); d.ld = 2048; }
        } else {
            if (pn < 2) { d.mode = 2; d.dst = MK + 256 * pn; d.ld = 512; d.g = g_xk; }
            else { d.dst = MV + 256 * (pn - 2); d.ld = 512; }
        }
        return d;
    }
    __device__ __forceinline__ float rowscale(float raw) const {
        if (kind == 0) return raw;
        if (kind == 1) return __builtin_amdgcn_rsqf(raw * (1.0f / DM) + EPS);
        return 1.f;
    }
    __device__ __forceinline__ void operator()(const f32x4 (&acc)[2][2][4][2], const Unit& u, int wr, int wc, int fr, int fq, const Init& I, int lastu) const {
        const TileDesc d = desc(u.pn);
        const int cl = 64 * wc + 8 * fq;
        f32x4 gv[2][2];
#pragma unroll
        for (int bj = 0; bj < 2; ++bj)
#pragma unroll
            for (int n = 0; n < 2; ++n) gv[bj][n] = (f32x4){d.ps, d.ps, d.ps, d.ps};
        if (d.mode == 1 || d.mode == 2) {
            const int gi = (d.mode == 2 ? 64 * (wc & 1) : 0) + 8 * fq;
#pragma unroll
            for (int bj = 0; bj < 2; ++bj)
#pragma unroll
                for (int n = 0; n < 2; ++n) gv[bj][n] = *(const f32x4*)(d.g + gi + 32 * bj + 4 * n) * d.ps;
        }
        float rf[2][4];
#pragma unroll
        for (int ai = 0; ai < 2; ++ai)
#pragma unroll
            for (int m = 0; m < 4; ++m) rf[ai][m] = rowscale(I.rv[ai][m]);
        if (d.mode == 1 || d.mode == 2) {
            float ss[2][4];
#pragma unroll
            for (int ai = 0; ai < 2; ++ai)
#pragma unroll
                for (int m = 0; m < 4; ++m) { float s0 = 0.f;
#pragma unroll
                    for (int bj = 0; bj < 2; ++bj)
#pragma unroll
                        for (int n = 0; n < 2; ++n) { const f32x4 v = acc[ai][bj][m][n]; s0 += (v[0] * v[0] + v[1] * v[1]) + (v[2] * v[2] + v[3] * v[3]); }
                    ss[ai][m] = s0 * rf[ai][m] * rf[ai][m]; }
#pragma unroll
            for (int ai = 0; ai < 2; ++ai)
#pragma unroll
                for (int m = 0; m < 4; ++m) ss[ai][m] += __shfl_xor(ss[ai][m], 16);
#pragma unroll
            for (int ai = 0; ai < 2; ++ai)
#pragma unroll
                for (int m = 0; m < 4; ++m) { auto rr = __builtin_amdgcn_permlane32_swap(__float_as_uint(ss[ai][m]), __float_as_uint(ss[ai][m]), false, false); ss[ai][m] = __uint_as_float(rr[0]) + __uint_as_float(rr[1]); }
            if (d.mode == 2) {
#pragma unroll
                for (int ai = 0; ai < 2; ++ai)
#pragma unroll
                    for (int m = 0; m < 4; ++m) if (fq == 0) xch[(ai * HALF + wr * 64 + m * 16 + fr) * 4 + wc] = ss[ai][m];
                asm volatile("s_waitcnt lgkmcnt(0)" ::: "memory"); __builtin_amdgcn_s_barrier(); asm volatile("" ::: "memory");
#pragma unroll
                for (int ai = 0; ai < 2; ++ai)
#pragma unroll
                    for (int m = 0; m < 4; ++m) ss[ai][m] += xch[(ai * HALF + wr * 64 + m * 16 + fr) * 4 + (wc ^ 1)];
            }
            const float inv = d.mode == 2 ? (1.0f / 128.0f) : (1.0f / 64.0f);
#pragma unroll
            for (int ai = 0; ai < 2; ++ai)
#pragma unroll
                for (int m = 0; m < 4; ++m) rf[ai][m] *= __builtin_amdgcn_rsqf(ss[ai][m] * inv + EPS);
        }
        asm volatile("" :: "v"(rf[0][0]), "v"(rf[0][1]), "v"(rf[0][2]), "v"(rf[0][3]), "v"(rf[1][0]), "v"(rf[1][1]), "v"(rf[1][2]), "v"(rf[1][3]), "v"(gv[0][0]), "v"(gv[0][1]), "v"(gv[1][0]), "v"(gv[1][1]));
        const bool wt = lastu && kind <= 1;
        switch (d.mode) {
            case 0: store_tile<0>(acc, d, rf, gv, u, wr, wc, fr, fq, wt); break;
            case 1: case 2: store_tile<1>(acc, d, rf, gv, u, wr, wc, fr, fq, wt); break;
            case 3: store_tile<3>(acc, d, rf, gv, u, wr, wc, fr, fq, wt); break;
            case 4: store_tile<4>(acc, d, rf, gv, u, wr, wc, fr, fq, wt); break;
            default: store_tile<5>(acc, d, rf, gv, u, wr, wc, fr, fq, wt); break;
        }
    }
    template <int MODE>
    __device__ __forceinline__ void store_tile(const f32x4 (&acc)[2][2][4][2], const TileDesc& d, const float (&rf)[2][4], const f32x4 (&gv)[2][2], const Unit& u, int wr, int wc, int fr, int fq, bool wt) const {
        const int lane_ = fr + 16 * fq, src4 = tr_src4(lane_);
        const int clS = 64 * wc + 8 * (lane_ & 3);
        bf16_t* base = d.dst + (size_t)(u.pm * BM + wr * 64 + (lane_ >> 2)) * d.ld + (MODE >= 4 ? (clS >> 1) : clS);
        const size_t ld16 = (size_t)16 * d.ld;
#pragma unroll
        for (int ai = 0; ai < 2; ++ai) {
        u32x4 wq[1][4][2];
#pragma unroll
            for (int m = 0; m < 4; ++m) {
                const float rs = rf[ai][m];
#pragma unroll
                for (int bj = 0; bj < 2; ++bj) {
                    if (MODE >= 4) {
                        f32x4 v0 = acc[ai][bj][m][0] * rs, v1 = acc[ai][bj][m][1] * rs;
                        if (MODE == 5) {
#pragma unroll
                            for (int i = 0; i < 4; ++i) v1[i] *= __builtin_amdgcn_rcpf(1.0f + __builtin_amdgcn_exp2f(-v1[i] * LOG2E)); }
                        v0 *= v1;
                        u32x2 w; w.x = cvtpk(v0[0], v0[1]); w.y = cvtpk(v0[2], v0[3]);
                        w = lane_tr(w, src4);
                        wq[0][m][bj].x = w.x; wq[0][m][bj].y = w.y;
                    } else {
                        f32x4 v0, v1;
                        if (MODE == 1) { v0 = acc[ai][bj][m][0] * (gv[bj][0] * rs); v1 = acc[ai][bj][m][1] * (gv[bj][1] * rs); }
                        else { v0 = acc[ai][bj][m][0] * rs; v1 = acc[ai][bj][m][1] * rs; }
                        if (MODE == 3) {
#pragma unroll
                            for (int i = 0; i < 4; ++i) { v0[i] *= __builtin_amdgcn_rcpf(1.0f + __builtin_amdgcn_exp2f(-v0[i] * LOG2E)); v1[i] *= __builtin_amdgcn_rcpf(1.0f + __builtin_amdgcn_exp2f(-v1[i] * LOG2E)); } }
                        u32x4 w; w.x = cvtpk(v0[0], v0[1]); w.y = cvtpk(v0[2], v0[3]); w.z = cvtpk(v1[0], v1[1]); w.w = cvtpk(v1[2], v1[3]);
                        wq[0][m][bj] = lane_tr(w, src4);
                    }
                }
            }
#pragma unroll
            for (int m = 0; m < 4; ++m) {
                bf16_t* rowp = base + (size_t)(ai * 8 + m) * ld16;
#pragma unroll
                for (int bj = 0; bj < 2; ++bj) {
                    if (MODE >= 4) { u32x2 w; w.x = wq[0][m][bj].x; w.y = wq[0][m][bj].y; *(u32x2*)(rowp + 16 * bj) = w; }
                    else if (wt) asm volatile("global_store_dwordx4 %0, %1, off sc1\n\ts_nop 1" :: "v"(rowp + 32 * bj), "v"(wq[0][m][bj]) : "memory");
                    else st16(rowp + 32 * bj, wq[0][m][bj]);
                }
            }
        }
    }
};
template <bool FIRST> struct EpiOut {
    const bf16_t* base; float* hout; bf16_t* hb; float* ssq; int dry;
    struct Init { u32x4 b[2][4][2]; };
    static constexpr bool RESID = true;
    __device__ __forceinline__ void init_load(Init& I, const Unit& u, int wr, int wc, int fr, int fq) const {
        const int cl = u.pn * BM + 64 * wc + 8 * fq;
#pragma unroll
        for (int ai = 0; ai < 2; ++ai)
#pragma unroll
            for (int m = 0; m < 4; ++m)
#pragma unroll
                for (int bj = 0; bj < 2; ++bj) I.b[ai][m][bj] = __builtin_nontemporal_load((const u32x4*)(base + (size_t)(u.pm * BM + ai * HALF + wr * 64 + m * 16 + fr) * DM + cl + 32 * bj));
    }
    __device__ __forceinline__ void init_acc(f32x4 (&acc)[2][2][4][2], const Init& I) const {
#pragma unroll
        for (int ai = 0; ai < 2; ++ai)
#pragma unroll
            for (int m = 0; m < 4; ++m)
#pragma unroll
                for (int bj = 0; bj < 2; ++bj) { const u32x4 bv = I.b[ai][m][bj];
                    acc[ai][bj][m][0] = (f32x4){bf_lo(bv.x), bf_hi(bv.x), bf_lo(bv.y), bf_hi(bv.y)}; acc[ai][bj][m][1] = (f32x4){bf_lo(bv.z), bf_hi(bv.z), bf_lo(bv.w), bf_hi(bv.w)}; }
    }
    __device__ __forceinline__ void operator()(const f32x4 (&acc)[2][2][4][2], const Unit& u, int wr, int wc, int fr, int fq, const Init&, int) const {
        const int cl = u.pn * BM + 64 * wc + 8 * fq;
        float sr[2][4];
#pragma unroll
        for (int ai = 0; ai < 2; ++ai) {
#pragma unroll
            for (int m = 0; m < 4; ++m) {
                const int row = u.pm * BM + ai * HALF + wr * 64 + m * 16 + fr; const size_t off = (size_t)row * DM + cl; float s = 0.f;
#pragma unroll
                for (int bj = 0; bj < 2; ++bj) {
                    const f32x4 h0 = acc[ai][bj][m][0], h1 = acc[ai][bj][m][1];
                    if (FIRST) {
                        u32x4 w; w.x = cvtpk(h0[0], h0[1]); w.y = cvtpk(h0[2], h0[3]); w.z = cvtpk(h1[0], h1[1]); w.w = cvtpk(h1[2], h1[3]);
                        st16(hb + off + 32 * bj, w);
                        s += (h0[0] * h0[0] + h0[1] * h0[1]) + (h0[2] * h0[2] + h0[3] * h0[3]) + (h1[0] * h1[0] + h1[1] * h1[1]) + (h1[2] * h1[2] + h1[3] * h1[3]);
                    } else { *(f32x4*)(hout + off + 32 * bj) = h0; *(f32x4*)(hout + off + 32 * bj + 4) = h1; }
                }
                sr[ai][m] = s;
            }
        }
        if (FIRST) {
#pragma unroll
            for (int ai = 0; ai < 2; ++ai)
#pragma unroll
                for (int m = 0; m < 4; ++m) sr[ai][m] += __shfl_xor(sr[ai][m], 16);
#pragma unroll
            for (int ai = 0; ai < 2; ++ai)
#pragma unroll
                for (int m = 0; m < 4; ++m) { auto rr = __builtin_amdgcn_permlane32_swap(__float_as_uint(sr[ai][m]), __float_as_uint(sr[ai][m]), false, false);
                    const float t = __uint_as_float(rr[0]) + __uint_as_float(rr[1]);
                    if (fq == 0) atomicAdd(ssq + u.pm * BM + ai * HALF + wr * 64 + m * 16 + fr, t); }
        }
    }
};
}

namespace att {
constexpr int NW = 8, QBLK = 32, KVBLK = 64;
constexpr int SHM_V = 16384, SHM_K = 16384, NSTG = 3, K_OFF = 0, V_OFF = NSTG * SHM_K;
constexpr int XSTG_END = 69632, WS_OFF = 98304, BIAS_OFF = 100352, SCAN_OFF = 108544;
constexpr float THR = 8.f;
#define KSWZ(row, colB) ((row) * 256 + ((colB) ^ (((row) & 7) << 4)))
#define SBAR() __builtin_amdgcn_sched_barrier(0)
__device__ __forceinline__ int v_st(int k, int c) { const int kk = (k & ~0xC) | ((k & 4) << 1) | ((k & 8) >> 1); return ((kk >> 3) * 4 + (c >> 5)) * 512 + ((kk & 7) * 32 + (c & 31)) * 2; }
__device__ __forceinline__ int v_rd_base(int lane) { return ((lane & 3) << 3) | (((lane >> 2) & 3) << 6) | (((lane >> 4) & 1) << 5) | (((lane >> 5) & 1) << 8); }
constexpr int v_rd_off(int d0, int ks, int half) { return d0 * 512 + ks * 4096 + half * 2048; }
__device__ __forceinline__ int crow(int r, int hi) { return (r & 3) + 8 * (r >> 2) + 4 * hi; }
__device__ __forceinline__ void mask_causal(f32x16& p0, f32x16& p1, int dq) {
    const float NEG = -__builtin_inff();
#pragma unroll
    for (int r = 0; r < 16; ++r) { const int c = (r & 3) + 8 * (r >> 2); if (dq - c < 0) p0[r] = NEG; if (dq - c - 32 < 0) p1[r] = NEG; }
}
__device__ __forceinline__ f32x16 ninf16() { const float n = -__builtin_inff(); return (f32x16){n, n, n, n, n, n, n, n, n, n, n, n, n, n, n, n}; }
template <bool ADD> __device__ __forceinline__ void partialSM(f32x16& p0, f32x16& p1, float rowc) {
    if (ADD) {
#pragma unroll
        for (int r = 0; r < 16; ++r) p0[r] += rowc;
#pragma unroll
        for (int r = 0; r < 16; ++r) p1[r] += rowc;
    }
#pragma unroll
    for (int r = 0; r < 16; ++r) p0[r] = __builtin_amdgcn_exp2f(p0[r]);
}
__device__ __forceinline__ void finishSM(f32x16& p0, f32x16& p1, float& l_reg, bf16x8& pa0, bf16x8& pa1, bf16x8& pa2, bf16x8& pa3) {
#pragma unroll
    for (int r = 0; r < 16; ++r) p1[r] = __builtin_amdgcn_exp2f(p1[r]);
    float ps = 0;
#pragma unroll
    for (int r = 0; r < 16; ++r) ps += p0[r];
#pragma unroll
    for (int r = 0; r < 16; ++r) ps += p1[r];
    { auto rr = __builtin_amdgcn_permlane32_swap(__float_as_uint(ps), __float_as_uint(ps), false, false);
      ps = __uint_as_float(rr[0]) + __uint_as_float(rr[1]); }
    l_reg += ps;
#define PK4(P, B_, OUT) do { unsigned a0 = cvtpk(P[B_+0], P[B_+1]), a1 = cvtpk(P[B_+2], P[B_+3]);                          \
        unsigned b0 = cvtpk(P[B_+4], P[B_+5]), b1 = cvtpk(P[B_+6], P[B_+7]);                                             \
        auto r0 = __builtin_amdgcn_permlane32_swap(a0, b0, false, false); auto r1 = __builtin_amdgcn_permlane32_swap(a1, b1, false, false); \
        u32x4 w = {r0[0], r1[0], r0[1], r1[1]}; OUT = __builtin_bit_cast(bf16x8, w); } while (0)
    PK4(p0, 0, pa0); PK4(p0, 8, pa1); PK4(p1, 0, pa2); PK4(p1, 8, pa3);
#undef PK4
}
template <int ND, int BIAS>
__device__ __forceinline__ void qkt(f32x16& p0, f32x16& p1, LAS const char* K_lds  , int ksub, int r32, int hi, const bf16x8* qr, LAS const float* bl) {
    if (BIAS) {
#pragma unroll
        for (int g = 0; g < 4; ++g) { const f32x4 a = *(LAS const f32x4*)(bl + 8 * g), b = *(LAS const f32x4*)(bl + 32 + 8 * g);
            p0[4 * g] = a[0]; p0[4 * g + 1] = a[1]; p0[4 * g + 2] = a[2]; p0[4 * g + 3] = a[3]; p1[4 * g] = b[0]; p1[4 * g + 1] = b[1]; p1[4 * g + 2] = b[2]; p1[4 * g + 3] = b[3]; }
    } else { p0 = f32x16{}; p1 = f32x16{}; }
    LAS const char* kb[4];
    int r32v = r32; asm volatile("" : "+v"(r32v));
#pragma unroll
    for (int dd = 0; dd < 4; ++dd) kb[dd] = K_lds + KSWZ(r32v, (dd * 16 + hi * 8) * 2) + ksub;
#pragma unroll
    for (int d0 = 0; d0 < ND; ++d0) { LAS const char* a = kb[d0 & 3] + (d0 >> 2) * 128;
        const bf16x8 b0 = *(LAS const bf16x8*)(a);
        const bf16x8 b1 = *(LAS const bf16x8*)(a + 32 * 256);
        p0 = __builtin_amdgcn_mfma_f32_32x32x16_bf16(b0, qr[d0], p0, 0, 0, 0);
        p1 = __builtin_amdgcn_mfma_f32_32x32x16_bf16(b1, qr[d0], p1, 0, 0, 0); }
}
__device__ __forceinline__ void pv_tile(f32x16* o, int vb0  , bf16x8 pa0, bf16x8 pa1, bf16x8 pa2, bf16x8 pa3) {
#define TRRD(dst, off) asm volatile("ds_read_b64_tr_b16 %0, %1 offset:%2" : "=&v"(dst) : "v"(vb0), "i"(off) : "memory")
#define PV_D0(d0) do { s16x4 l0, l1, l2, l3, h0, h1, h2, h3; constexpr int b_ = v_rd_off(d0, 0, 0); \
        TRRD(l0, b_); TRRD(h0, b_ + 2048); TRRD(l1, b_ + 4096); TRRD(h1, b_ + 6144); TRRD(l2, b_ + 8192); TRRD(h2, b_ + 10240); TRRD(l3, b_ + 12288); TRRD(h3, b_ + 14336); \
        asm volatile("s_waitcnt lgkmcnt(0)" ::: "memory"); SBAR(); \
        o[d0] = __builtin_amdgcn_mfma_f32_32x32x16_bf16(pa0, (bf16x8){l0[0], l0[1], l0[2], l0[3], h0[0], h0[1], h0[2], h0[3]}, o[d0], 0, 0, 0);   \
        o[d0] = __builtin_amdgcn_mfma_f32_32x32x16_bf16(pa1, (bf16x8){l1[0], l1[1], l1[2], l1[3], h1[0], h1[1], h1[2], h1[3]}, o[d0], 0, 0, 0);   \
        o[d0] = __builtin_amdgcn_mfma_f32_32x32x16_bf16(pa2, (bf16x8){l2[0], l2[1], l2[2], l2[3], h2[0], h2[1], h2[2], h2[3]}, o[d0], 0, 0, 0);   \
        o[d0] = __builtin_amdgcn_mfma_f32_32x32x16_bf16(pa3, (bf16x8){l3[0], l3[1], l3[2], l3[3], h3[0], h3[1], h3[2], h3[3]}, o[d0], 0, 0, 0); } while (0)
    PV_D0(0); PV_D0(1); PV_D0(2); PV_D0(3);
#undef PV_D0
#undef TRRD
}
template <int ND> struct Pre { bf16x8 qr[ND]; };
template <int ND>
__device__ __forceinline__ void attn_preload(Pre<ND>& P, const bf16_t* Qw, int qp) {
    int tid = threadIdx.x; asm volatile("" : "+v"(tid));
    const int lane = tid & 63, r32 = lane & 31, hi = lane >> 5;
#pragma unroll
    for (int d0 = 0; d0 < ND; ++d0) P.qr[d0] = __builtin_nontemporal_load((const bf16x8*)(Qw + (size_t)r32 * qp + d0 * 16 + hi * 8));
}
template <int ND, int BIAS, bool CAUSAL>
__device__ __forceinline__ void attn_core(Pre<ND>& P, const bf16_t* Kp, int kp, const bf16_t* Vp, int vp, int NT, int qlo, int ksub, int tsh, float tslope, float eoff,
                                          LAS char* lds, f32x16 (&o)[4], float& l_out) {
    int tid = threadIdx.x; asm volatile("" : "+v"(tid));
    const int wid = __builtin_amdgcn_readfirstlane(tid >> 6), lane = tid & 63, r32 = lane & 31, hi = lane >> 5;
    LAS char* K_lds = lds + K_OFF; LAS char* V_lds = lds + V_OFF;
    LAS const float* biasL = (LAS const float*)(lds + BIAS_OFF) + tsh + 4 * hi;
    const int vb0 = (int)(unsigned)(uintptr_t)V_lds + v_rd_base(lane);
    const int qm = qlo + r32 - 4 * hi;
    const int tl = __builtin_amdgcn_readfirstlane((qlo + 31) >> 6);
    bf16x8 (&qr)[ND] = P.qr;
    const bf16_t* ksrc[2]; const bf16_t* vsrc[2];
#pragma unroll
    for (int i = 0; i < 2; ++i) { const int p = 2 * wid + i;
        const int row = 4 * p + (lane >> 4); ksrc[i] = Kp + (size_t)row * kp + 8 * ((lane & 15) ^ (row & 7));
        const int sbt = 2 * p + (lane >> 5), kk = (sbt >> 2) * 8 + ((lane & 31) >> 2), c = 32 * (sbt & 3) + 8 * (lane & 3), k = (kk & ~0xC) | ((kk & 4) << 1) | ((kk & 8) >> 1);
        vsrc[i] = Vp + (size_t)k * vp + c; }
    const size_t ktile = (size_t)KVBLK * kp, vtile = (size_t)KVBLK * vp;
#define DMA_K(t_, stg) do { const int tt_ = (t_) < NT ? (t_) : NT - 1; _Pragma("unroll") for (int i_ = 0; i_ < 2; ++i_) \
        __builtin_amdgcn_global_load_lds((const unsigned*)(ksrc[i_] + (size_t)tt_ * ktile), (LAS unsigned*)(K_lds + (stg) + (2 * wid + i_) * 1024), 16, 0, 0); } while (0)
#define DMA_V(t_, stg) do { const int tt_ = (t_) < NT ? (t_) : NT - 1; _Pragma("unroll") for (int i_ = 0; i_ < 2; ++i_) \
        __builtin_amdgcn_global_load_lds((const unsigned*)(vsrc[i_] + (size_t)tt_ * vtile), (LAS unsigned*)(V_lds + (stg) + (2 * wid + i_) * 1024), 16, 0, 0); } while (0)
#define WAIT_BAR(N) asm volatile("s_waitcnt vmcnt(" #N ") lgkmcnt(0)\n\ts_barrier" ::: "memory")
#define MASKT(P0_, P1_, t) do { if (CAUSAL) { const int kb_ = (t) * KVBLK; if (kb_ + KVBLK - 1 > qlo) { asm volatile("" ::: "memory"); mask_causal(P0_, P1_, qm - kb_); } } } while (0)
#define BL(t) (biasL + (BIAS == 2 ? (t) * KVBLK : 0))
#define ROWC(t) (BIAS == 1 ? rowc + tslope * (float)(t) : rowc)
    float l_reg = 0.f, rowc = -eoff;
#pragma unroll
    for (int d_ = 0; d_ < 4; ++d_) o[d_] = f32x16{};
    f32x16 pA0, pA1, pB0, pB1; bf16x8 pa0, pa1, pa2, pa3;
    int s_m1 = 2 * SHM_K, s_0 = 0, s_p1 = SHM_K, s_p2 = 2 * SHM_K;
#define ROT() do { s_m1 = s_0; s_0 = s_p1; s_p1 = s_p2; s_p2 = (s_p2 == 2 * SHM_K) ? 0 : s_p2 + SHM_K; } while (0)
    DMA_K(0, 0); DMA_V(0, 0); DMA_K(1, SHM_K);
    asm volatile("s_waitcnt vmcnt(2)" ::: "memory");
    __builtin_amdgcn_s_barrier(); asm volatile("" ::: "memory");
    if (BIAS == 2) rowc -= ((LAS const float*)(lds + BIAS_OFF))[tsh + qlo + r32];
    if (BIAS == 1) rowc -= (tslope * (1.0f / 64.0f)) * (float)(qlo + r32);
    DMA_K(2, 2 * SHM_K); DMA_V(1, SHM_V);
    SBAR(); qkt<ND, BIAS>(pA0, pA1, K_lds + s_0, ksub, r32, hi, qr, BL(0));
    MASKT(pA0, pA1, 0); partialSM<BIAS != 0>(pA0, pA1, ROWC(0));
    WAIT_BAR(4);
    ROT();
#define STEP(PX0, PX1, PY0, PY1, t) do { \
        DMA_K((t) + 2, s_p2); DMA_V((t) + 1, s_p1); \
        const bool act_ = !CAUSAL || (t) <= tl;       \
        SBAR(); if (act_) qkt<ND, BIAS>(PX0, PX1, K_lds + s_0, ksub, r32, hi, qr, BL(t)); \
        if (!CAUSAL || (t) - 1 <= tl) { finishSM(PY0, PY1, l_reg, pa0, pa1, pa2, pa3); SBAR(); \
            pv_tile(o, vb0 + s_m1, pa0, pa1, pa2, pa3); }       \
        if (act_) { MASKT(PX0, PX1, (t)); partialSM<BIAS != 0>(PX0, PX1, ROWC(t)); } else { PX0 = f32x16{}; PX1 = ninf16(); }   \
        WAIT_BAR(4); \
        ROT(); } while (0)
    int t = 1;
    for (; t + 1 < NT; t += 2) {
        STEP(pB0, pB1, pA0, pA1, t);
        STEP(pA0, pA1, pB0, pB1, t + 1);
    }
    const bool even = (NT & 1) == 0;
    const bool actL = !CAUSAL || NT - 1 <= tl;
    if (even && actL) { SBAR(); qkt<ND, BIAS>(pB0, pB1, K_lds + s_0, ksub, r32, hi, qr, BL(NT - 1)); SBAR(); }
    if (!CAUSAL || (even ? NT - 2 : NT - 1) <= tl) { finishSM(pA0, pA1, l_reg, pa0, pa1, pa2, pa3); SBAR();
        pv_tile(o, vb0 + s_m1, pa0, pa1, pa2, pa3); }
    if (even) { if (actL) { MASKT(pB0, pB1, NT - 1); partialSM<BIAS != 0>(pB0, pB1, ROWC(NT - 1)); } WAIT_BAR(0);
        if (actL) { finishSM(pB0, pB1, l_reg, pa0, pa1, pa2, pa3); SBAR(); pv_tile(o, vb0 + s_0, pa0, pa1, pa2, pa3); } }
    asm volatile("s_waitcnt vmcnt(0)" ::: "memory");
    l_out = l_reg;
#undef DMA_K
#undef DMA_V
#undef WAIT_BAR
#undef MASKT
#undef BL
#undef ROWC
#undef ROT
#undef STEP
}
__device__ __forceinline__ void store_rows_bf16(const f32x16 (&o)[4], float l_reg, bf16_t* Ow, int op, LAS char* lds, const bf16_t* Gw, int gp) {
    int tid = threadIdx.x; asm volatile("" : "+v"(tid));
    const int wid = __builtin_amdgcn_readfirstlane(tid >> 6), lane = tid & 63, r32 = lane & 31, hi = lane >> 5;
    LAS float* li_l = (LAS float*)(lds + WS_OFF) + wid * 64;
    if (hi == 0) li_l[r32] = l_reg;
    asm volatile("s_waitcnt lgkmcnt(0)" ::: "memory");
    float rli[16];
#pragma unroll
    for (int r = 0; r < 16; ++r) rli[r] = __builtin_amdgcn_rcpf(li_l[crow(r, hi)]);
    u32x4 gin[8];
#pragma unroll
    for (int i = 0; i < 8; ++i) { const int id = i * 64 + lane, row = id >> 4, ch = id & 15; gin[i] = __builtin_nontemporal_load((const u32x4*)(Gw + (size_t)row * gp + ch * 8)); }
    __syncthreads();
    LAS bf16_t* stg = (LAS bf16_t*)lds + wid * (32 * 136);
#pragma unroll
    for (int r = 0; r < 16; ++r) { const int orow = crow(r, hi);
#pragma unroll
        for (int d0 = 0; d0 < 4; ++d0) { const unsigned w = cvtpk(o[d0][r] * rli[r], 0.f); stg[orow * 136 + d0 * 32 + r32] = (bf16_t)(w & 0xffffu); } }
    asm volatile("s_waitcnt lgkmcnt(0)" ::: "memory");
#pragma unroll
    for (int i = 0; i < 8; ++i) { const int id = i * 64 + lane, row = id >> 4, ch = id & 15;
        const u32x4 v = *(LAS const u32x4*)(stg + row * 136 + ch * 8); const u32x4 gq = gin[i]; u32x4 w;
        w.x = cvtpk(bf_lo(v.x) * bf_lo(gq.x), bf_hi(v.x) * bf_hi(gq.x)); w.y = cvtpk(bf_lo(v.y) * bf_lo(gq.y), bf_hi(v.y) * bf_hi(gq.y));
        w.z = cvtpk(bf_lo(v.z) * bf_lo(gq.z), bf_hi(v.z) * bf_hi(gq.z)); w.w = cvtpk(bf_lo(v.w) * bf_lo(gq.w), bf_hi(v.w) * bf_hi(gq.w));
        st16(Ow + (size_t)row * op + ch * 8, w); }
    asm volatile("s_waitcnt lgkmcnt(0)" ::: "memory");
    __syncthreads();
}
#undef KSWZ
#undef SBAR
}

typedef GAS unsigned gu32;
#define RLX_AGENT __ATOMIC_RELAXED, __HIP_MEMORY_SCOPE_AGENT
#define XB_TMO      128
#define XB_XCNT(j)  (256  + 64 * (j))
#define XB_XSUB(j)  (1280 + 64 * (j))
#define XB_XGEN(j)  (2304 + 64 * (j))
#define XB_TOP      3328
#define XB_TOPGEN   3392
#define XCD_BAR_WORDS 3456
#define XB_SPIN_CAP (1u << 18)
__device__ __forceinline__ unsigned xb_ld(unsigned* p)              { return __hip_atomic_load(p, __ATOMIC_RELAXED, __HIP_MEMORY_SCOPE_AGENT); }
__device__ __forceinline__ unsigned xb_add(unsigned* p, unsigned v) { return __hip_atomic_fetch_add(p, v, __ATOMIC_RELAXED, __HIP_MEMORY_SCOPE_AGENT); }
__device__ __forceinline__ unsigned xb_xcc_id() { return (unsigned)__builtin_amdgcn_s_getreg((3 << 11) | 20) & 0xFu; }
#define XB_SPIN(cond, bar) do { unsigned _sp = 0; while (cond) { __builtin_amdgcn_s_sleep(1); \
    if ((++_sp & 255u) == 0u) { if (xb_ld(&(bar)[XB_TMO])) break; if (_sp > XB_SPIN_CAP) { atomicAdd(&(bar)[XB_TMO], 1u); break; } } } } while (0)
struct XcdBarrier { unsigned* bar; unsigned x; volatile LAS unsigned* st; };
__device__ __forceinline__ XcdBarrier xcd_barrier_post(unsigned* bar, volatile LAS unsigned* st) {
    XcdBarrier b; b.bar = bar; b.x = xb_xcc_id(); b.st = st;
    if (threadIdx.x == 0) (void)xb_add(&bar[XB_XCNT(b.x)], 1u);
    return b;
}
__device__ __forceinline__ void xcd_barrier_complete(unsigned* bar, unsigned x, unsigned& nloc, unsigned& nx) {
    const unsigned G = gridDim.x * gridDim.y * gridDim.z;
    unsigned sum, cnt, mine, sp = 0u;
    for (;;) {
        sum = 0u; cnt = 0u; mine = 0u;
#pragma unroll
        for (unsigned j = 0; j < 16; ++j) { const unsigned c = xb_ld(&bar[XB_XCNT(j)]); sum += c; cnt += (c > 0u) ? 1u : 0u; mine = (j == x) ? c : mine; }
        if (sum == G) break;
        __builtin_amdgcn_s_sleep(1);
        if ((++sp & 255u) == 0u) { if (xb_ld(&bar[XB_TMO])) break; if (sp > XB_SPIN_CAP) { atomicAdd(&bar[XB_TMO], 1u); break; } }
    }
    nloc = mine > 0u ? mine : 1u; nx = cnt > 0u ? cnt : 1u;
}
__device__ __forceinline__ void xcd_barrier(const XcdBarrier& b) {
    asm volatile("s_waitcnt vmcnt(0)" ::: "memory");
    __syncthreads();
    if (threadIdx.x == 0) {
        unsigned* bar = b.bar;
        __builtin_amdgcn_s_waitcnt(0);
        unsigned nloc = b.st[0], nx = b.st[1];
        if (nloc == 0u) { xcd_barrier_complete(bar, b.x, nloc, nx); b.st[0] = nloc; b.st[1] = nx; }
        const unsigned old = xb_add(&bar[XB_XSUB(b.x)], 1u);
        const unsigned gen = old / nloc;
        if (old + 1u == (gen + 1u) * nloc) {
            __builtin_amdgcn_fence(__ATOMIC_RELEASE, "agent");
            asm volatile("s_waitcnt vmcnt(0)" ::: "memory");
            const unsigned og = xb_add(&bar[XB_TOP], 1u);
            const unsigned tg = og / nx;
            if (og + 1u != (tg + 1u) * nx) XB_SPIN(xb_ld(&bar[XB_TOP]) < (tg + 1u) * nx, bar);
            __builtin_amdgcn_fence(__ATOMIC_ACQUIRE, "agent");
            asm volatile("s_waitcnt vmcnt(0)" ::: "memory");
        } else {
            XB_SPIN(xb_ld(&bar[XB_TOP]) < (gen + 1u) * nx, bar);
            __builtin_amdgcn_fence(__ATOMIC_ACQUIRE, "agent");
            asm volatile("s_waitcnt vmcnt(0)" ::: "memory");
        }
    }
    __syncthreads();
}

struct Args { const float* in[25]; float* out; unsigned char* ws; int ph_lo, ph_hi; };
struct Frame {
    LAS unsigned char* lds;
    int tid, lane, wave, vcu, G;
    unsigned char* ws;
};

struct P0Job { const float* W; const float* g; bf16_t* dst; int ldw, src0, K, dst0, nblk, r, src1; };
__device__ __forceinline__ void p0_load(const P0Job& j, int lane, float (&v)[32]) {
    const int kb = j.r / j.nblk, nb = j.r % j.nblk;
    const int n = lane & 31;
    const int col = j.src1 > 0 ? ((n & 4) ? j.src1 : j.src0) + 16 * nb + 4 * (n >> 3) + (n & 3) : j.src0 + 32 * nb + n;
    const float* src = j.W + (size_t)(64 * kb) * j.ldw + col + (size_t)(lane >> 5) * j.ldw;
#pragma unroll
    for (int i = 0; i < 32; ++i) v[i] = __builtin_nontemporal_load(src + (size_t)(2 * i) * j.ldw);
}
__device__ __forceinline__ void p0_finish(const P0Job& j, int lane, const float (&v)[32], LAS float* scr) {
    const int kb = j.r / j.nblk, nb = j.r % j.nblk, k0 = 64 * kb;
    const int L = j.dst0 + 32 * nb, c = L & 255, rowbase = (L & ~255) + 128 * ((c >> 5) & 1) + 32 * (c >> 6);
#pragma unroll
    for (int i = 0; i < 32; ++i) scr[(2 * i + (lane >> 5)) * 33 + (lane & 31)] = v[i];
    LDS_WAIT(); asm volatile("" ::: "memory");
    const int cc = lane & 7;
    f32x4 g0 = {1.f, 1.f, 1.f, 1.f}, g1 = {1.f, 1.f, 1.f, 1.f};
    if (j.g) { g0 = *(const f32x4*)(j.g + k0 + 8 * cc); g1 = *(const f32x4*)(j.g + k0 + 8 * cc + 4); }
#pragma unroll
    for (int jj = 0; jj < 4; ++jj) { const int n = (lane >> 3) + 8 * jj; const LAS float* sp = scr + (8 * cc) * 33 + n;
        u32x4 o; o.x = cvtpk(sp[0 * 33] * g0[0], sp[1 * 33] * g0[1]); o.y = cvtpk(sp[2 * 33] * g0[2], sp[3 * 33] * g0[3]);
        o.z = cvtpk(sp[4 * 33] * g1[0], sp[5 * 33] * g1[1]); o.w = cvtpk(sp[6 * 33] * g1[2], sp[7 * 33] * g1[3]);
        *(u32x4*)(j.dst + (size_t)(rowbase + n) * j.K + k0 + 8 * cc) = o; }
    LDS_WAIT(); asm volatile("" ::: "memory");
}
template <bool NORM> __device__ __forceinline__ void row_to_bf16(const float* xrow, bf16_t* orow, float* rstd_out, int lane) {
    const f32x4* xr = (const f32x4*)xrow + lane;
    f32x4 v[4]; float s = 0.f;
#pragma unroll
    for (int j = 0; j < 4; ++j) { v[j] = __builtin_nontemporal_load(xr + 64 * j); s += (v[j].x * v[j].x + v[j].y * v[j].y) + (v[j].z * v[j].z + v[j].w * v[j].w); }
    const float rstd = 1.0f / sqrtf(wave_sum(s) * (1.0f / DM) + EPS);
    const float sc = NORM ? rstd : 1.f;
    u32x2* o8 = (u32x2*)orow + lane;
#pragma unroll
    for (int j = 0; j < 4; ++j) { u32x2 w; w.x = cvtpk(v[j].x * sc, v[j].y * sc); w.y = cvtpk(v[j].z * sc, v[j].w * sc); o8[64 * j] = w; }
    if (rstd_out && lane == 0) *rstd_out = rstd;
}

__global__ void __launch_bounds__(512, 2) hybrid_fwd(Args args) {
    extern __shared__ __attribute__((aligned(16))) unsigned char lds_raw[];
    Frame F;
    F.lds = (LAS unsigned char*)lds_raw;
    F.tid = threadIdx.x; F.lane = F.tid & 63; F.wave = __builtin_amdgcn_readfirstlane(F.tid >> 6);
    F.G = gridDim.x; { const int bx = blockIdx.x; F.vcu = (F.G % 8 == 0) ? (bx % 8) * (F.G / 8) + bx / 8 : bx; }
    F.ws = args.ws;
    unsigned char* ws = args.ws;
    volatile LAS unsigned* MISC = (volatile LAS unsigned*)(F.lds + MISC_OFF);
    for (int u = F.tid; u < (LDS_BYTES - LDSCTL_OFF) / 4; u += 512) ((LAS unsigned*)(F.lds + LDSCTL_OFF))[u] = 0u;
    __syncthreads();
    unsigned* ctl = (unsigned*)(ws + WS_CTL);
    XcdBarrier bar; bar.bar = ctl + CW_BAR; bar.x = 0; bar.st = nullptr;
#if USE_MEMSET
    if (MK_N_LAUNCHES == 1) bar = xcd_barrier_post(ctl + CW_BAR, MISC + 8);
#else
    if (MK_N_LAUNCHES == 1 && blockIdx.x == 0) {
        unsigned long long* z = (unsigned long long*)(ctl + CW_ZERO_LO);
        for (int i = F.tid; i < (CW_ZERO_HI - CW_ZERO_LO) / 2; i += 512) __hip_atomic_store(z + i, 0ull, __ATOMIC_RELAXED, __HIP_MEMORY_SCOPE_AGENT);
        unsigned long long* zs = (unsigned long long*)(ws + WS_SSQ1);
        for (int i = F.tid; i < M / 2; i += 512) __hip_atomic_store(zs + i, 0ull, __ATOMIC_RELAXED, __HIP_MEMORY_SCOPE_AGENT);
        asm volatile("s_waitcnt vmcnt(0)" ::: "memory"); __syncthreads();
        if (F.tid == 0) { __builtin_amdgcn_fence(__ATOMIC_RELEASE, "agent"); asm volatile("s_waitcnt vmcnt(0)" ::: "memory");
            __hip_atomic_store((unsigned long long*)(ctl + CW_FLAG), INIT_MAGIC, __ATOMIC_RELAXED, __HIP_MEMORY_SCOPE_AGENT); }
    }
#endif
    const int lo = args.ph_lo, hi_ph = args.ph_hi;
#ifndef PHASE_MASK
#define PHASE_MASK 0x1ff
#endif
#define IN(k) (((PHASE_MASK >> (k)) & 1) && lo <= (k) && (k) < hi_ph)
#if DUP_MASK
#define REPS(k) for (int rep_ = ((DUP_MASK >> (k)) & 1) ? 0 : 1; rep_ < 2; ++rep_)
#define DRY (rep_ == 0)
#else
#define REPS(k)
#define DRY false
#endif
#if PROBE_A >= 0
#define STAMP(k) do { if (blockIdx.x == 0 && F.tid == 0) MISC[16 + (k)] = (unsigned)__builtin_amdgcn_s_memrealtime(); } while (0)
#else
#define STAMP(k)
#endif
#define SEAM(k) do { if (MK_N_LAUNCHES == 1 && IN(k) && (IN((k) + 1) || (((k) == 2 || (k) == 6) && IN((k) + 2)))) xcd_barrier(bar); STAMP((k) + 1); } while (0)

    const float* x = args.in[0]; const float* mem = args.in[1];
    bf16_t* xb = (bf16_t*)args.out;
    float* hout = args.out;
    float* rstd0 = (float*)(ws + WS_RSTD0); float* ssq1 = (float*)(ws + WS_SSQ1); float* WF = (float*)(ws + WS_WF); float* LF = (float*)(ws + WS_LF);
    bf16_t *WA_e = (bf16_t*)(ws + WS_WA_E), *WG_e = (bf16_t*)(ws + WS_WG_E), *WO_e = (bf16_t*)(ws + WS_WO_E), *WM_e = (bf16_t*)(ws + WS_WM_E);
    bf16_t *WA_o = (bf16_t*)(ws + WS_WA_O), *WG_o = (bf16_t*)(ws + WS_WG_O), *WO_o = (bf16_t*)(ws + WS_WO_O), *WM_o = (bf16_t*)(ws + WS_WM_O);
    bf16_t *memn = (bf16_t*)(ws + WS_MEMN), *MK_e = (bf16_t*)(ws + WS_MK_E), *MV_e = (bf16_t*)(ws + WS_MV_E), *MK_o = (bf16_t*)(ws + WS_MK_O), *MV_o = (bf16_t*)(ws + WS_MV_O);
    bf16_t *Y = (bf16_t*)(ws + WS_Y), *R1 = (bf16_t*)(ws + WS_R1), *R2 = (bf16_t*)(ws + WS_R2), *R3 = (bf16_t*)(ws + WS_R3), *BB = (bf16_t*)(ws + WS_BB);
    LAS float* xch = (LAS float*)(F.lds + XCH_OFF);
    bf16_t* GA_e = (bf16_t*)args.out + (size_t)M * 1024;
    bf16_t* GX_e = R2 + (size_t)M * 1024;
    bf16_t* G1 = (bf16_t*)args.out;
    LAS char* alds = (LAS char*)F.lds;

    STAMP(0);
    if (IN(0)) REPS(0) {
        LAS float* scr = (LAS float*)(F.lds + F.wave * 16384);
        const int gw = F.vcu * 8 + F.wave, NGW = F.G * 8;
#define P0_DECODE(J, it_) do { int r = (it_); \
            if (r < 16 * 96) { J = P0Job{args.in[3], args.in[2], WA_e, 7168, 0, 1024, 0, 96, r}; break; } r -= 16 * 96;              \
            if (r < 16 * 32) { J = P0Job{args.in[3], args.in[2], WA_e, 7168, 4096, 1024, 3072, 32, r, 4608}; break; } r -= 16 * 32;   \
            if (r < 16 * 16) { J = P0Job{args.in[3], args.in[2], WA_e, 7168, 5120, 1024, 4096, 16, r, 5632}; break; } r -= 16 * 16;   \
            if (r < 16 * 16) { J = P0Job{args.in[3], args.in[2], WA_e, 7168, 6144, 1024, 4608, 16, r}; break; } r -= 16 * 16;        \
            if (r < 16 * 32) { J = P0Job{args.in[3], args.in[2], WG_e, 7168, 3072, 1024, 0, 32, r}; break; } r -= 16 * 32;           \
            if (r < 16 * 16) { J = P0Job{args.in[3], args.in[2], WG_e, 7168, 5376, 1024, 1024, 16, r, 5888}; break; } r -= 16 * 16;   \
            if (r < 16 * 16) { J = P0Job{args.in[3], args.in[2], WG_e, 7168, 6656, 1024, 1536, 16, r}; break; } r -= 16 * 16;        \
            if (r < 32 * 32) { J = P0Job{args.in[4], nullptr, WO_e, 1024, 0, 2048, 0, 32, r}; break; } r -= 32 * 32;                 \
            if (r < 16 * 32) { J = P0Job{args.in[14], args.in[13], WM_e, 1024, 0, 1024, 0, 32, r}; break; } r -= 16 * 32;            \
            if (r < 16 * 144) { J = P0Job{args.in[16], args.in[15], WA_o, 7180, 0, 1024, 0, 144, r}; break; } r -= 16 * 144;         \
            if (r < 16 * 16) { J = P0Job{args.in[16], args.in[15], WA_o, 7180, 6156, 1024, 4608, 16, r}; break; } r -= 16 * 16;      \
            if (r < 16 * 48) { J = P0Job{args.in[16], args.in[15], WG_o, 7180, 4608, 1024, 0, 48, r}; break; } r -= 16 * 48;         \
            if (r < 16 * 16) { J = P0Job{args.in[16], args.in[15], WG_o, 7180, 6668, 1024, 1536, 16, r}; break; } r -= 16 * 16;      \
            if (r < 32 * 32) { J = P0Job{args.in[17], nullptr, WO_o, 1024, 0, 2048, 0, 32, r}; break; } r -= 32 * 32; \
            J = P0Job{args.in[24], args.in[23], WM_o, 1024, 0, 1024, 0, 32, r}; } while (0)
        { int it = gw; P0Job cur{}, nxt{}; float va[32], vb[32];
#define P0_IDX(i_) ((i_) < 3584 ? (i_) : (i_) < 4096 ? (i_) + 1024 : (i_) + 5632)
          if (it < 4608) { P0_DECODE(cur, P0_IDX(it)); p0_load(cur, F.lane, va); }
          while (it < 4608) {
              const int itn = it + NGW; const bool hn = itn < 4608;
              if (hn) { P0_DECODE(nxt, P0_IDX(itn)); p0_load(nxt, F.lane, vb); }
              p0_finish(cur, F.lane, va, scr);
#pragma unroll
              for (int i = 0; i < 32; ++i) va[i] = vb[i];
              cur = nxt; it = itn;
          } }
        for (int m = gw; m < M; m += 4 * NGW) {
            f32x4 v[4][4]; float ss[4];
#pragma unroll
            for (int q = 0; q < 4; ++q) { const int mq = (m + q * NGW < M) ? m + q * NGW : m; const f32x4* xr = (const f32x4*)(x + (size_t)mq * DM) + F.lane;
#pragma unroll
                for (int j = 0; j < 4; ++j) v[q][j] = __builtin_nontemporal_load(xr + 64 * j); }
#pragma unroll
            for (int q = 0; q < 4; ++q) { float t = 0.f;
#pragma unroll
                for (int j = 0; j < 4; ++j) t += (v[q][j].x * v[q][j].x + v[q][j].y * v[q][j].y) + (v[q][j].z * v[q][j].z + v[q][j].w * v[q][j].w);
                ss[q] = t; }
#pragma unroll
            for (int o = 1; o < 64; o <<= 1) {
#pragma unroll
                for (int q = 0; q < 4; ++q) ss[q] += __shfl_xor(ss[q], o); }
#pragma unroll
            for (int q = 0; q < 4; ++q) { const int mm = m + q * NGW; if (mm >= M) continue; u32x2* o8 = (u32x2*)(xb + (size_t)mm * DM) + F.lane;
#pragma unroll
                for (int j = 0; j < 4; ++j) { u32x2 w; w.x = cvtpk(v[q][j].x, v[q][j].y); w.y = cvtpk(v[q][j].z, v[q][j].w); o8[64 * j] = w; }
                if (F.lane == 0) rstd0[mm] = 1.0f / sqrtf(ss[q] * (1.0f / DM) + EPS); }
        }
        for (int m = gw; m < MM; m += NGW) row_to_bf16<true>(mem + (size_t)m * DM, memn + (size_t)m * DM, nullptr, F.lane);
        for (int i = (F.vcu * 512 + F.tid); i < 16 * 1024; i += F.G * 512) { const int c = i >> 10, k = i & 1023;
            const float wv_ = c < 12 ? args.in[15][k] * args.in[16][(size_t)k * 7180 + 6144 + c] : 0.f; ((bf16_t*)WF)[i] = (bf16_t)(cvtpk(wv_, 0.f) & 0xffffu); }
    }
#if !USE_MEMSET
    if (MK_N_LAUNCHES == 1) {
        if (F.tid == 0) { unsigned sp = 0;
            while (__hip_atomic_load((unsigned long long*)(ctl + CW_FLAG), __ATOMIC_RELAXED, __HIP_MEMORY_SCOPE_AGENT) != INIT_MAGIC) { __builtin_amdgcn_s_sleep(2); if (++sp > (1u << 24)) break; }
            __builtin_amdgcn_fence(__ATOMIC_ACQUIRE, "agent"); asm volatile("s_waitcnt vmcnt(0)" ::: "memory"); }
        __syncthreads();
        bar = xcd_barrier_post(ctl + CW_BAR, MISC + 8);
    }
#endif
    SEAM(0);

    if (IN(1)) REPS(1) {
        if (STAGGER_TICKS > 0 && ((blockIdx.x >> 3) & 1)) { const unsigned long long t0 = __builtin_amdgcn_s_memrealtime(); while (__builtin_amdgcn_s_memrealtime() - t0 < (unsigned long long)STAGGER_TICKS) __builtin_amdgcn_s_sleep(8); }
        pg8::Gemm g{xb, WA_e, M, 7168, DM}; pg8::StaticOrder S; S.init(M, 7168, F.G, (int)blockIdx.x);
        pg8::EpiProj E{0, rstd0, nullptr, Y, R1, R2, R3, BB, nullptr, nullptr, args.in[5], args.in[6], args.in[11], nullptr, xch, GA_e, GX_e};
        pg8::gemm_phase<pg8::EpiProj, pg8::StaticOrder, true>(F.lds, g, S, E);
    }
    SEAM(1);

#define Q_POP_FIRST(qh) do { if (F.tid == 0) MISC[12] = xb_add((qh), 1u); LDS_WAIT(); __syncthreads(); cur = (int)MISC[12]; __syncthreads(); } while (0)
#define Q_PREFETCH(qh) unsigned nxt_reg_ = 0u; if (F.tid == 0) nxt_reg_ = xb_add((qh), 1u)
#define Q_NEXT() do { if (F.tid == 0) MISC[12] = nxt_reg_; LDS_WAIT(); __syncthreads(); cur = (int)MISC[12]; __syncthreads(); } while (0)
    if (IN(2)) REPS(2) {
        bf16_t* dummy = (bf16_t*)(ws + WS_END) + (size_t)(F.vcu * 8 + F.wave) * 2048;
        unsigned* qh = ctl + CW_Q2 + (DRY ? 64 : 0); unsigned* mkv_done = ctl + CW_MKV;
        const int r32 = F.lane & 31, hi = F.lane >> 5;
        float lam;
        { const float* lp = args.in[7]; const float a = wave_sum(lp[F.lane] * lp[64 + F.lane]), b = wave_sum(lp[128 + F.lane] * lp[192 + F.lane]);
          lam = __builtin_bit_cast(float, __builtin_amdgcn_readfirstlane(__builtin_bit_cast(int, expf(a) - expf(b) + LAM_INIT))); }
        float zb, b2;
        { float gq = fabsf(args.in[5][F.lane]), gk = fabsf(args.in[6][F.lane]);
#pragma unroll
          for (int o = 1; o < 64; o <<= 1) { gq = fmaxf(gq, __shfl_xor(gq, o)); gk = fmaxf(gk, __shfl_xor(gk, o)); }
          b2 = __builtin_bit_cast(float, __builtin_amdgcn_readfirstlane(__builtin_bit_cast(int, 16.0f * gq * gk))); zb = ZSKIP + b2; }
        const float eoff64 = fmaxf(0.f, b2 * 0.5f * LOG2E - 100.0f);
        int cur; Q_POP_FIRST(qh);
        while ((P2_PARTS & 1) && cur < 64) {
            Q_PREFETCH(qh);
            { const int lay = cur >> 5, uu = cur & 31; pg8::OneUnit S{uu >> 2, uu & 3};
              pg8::Gemm g{memn, lay ? WM_o : WM_e, MM, 1024, DM};
              pg8::EpiProj E{2, nullptr, nullptr, nullptr, nullptr, nullptr, nullptr, nullptr, lay ? MK_o : MK_e, lay ? MV_o : MV_e, nullptr, nullptr, nullptr, lay ? args.in[22] : args.in[12], xch, nullptr, nullptr};
              pg8::gemm_phase<pg8::EpiProj, pg8::OneUnit, true>(F.lds, g, S, E);
              if (F.tid == 0 && !DRY) { __builtin_amdgcn_fence(__ATOMIC_RELEASE, "agent"); asm volatile("s_waitcnt vmcnt(0)" ::: "memory"); xb_add(mkv_done, 1u); } }
            Q_NEXT();
        }
        asm volatile("" ::: "memory");
#define DIFF_DECODE(c_) const int j = (c_) - 64, qb = 15 - (j >> 6), bh = j & 63, b = bh >> 3, h = bh & 7, sub = F.wave >> 2, w4 = sub ? 3 - (F.wave & 3) : (F.wave & 3);     \
              const float slope = exp2f(-(float)(h + 1)), cslope = slope * LOG2E; \
              int jlo = 0; { const float dz = zb / slope, q0f = (float)(qb * 128); if (q0f > dz) jlo = (int)((q0f - dz) * (1.0f / 64.0f)); } \
              const size_t row0 = (size_t)b * SEQ + qb * 128; \
              bf16_t* Qw = Y + (row0 + w4 * 32) * 2048 + 128 * h + 64 * sub; \
              const bf16_t* Kp = R1 + (size_t)(b * SEQ + 64 * jlo) * 1024 + 128 * h; const bf16_t* Vp = R2 + (size_t)(b * SEQ + 64 * jlo) * 1024 + 128 * h
        att::Pre<4> PD;
        if ((P2_PARTS & 2) && cur < 1088) { DIFF_DECODE(cur); att::attn_preload<4>(PD, Qw, 2048); }
        while ((P2_PARTS & 2) && cur < 1088) {
            unsigned nxt_reg_ = 0u; if (F.tid == 0) nxt_reg_ = xb_add(qh, 1u);
            int nxt;
            { DIFF_DECODE(cur);
              if (F.tid < 64) ((LAS float*)(alds + att::BIAS_OFF))[F.tid] = cslope * (float)F.tid;
              f32x16 o[4]; float l;
              att::attn_core<4, 1, true>(PD, Kp, 1024, Vp, 1024, 2 * (qb + 1) - jlo, qb * 128 + w4 * 32 - 64 * jlo, 128 * sub, 0, cslope * 64.f, eoff64, alds, o, l);
              if (F.tid == 0) MISC[12] = nxt_reg_; LDS_WAIT(); __syncthreads(); nxt = (int)MISC[12];
              if (nxt < 1088) { DIFF_DECODE(nxt); att::attn_preload<4>(PD, Qw, 2048); }
              const int chq = F.lane & 15;
              LAS float* li_l = (LAS float*)(alds + att::WS_OFF) + F.wave * 64;
              if (hi == 0) li_l[r32] = l;
              LDS_WAIT();
              float rli[16];
#pragma unroll
              for (int r = 0; r < 16; ++r) rli[r] = __builtin_amdgcn_rcpf(li_l[att::crow(r, hi)]);
              __syncthreads();
              LAS float* X = (LAS float*)alds + w4 * (32 * 132);
              if (sub == 1) {
#pragma unroll
                  for (int r = 0; r < 16; ++r) { const int orow = att::crow(r, hi); const float f = rli[r] * lam;
#pragma unroll
                      for (int d0 = 0; d0 < 4; ++d0) X[orow * 132 + d0 * 32 + r32] = o[d0][r] * f; }
              }
              LDS_WAIT(); __syncthreads();
              if (sub == 0) {
#pragma unroll
                  for (int r = 0; r < 16; ++r) { const int orow = att::crow(r, hi);
#pragma unroll
                      for (int d0 = 0; d0 < 4; ++d0) { const float t = o[d0][r] * rli[r] - X[orow * 132 + d0 * 32 + r32]; X[orow * 132 + d0 * 32 + r32] = t; } }
                  u32x4 gin[8];
#pragma unroll
                  for (int i = 0; i < 8; ++i) gin[i] = __builtin_nontemporal_load((const u32x4*)(GA_e + (row0 + w4 * 32 + 4 * i + (F.lane >> 4)) * 1024 + 128 * h + chq * 8));
                  const f32x4 g0 = *(const f32x4*)(args.in[8] + chq * 8), g1 = *(const f32x4*)(args.in[8] + chq * 8 + 4);
                  LDS_WAIT();
                  const LAS float* xr = X + r32 * 132 + hi * 64;
                  float ssum = 0.f;
#pragma unroll
                  for (int c = 0; c < 16; ++c) { const f32x4 t = *(const LAS f32x4*)(xr + 4 * c); ssum += (t[0] * t[0] + t[1] * t[1]) + (t[2] * t[2] + t[3] * t[3]); }
                  { auto rr = __builtin_amdgcn_permlane32_swap(__float_as_uint(ssum), __float_as_uint(ssum), false, false); ssum = __uint_as_float(rr[0]) + __uint_as_float(rr[1]); }
                  const float rn = (1.0f - LAM_INIT) * __builtin_amdgcn_rsqf(ssum * (1.0f / 128.0f) + EPS);
                  if (hi == 0) li_l[32 + r32] = rn;
                  LDS_WAIT();
#pragma unroll
                  for (int i = 0; i < 8; ++i) { const int row = 4 * i + (F.lane >> 4);
                      const LAS float* xs = X + row * 132 + chq * 8;
                      const f32x4 t0 = *(const LAS f32x4*)(xs), t1 = *(const LAS f32x4*)(xs + 4);
                      const float rv = li_l[32 + row];
                      const u32x4 gz = gin[i];
                      u32x4 w; w.x = cvtpk(t0[0] * rv * g0[0] * bf_lo(gz.x), t0[1] * rv * g0[1] * bf_hi(gz.x)); w.y = cvtpk(t0[2] * rv * g0[2] * bf_lo(gz.y), t0[3] * rv * g0[3] * bf_hi(gz.y));
                      w.z = cvtpk(t1[0] * rv * g1[0] * bf_lo(gz.z), t1[1] * rv * g1[1] * bf_hi(gz.z)); w.w = cvtpk(t1[2] * rv * g1[2] * bf_lo(gz.w), t1[3] * rv * g1[3] * bf_hi(gz.w));
                      bf16_t* op_ = DRY ? dummy + row * 32 + chq * 8 : Y + (row0 + w4 * 32 + row) * 2048 + 128 * h + chq * 8;
                      st16(op_, w); }
              }
              LDS_WAIT(); __syncthreads(); }
            cur = nxt;
        }
#undef DIFF_DECODE
        asm volatile("" ::: "memory");
        if (cur < 1344) {
            if (F.tid == 0) { unsigned sp = 0; while (xb_ld(mkv_done) < 64u && !DRY) { __builtin_amdgcn_s_sleep(2); if (++sp > (1u << 22)) break; }
                __builtin_amdgcn_fence(__ATOMIC_ACQUIRE, "agent"); asm volatile("s_waitcnt vmcnt(0)" ::: "memory"); }
            __syncthreads();
        }
#define CROSS_DECODE(c_, base_, MK_, MV_) const int c = (c_) - (base_), b = c >> 5, hd = (c >> 3) & 3, qb = c & 7; \
              bf16_t* Qw = Y + (size_t)(b * SEQ + qb * 256 + F.wave * 32) * 2048 + 1536 + 128 * hd; \
              const bf16_t* Kp = (MK_) + (size_t)(b * MEML) * 512 + 128 * hd; const bf16_t* Vp = (MV_) + (size_t)(b * MEML) * 512 + 128 * hd
        att::Pre<8> PX;
        if ((P2_PARTS & 4) && cur < 1344) { CROSS_DECODE(cur, 1088, MK_e, MV_e); att::attn_preload<8>(PX, Qw, 2048); }
        while ((P2_PARTS & 4) && cur < 1344) {
            unsigned nxt_reg_ = 0u; if (F.tid == 0) nxt_reg_ = xb_add(qh, 1u);
            int nxt;
            { CROSS_DECODE(cur, 1088, MK_e, MV_e);
              f32x16 o[4]; float l;
              att::attn_core<8, 0, false>(PX, Kp, 512, Vp, 512, 4, 0, 0, 0, 0.f, 0.f, alds, o, l);
              if (F.tid == 0) MISC[12] = nxt_reg_; LDS_WAIT(); __syncthreads(); nxt = (int)MISC[12];
              bf16_t* Ow = DRY ? dummy : Qw; const bf16_t* GXw = GX_e + (size_t)(b * SEQ + qb * 256 + F.wave * 32) * 512 + 128 * hd;
              if (nxt < 1344) { CROSS_DECODE(nxt, 1088, MK_e, MV_e); att::attn_preload<8>(PX, Qw, 2048); }
              att::store_rows_bf16(o, l, Ow, DRY ? 32 : 2048, alds, GXw, 512); }
            cur = nxt;
        }
        asm volatile("" ::: "memory");
        while ((P2_PARTS & 8) && cur < 1600) {
            Q_PREFETCH(qh);
            { const int ch = (F.tid & 63) * 8, t0 = 64 * (cur - 1344) + 8 * (F.tid >> 6);
              const float* cw = args.in[9]; const float* cbp = args.in[10];
              u32x4 uin[10], gin[8];
              const bool halo = (t0 & (SEQ - 1)) != 0;
#pragma unroll
              for (int rr = 0; rr < 10; ++rr) { const size_t t = (size_t)((halo || rr >= 2) ? t0 - 2 + rr : t0); uin[rr] = __builtin_nontemporal_load((const u32x4*)(R3 + t * 512 + ch)); }
#pragma unroll
              for (int rr = 0; rr < 8; ++rr) gin[rr] = __builtin_nontemporal_load((const u32x4*)(BB + (size_t)(t0 + rr) * 512 + ch));
              float w0[8], w1[8], w2[8], bsv[8], um2[8], um1[8];
#pragma unroll
              for (int j = 0; j < 8; ++j) { w0[j] = cw[ch + j]; w1[j] = cw[512 + ch + j]; w2[j] = cw[1024 + ch + j]; bsv[j] = cbp[ch + j]; }
#define CONV_U(dst, U_) do { dst[0] = bf_lo(U_.x); dst[1] = bf_hi(U_.x); dst[2] = bf_lo(U_.y); dst[3] = bf_hi(U_.y); dst[4] = bf_lo(U_.z); dst[5] = bf_hi(U_.z); dst[6] = bf_lo(U_.w); dst[7] = bf_hi(U_.w); } while (0)
              CONV_U(um2, uin[0]); CONV_U(um1, uin[1]);
              if (!halo) {
#pragma unroll
                  for (int j = 0; j < 8; ++j) { um2[j] = 0.f; um1[j] = 0.f; } }
#pragma unroll
              for (int rr = 0; rr < 8; ++rr) { const size_t t = (size_t)(t0 + rr);
                  float u0[8], gv[8], yv[8];
                  CONV_U(u0, uin[rr + 2]); CONV_U(gv, gin[rr]);
#pragma unroll
                  for (int j = 0; j < 8; ++j) { yv[j] = gv[j] * (w0[j] * um2[j] + w1[j] * um1[j] + w2[j] * u0[j] + bsv[j]); um2[j] = um1[j]; um1[j] = u0[j]; }
                  u32x4 w; w.x = cvtpk(yv[0], yv[1]); w.y = cvtpk(yv[2], yv[3]); w.z = cvtpk(yv[4], yv[5]); w.w = cvtpk(yv[6], yv[7]);
                  *(u32x4*)(DRY ? dummy + (rr & 7) * 64 : Y + t * 2048 + 1024 + ch) = w; }
#undef CONV_U
            }
            Q_NEXT();
        }
        asm volatile("" ::: "memory");
        while (cur < 2176) {
            Q_PREFETCH(qh);
            { const int n_ = 8 * (cur - 1600) + F.wave; P0Job jb{}; P0_DECODE(jb, (n_ < 1024 ? 3584 + n_ : 4096 + n_)); float vv[32];
              p0_load(jb, F.lane, vv); p0_finish(jb, F.lane, vv, (LAS float*)(F.lds + F.wave * 16384)); }
            Q_NEXT();
        }
    }
    SEAM(2);

    if (IN(4)) REPS(4) {
        pg8::Gemm g{Y, WO_e, M, DM, 2048}; pg8::StaticOrder S; S.init(M, DM, F.G, (int)blockIdx.x, 8);
        pg8::EpiOut<true> E{xb, nullptr, R3, ssq1, DRY ? 1 : 0};
        pg8::gemm_phase<pg8::EpiOut<true>, pg8::StaticOrder, true>(F.lds, g, S, E);
    }
    SEAM(4);

    if (IN(5)) REPS(5) {
        for (int v = F.vcu; v < 256; v += F.G) {
            const int w4 = F.wave & 3, kh = F.wave >> 2, fr = F.lane & 15, fq = F.lane >> 4, row0 = 64 * v + 16 * w4;
            const bf16_t* ap = R3 + (size_t)(row0 + fr) * DM + kh * 512 + 8 * fq;
            const bf16_t* bp = (const bf16_t*)WF + (size_t)fr * DM + kh * 512 + 8 * fq;
            f32x4 facc = {0.f, 0.f, 0.f, 0.f};
#pragma unroll 8
            for (int ks = 0; ks < 16; ++ks) { const bf16x8 a = *(const bf16x8*)(ap + 32 * ks), bb = *(const bf16x8*)(bp + 32 * ks);
                facc = __builtin_amdgcn_mfma_f32_16x16x32_bf16(a, bb, facc, 0, 0, 0); }
            LAS f32x4* fx = (LAS f32x4*)F.lds + w4 * 64 + F.lane;
            if (kh == 1) *fx = facc;
            LDS_WAIT(); __syncthreads();
            if (kh == 0) { const f32x4 o2 = *fx; facc += o2;
                const float fbc = args.in[20][fr < 12 ? fr : 0];
                float sq[4];
#pragma unroll
                for (int r = 0; r < 4; ++r) sq[r] = ssq1[row0 + 4 * fq + r];
#pragma unroll
                for (int r = 0; r < 4; ++r) { const int row = row0 + 4 * fq + r;
                    const float f = facc[r] * __builtin_amdgcn_rsqf(sq[r] * (1.0f / DM) + EPS) + fbc;
                    const float ls = fminf(f, 0.f) - __logf(1.0f + __expf(-fabsf(f)));
                    if (fr < 12) LF[(size_t)row * 12 + fr] = ls; } }
            LDS_WAIT(); __syncthreads();
        }
        if (STAGGER_TICKS > 0 && ((blockIdx.x >> 3) & 1)) { const unsigned long long t0 = __builtin_amdgcn_s_memrealtime(); while (__builtin_amdgcn_s_memrealtime() - t0 < (unsigned long long)STAGGER_TICKS) __builtin_amdgcn_s_sleep(8); }
        pg8::Gemm g{R3, WA_o, M, 7168, DM}; pg8::StaticOrder S; S.init(M, 7168, F.G, (int)blockIdx.x);
        pg8::EpiProj E{1, nullptr, ssq1, Y, R1, R2, nullptr, nullptr, nullptr, nullptr, args.in[18], args.in[19], args.in[21], nullptr, xch, G1, nullptr};
        pg8::gemm_phase<pg8::EpiProj, pg8::StaticOrder, true>(F.lds, g, S, E);
    }
    SEAM(5);

    if (IN(6)) REPS(6) {
        bf16_t* dummy = (bf16_t*)(ws + WS_END) + (size_t)(F.vcu * 8 + F.wave) * 2048;
        unsigned* qh = ctl + CW_Q6 + (DRY ? 64 : 0);
        float eoff128, zbF;
        { float gq = fmaxf(fabsf(args.in[18][F.lane]), fabsf(args.in[18][64 + F.lane])), gk = fmaxf(fabsf(args.in[19][F.lane]), fabsf(args.in[19][64 + F.lane]));
#pragma unroll
          for (int o = 1; o < 64; o <<= 1) { gq = fmaxf(gq, __shfl_xor(gq, o)); gk = fmaxf(gk, __shfl_xor(gk, o)); }
          eoff128 = __builtin_bit_cast(float, __builtin_amdgcn_readfirstlane(__builtin_bit_cast(int, fmaxf(0.f, 11.3137085f * gq * gk * LOG2E - 100.0f))));
          zbF = __builtin_bit_cast(float, __builtin_amdgcn_readfirstlane(__builtin_bit_cast(int, (ZSKIP + 2.0f * 11.3137085f * gq * gk) * LOG2E))); }
        int cur; Q_POP_FIRST(qh);
#define FOX_DECODE(c_) const int qb = 7 - (c_) / 96, bh = (c_) % 96, b = bh / 12, h = bh % 12; \
              bf16_t* Qw = Y + (size_t)(b * SEQ + qb * 256 + F.wave * 32) * 2048 + 128 * h; \
              const bf16_t* Kp = R1 + (size_t)(b * SEQ) * 1536 + 128 * h; const bf16_t* Vp = R2 + (size_t)(b * SEQ) * 1536 + 128 * h
        att::Pre<8> PF; float lfp[4] = {0.f, 0.f, 0.f, 0.f};
#define FOX_LF_LOAD() do { const int n_ = 256 * (qb + 1), t0_ = 4 * F.tid; lfp[0] = lfp[1] = lfp[2] = lfp[3] = 0.f; \
            if (t0_ < n_) { const float* lf = LF + ((size_t)b * SEQ + t0_) * 12 + h; lfp[0] = lf[0]; lfp[1] = lf[12]; lfp[2] = lf[24]; lfp[3] = lf[36]; } } while (0)
        if (cur < 768) { FOX_DECODE(cur); att::attn_preload<8>(PF, Qw, 2048); FOX_LF_LOAD(); }
        while (cur < 768) {
            unsigned nxt_reg_ = 0u; if (F.tid == 0) nxt_reg_ = xb_add(qh, 1u);
            int nxt;
            { FOX_DECODE(cur);
              { const int n = 256 * (qb + 1), t0 = 4 * F.tid; const float v0 = lfp[0], v1 = lfp[1], v2 = lfp[2], v3 = lfp[3];
                const float s1 = v0, s2 = s1 + v1, s3 = s2 + v2, s4 = s3 + v3;
                float xs = s4;
#pragma unroll
                for (int off = 1; off < 64; off <<= 1) { const float t = __shfl_up(xs, off); if (F.lane >= off) xs += t; }
                LAS float* wtot = (LAS float*)(alds + att::SCAN_OFF);
                if (F.lane == 63) wtot[F.wave] = xs;
                LDS_WAIT(); __syncthreads();
                float pre = 0.f;
#pragma unroll
                for (int w = 0; w < 8; ++w) { const float t = wtot[w]; if (w < F.wave) pre += t; }
                const float ex = pre + (xs - s4);
                if (t0 < n) { LAS float* bl = (LAS float*)(alds + att::BIAS_OFF) + t0;
                    *(LAS f32x4*)bl = (f32x4){-(ex + s1) * LOG2E, -(ex + s2) * LOG2E, -(ex + s3) * LOG2E, -(ex + s4) * LOG2E}; }
              }
              f32x16 o[4]; float l;
              int jlo = 0;
              if (FOX_SKIP) { LDS_WAIT(); __syncthreads();
                  LAS const float* tb = (LAS const float*)(alds + att::BIAS_OFF);
                  const float d = tb[F.lane < 4 * qb ? 64 * F.lane + 63 : 0] - tb[256 * qb];
                  jlo = __builtin_popcountll(__ballot(F.lane < 4 * qb && d < -zbF)); }
              att::attn_core<8, 2, true>(PF, Kp + (size_t)(64 * jlo) * 1536, 1536, Vp + (size_t)(64 * jlo) * 1536, 1536, 4 * (qb + 1) - jlo, qb * 256 + F.wave * 32 - 64 * jlo, 0, 64 * jlo, 0.f, eoff128, alds, o, l);
              if (F.tid == 0) MISC[12] = nxt_reg_; LDS_WAIT(); __syncthreads(); nxt = (int)MISC[12];
              bf16_t* Ow = DRY ? dummy : Qw; const bf16_t* Gw = G1 + (size_t)(b * SEQ + qb * 256 + F.wave * 32) * 2048 + 128 * h;
              if (nxt < 768) { FOX_DECODE(nxt); att::attn_preload<8>(PF, Qw, 2048); FOX_LF_LOAD(); }
              att::store_rows_bf16(o, l, Ow, DRY ? 32 : 2048, alds, Gw, 2048); }
            cur = nxt;
        }
#undef FOX_DECODE
#undef FOX_LF_LOAD
        asm volatile("" ::: "memory");
        att::Pre<8> PX;
        if (cur < 1024) { CROSS_DECODE(cur, 768, MK_o, MV_o); att::attn_preload<8>(PX, Qw, 2048); }
        while (cur < 1024) {
            unsigned nxt_reg_ = 0u; if (F.tid == 0) nxt_reg_ = xb_add(qh, 1u);
            int nxt;
            { CROSS_DECODE(cur, 768, MK_o, MV_o);
              f32x16 o[4]; float l;
              att::attn_core<8, 0, false>(PX, Kp, 512, Vp, 512, 4, 0, 0, 0, 0.f, 0.f, alds, o, l);
              if (F.tid == 0) MISC[12] = nxt_reg_; LDS_WAIT(); __syncthreads(); nxt = (int)MISC[12];
              bf16_t* Ow = DRY ? dummy : Qw; const bf16_t* Gw = G1 + (size_t)(b * SEQ + qb * 256 + F.wave * 32) * 2048 + 1536 + 128 * hd;
              if (nxt < 1024) { CROSS_DECODE(nxt, 768, MK_o, MV_o); att::attn_preload<8>(PX, Qw, 2048); }
              att::store_rows_bf16(o, l, Ow, DRY ? 32 : 2048, alds, Gw, 2048); }
            cur = nxt;
        }
#undef CROSS_DECODE
        asm volatile("" ::: "memory");
        while (cur < 1152) {
            Q_PREFETCH(qh);
            { P0Job jb{}; P0_DECODE(jb, 8704 + 8 * (cur - 1024) + F.wave); float vv[32];
              p0_load(jb, F.lane, vv); p0_finish(jb, F.lane, vv, (LAS float*)(F.lds + F.wave * 16384)); }
            Q_NEXT();
        }
    }
    SEAM(6);

    if (IN(8)) REPS(8) {
#if !USE_MEMSET
        if (MK_N_LAUNCHES == 1 && blockIdx.x == 0 && F.tid == 0) __hip_atomic_store((unsigned long long*)(ctl + CW_FLAG), 0ull, __ATOMIC_RELAXED, __HIP_MEMORY_SCOPE_AGENT);
#endif
        pg8::Gemm g{Y, WO_o, M, DM, 2048}; pg8::StaticOrder S; S.init(M, DM, F.G, (int)blockIdx.x, 8);
        pg8::EpiOut<false> E{R3, hout, nullptr, nullptr, DRY ? 1 : 0};
        pg8::gemm_phase<pg8::EpiOut<false>, pg8::StaticOrder, true>(F.lds, g, S, E);
    }
#if PROBE_A >= 0
    xcd_barrier(bar); STAMP(9);
    if (blockIdx.x == 0) {
        const float ta = (float)(MISC[16 + PROBE_A + 1] - MISC[16 + PROBE_A]) * 0.000001f;
        const float tb = (PROBE_B >= 0) ? (float)(MISC[16 + (PROBE_B >= 0 ? PROBE_B : 0) + 1] - MISC[16 + (PROBE_B >= 0 ? PROBE_B : 0)]) * 0.0000025f : 0.05f;
        if (F.tid == 0) hout[0] += ta;
        for (int i = F.tid; i < (1 << 22); i += 512) hout[1024 + i] += tb;
    }
#endif
#undef P0_DECODE
#undef P0_IDX
#undef IN
#undef SEAM
#undef REPS
#undef DRY
}

extern "C" void kernel_launch(void* const* d_in, const int* in_sizes, int n_in, void* d_out, int out_size, void* d_ws, size_t ws_size, hipStream_t stream) {
    static int grid = 0;
    if (grid == 0) {
        if (n_in != 25 || in_sizes[0] != M * DM || out_size != M * DM || ws_size < WS_END) {
            fprintf(stderr, "kernel_launch: unexpected shapes (n_in %d, in0 %d, out %d, ws %zu); nothing launched\n", n_in, n_in > 0 ? in_sizes[0] : -1, out_size, ws_size); grid = -1; return; }
        int dev = 0, cus = 0, per_cu = 0;
        if (hipGetDevice(&dev) != hipSuccess || hipDeviceGetAttribute(&cus, hipDeviceAttributeMultiprocessorCount, dev) != hipSuccess) { fprintf(stderr, "kernel_launch: device query failed\n"); grid = -1; return; }
        if (hipFuncSetAttribute((const void*)hybrid_fwd, hipFuncAttributeMaxDynamicSharedMemorySize, LDS_BYTES) != hipSuccess) { fprintf(stderr, "kernel_launch: hipFuncSetAttribute failed\n"); grid = -1; return; }
        if (hipOccupancyMaxActiveBlocksPerMultiprocessor(&per_cu, (const void*)hybrid_fwd, 512, LDS_BYTES) != hipSuccess || per_cu < 1) {
            fprintf(stderr, "kernel_launch: occupancy query reports %d workgroups per CU\n", per_cu); per_cu = 1; }
        (void)hipGetLastError();
        grid = cus;
        if (grid > 256) grid = 256;
    }
    if (grid < 0) return;
#if USE_MEMSET || MK_N_LAUNCHES != 1
    if (hipMemsetAsync((char*)d_ws + WS_CTL, 0, CTL_ZERO_BYTES, stream) != hipSuccess) { fprintf(stderr, "kernel_launch: memset failed\n"); return; }
#endif
    Args a{};
    for (int i = 0; i < 25; ++i) a.in[i] = (const float*)d_in[i];
    a.out = (float*)d_out; a.ws = (unsigned char*)d_ws;
    if (MK_N_LAUNCHES == 1) { a.ph_lo = 0; a.ph_hi = 9; hipLaunchKernelGGL(hybrid_fwd, dim3(grid), dim3(512), LDS_BYTES, stream, a); }
    else { for (int p = 0; p < 9; ++p) { a.ph_lo = p; a.ph_hi = p + 1; hipLaunchKernelGGL(hybrid_fwd, dim3(grid), dim3(512), LDS_BYTES, stream, a); } }
    const hipError_t le = hipPeekAtLastError();
    if (le != hipSuccess) fprintf(stderr, "kernel_launch: launch failed: %s\n", hipGetErrorName(le));
}
```
